# Optimizing an MI355X kernel written in HIP

```python
import math
import jax, jax.numpy as jnp
from jax import lax
import numpy as np

D_MODEL = 1024
BATCH = 2
SEQ = 8192
DEPTH = 2

N_BRANCH = 4
BRANCH_W = D_MODEL // 4
POOL_WINDOWS = (2, 4, 8, 16)
POOL_GROUPS = len(POOL_WINDOWS)
POOL_GW = BRANCH_W // POOL_GROUPS
SG_HEADS = 4
SG_CHUNK = 128
SG_HD = BRANCH_W // SG_HEADS
CONV_WIDTH = 31
ATT_HEADS = 4
ATT_HD = BRANCH_W // ATT_HEADS
ATT_BLOCK = 128
COL_SIZES = (
    BRANCH_W,
    2 * BRANCH_W,
    2 * BRANCH_W,
    BRANCH_W,
    BRANCH_W,
    BRANCH_W,
    ATT_HEADS,
    N_BRANCH * D_MODEL,
)
COL_TOTAL = int(sum(COL_SIZES))
COL_SPLITS = tuple(int(i) for i in np.cumsum(COL_SIZES)[:-1])
N_EXPERTS = 64
TOP_K = 6
N_GROUPS = 8
TOPK_GROUPS = 4
EXPERT_FF = 256
SHARED_FF = 256
ROUTE_SCALE = 2.5
MOE_CHUNK = 128
EPS = 1e-6
N_MOD = 6

kernel_name = "hybrid_pool_sgmlp_conformer_fox_moe_adaln"


def rms_norm(x, g):
    x32 = x.astype(jnp.float32)
    y = x32 * lax.rsqrt(jnp.mean(x32 * x32, axis=-1, keepdims=True) + EPS)
    return (y * g.astype(jnp.float32)).astype(x.dtype)


def layer_norm(x, g, b):
    x32 = x.astype(jnp.float32)
    mu = jnp.mean(x32, axis=-1, keepdims=True)
    var = jnp.mean(jnp.square(x32 - mu), axis=-1, keepdims=True)
    y = (x32 - mu) * lax.rsqrt(var + EPS)
    return (y * g.astype(jnp.float32) + b.astype(jnp.float32)).astype(x.dtype)


def multiscale_pool(u, w_pool, scale):
    B, S, _ = u.shape
    ug = u.reshape(B, S, POOL_GROUPS, POOL_GW).astype(jnp.float32)
    cs = jnp.cumsum(ug, axis=1)
    count = jnp.arange(1, S + 1, dtype=jnp.float32)
    outs = []
    for gi, w in enumerate(POOL_WINDOWS):
        csg = cs[:, :, gi]
        lag = jnp.pad(csg, ((0, 0), (w, 0), (0, 0)))[:, :S]
        mean = (csg - lag) / jnp.minimum(count, float(w))[None, :, None]
        outs.append(mean - ug[:, :, gi])
    pooled = jnp.stack(outs, axis=2)
    y = jnp.einsum('bsgc,gcd->bsgd', pooled, w_pool.astype(jnp.float32)).reshape(B, S, BRANCH_W)
    return (y * scale.astype(jnp.float32)).astype(u.dtype)


def spatial_gating(z, ln_g, ln_b, w_s, b_s):
    B, S, _ = z.shape
    z = jax.nn.gelu(z)
    u, v = jnp.split(z, 2, axis=-1)
    v = layer_norm(v, ln_g, ln_b)
    vb = v.reshape(B, S // SG_CHUNK, SG_CHUNK, SG_HEADS, SG_HD)
    causal = jnp.tril(jnp.ones((SG_CHUNK, SG_CHUNK), dtype=w_s.dtype))
    s = jnp.einsum('hts,bnshc->bnthc', w_s * causal, vb)
    s = s + jnp.transpose(b_s)[None, None, :, :, None]
    return u * s.reshape(B, S, BRANCH_W)


def conformer_conv(z, conv_w, conv_b, ln_g, ln_b):
    a, g = jnp.split(z, 2, axis=-1)
    y = a * jax.nn.sigmoid(g)
    y = lax.conv_general_dilated(
        y, conv_w[:, None, :].astype(y.dtype), window_strides=(1,),
        padding=[(CONV_WIDTH - 1, 0)], dimension_numbers=('NWC', 'WIO', 'NWC'),
        feature_group_count=BRANCH_W) + conv_b
    y = layer_norm(y, ln_g, ln_b)
    return jax.nn.silu(y)


def forgetting_attention(q, k, v, f_logit):
    B, S, H, dh = q.shape
    nb = S // ATT_BLOCK
    log_f = jax.nn.log_sigmoid(f_logit.astype(jnp.float32))
    cum = jnp.cumsum(log_f, axis=1)
    cum_k = jnp.transpose(cum, (0, 2, 1))
    k32 = k.astype(jnp.float32)
    v32 = v.astype(jnp.float32)
    qb = jnp.transpose(q.reshape(B, nb, ATT_BLOCK, H, dh), (1, 0, 2, 3, 4))
    cb = jnp.transpose(cum.reshape(B, nb, ATT_BLOCK, H), (1, 0, 3, 2))
    starts = jnp.arange(nb, dtype=jnp.int32) * ATT_BLOCK
    kpos = jnp.arange(S, dtype=jnp.int32)
    scale = 1.0 / math.sqrt(dh)

    def one_block(args):
        q_blk, c_blk, start = args
        logits = jnp.einsum('bqhd,bkhd->bhqk', q_blk.astype(jnp.float32), k32) * scale
        logits = logits + c_blk[..., None] - cum_k[:, :, None, :]
        qpos = start + jnp.arange(ATT_BLOCK, dtype=jnp.int32)
        mask = kpos[None, :] <= qpos[:, None]
        logits = jnp.where(mask[None, None], logits, -jnp.inf)
        p = jax.nn.softmax(logits, axis=-1)
        return jnp.einsum('bhqk,bkhd->bqhd', p, v32)

    out = lax.map(one_block, (qb, cb, starts))
    out = jnp.transpose(out, (1, 0, 2, 3, 4)).reshape(B, S, H * dh)
    return out.astype(q.dtype)


def mixer_sublayer(h, w_in, b_f, pool_w, pool_scale, sg_ln_g, sg_ln_b, sg_w, sg_b,
                   conv_w, conv_b, conv_ln_g, conv_ln_b, w_branch, w_out):
    B, S, D = h.shape
    proj = jnp.einsum('bsd,dc->bsc', h, w_in)
    z_pool, z_sg, z_conv, q, k, v, f_logit, gate_cols = jnp.split(proj, COL_SPLITS, axis=-1)
    y_a = multiscale_pool(z_pool, pool_w, pool_scale)
    y_b = spatial_gating(z_sg, sg_ln_g, sg_ln_b, sg_w, sg_b)
    y_c = conformer_conv(z_conv, conv_w, conv_b, conv_ln_g, conv_ln_b)
    y_d = forgetting_attention(q.reshape(B, S, ATT_HEADS, ATT_HD),
                               k.reshape(B, S, ATT_HEADS, ATT_HD),
                               v.reshape(B, S, ATT_HEADS, ATT_HD),
                               f_logit + b_f)
    ys = jnp.stack([y_a, y_b, y_c, y_d.astype(y_a.dtype)], axis=2)
    branch = jnp.einsum('bsnc,ncd->bsnd', ys, w_branch)
    gates = jax.nn.sigmoid(gate_cols).reshape(B, S, N_BRANCH, D)
    merged = jnp.sum(gates * branch, axis=2)
    return jnp.einsum('bsd,de->bse', merged, w_out)


def moe_ffn(h, router_w, router_bias, w1, w3, w2, sw1, sw3, sw2):
    B, S, D = h.shape
    T = B * S
    t = h.reshape(T, D)
    scores = jax.nn.sigmoid(jnp.einsum('td,de->te', t, router_w).astype(jnp.float32))
    sel = scores + router_bias.astype(jnp.float32)
    grouped = sel.reshape(T, N_GROUPS, N_EXPERTS // N_GROUPS)
    group_score = jnp.sum(lax.top_k(grouped, 2)[0], axis=-1)
    _, gidx = lax.top_k(group_score, TOPK_GROUPS)
    gmask = jnp.sum(jax.nn.one_hot(gidx, N_GROUPS, dtype=jnp.float32), axis=1) > 0
    emask = jnp.repeat(gmask, N_EXPERTS // N_GROUPS, axis=1)
    _, eidx = lax.top_k(jnp.where(emask, sel, -jnp.inf), TOP_K)
    w = jnp.take_along_axis(scores, eidx, axis=1)
    w = w / jnp.sum(w, axis=-1, keepdims=True) * ROUTE_SCALE
    dense_gates = jnp.sum(jax.nn.one_hot(eidx, N_EXPERTS, dtype=jnp.float32) * w[..., None], axis=1)
    nchunk = T // MOE_CHUNK

    def chunk_fn(args):
        tc, gc = args
        a = jnp.einsum('td,edf->tef', tc, w1)
        b = jnp.einsum('td,edf->tef', tc, w3)
        hid = jax.nn.silu(a) * b * gc[:, :, None].astype(tc.dtype)
        return jnp.einsum('tef,efd->td', hid, w2)

    routed = lax.map(chunk_fn, (t.reshape(nchunk, MOE_CHUNK, D),
                                dense_gates.reshape(nchunk, MOE_CHUNK, N_EXPERTS))).reshape(T, D)
    shared = jnp.einsum('tf,fd->td', jax.nn.silu(t @ sw1) * (t @ sw3), sw2)
    return (routed + shared).reshape(B, S, D)


def setup_inputs(seed: int = 0) -> dict:
    key = jax.random.key(seed)
    ks = jax.random.split(key, 32)
    f32 = jnp.float32
    n = lambda i, shape: jax.random.normal(ks[i], shape, dtype=f32)
    L, D, E = DEPTH, D_MODEL, N_EXPERTS
    return {
        "x": n(0, (BATCH, SEQ, D)),
        "c": n(1, (BATCH, D)),
        "w_in": n(2, (L, D, COL_TOTAL)) * D ** -0.5,
        "b_f": 3.0 + 0.5 * n(3, (L, ATT_HEADS)),
        "pool_w": n(4, (L, POOL_GROUPS, POOL_GW, POOL_GW)) * POOL_GW ** -0.5,
        "pool_scale": 1.0 + 0.1 * n(5, (L, BRANCH_W)),
        "sg_ln_g": 1.0 + 0.1 * n(6, (L, BRANCH_W)),
        "sg_ln_b": 0.02 * n(7, (L, BRANCH_W)),
        "sg_w": n(8, (L, SG_HEADS, SG_CHUNK, SG_CHUNK)) * (0.5 * SG_CHUNK ** -0.5),
        "sg_b": 1.0 + 0.1 * n(9, (L, SG_HEADS, SG_CHUNK)),
        "conv_w": n(10, (L, CONV_WIDTH, BRANCH_W)) * CONV_WIDTH ** -0.5,
        "conv_b": 0.02 * n(11, (L, BRANCH_W)),
        "conv_ln_g": 1.0 + 0.1 * n(12, (L, BRANCH_W)),
        "conv_ln_b": 0.02 * n(13, (L, BRANCH_W)),
        "w_branch": n(14, (L, N_BRANCH, BRANCH_W, D)) * BRANCH_W ** -0.5,
        "w_out": n(15, (L, D, D)) * D ** -0.5,
        "mix_norm_g": 1.0 + 0.1 * n(16, (L, D)),
        "ffn_norm_g": 1.0 + 0.1 * n(17, (L, D)),
        "ada_w": n(18, (L, D, N_MOD * D)) * (0.5 * D ** -0.5),
        "ada_b": 0.02 * n(19, (L, N_MOD * D)),
        "router_w": n(20, (L, D, E)) * D ** -0.5,
        "router_bias": 0.01 * n(21, (L, E)),
        "exp_w1": n(22, (L, E, D, EXPERT_FF)) * D ** -0.5,
        "exp_w3": n(23, (L, E, D, EXPERT_FF)) * D ** -0.5,
        "exp_w2": n(24, (L, E, EXPERT_FF, D)) * EXPERT_FF ** -0.5,
        "shared_w1": n(25, (L, D, SHARED_FF)) * D ** -0.5,
        "shared_w3": n(26, (L, D, SHARED_FF)) * D ** -0.5,
        "shared_w2": n(27, (L, SHARED_FF, D)) * SHARED_FF ** -0.5,
        "final_norm_g": 1.0 + 0.1 * n(28, (D,)),
    }


def reference(x, c, w_in, b_f, pool_w, pool_scale, sg_ln_g, sg_ln_b, sg_w, sg_b,
              conv_w, conv_b, conv_ln_g, conv_ln_b, w_branch, w_out, mix_norm_g, ffn_norm_g,
              ada_w, ada_b, router_w, router_bias, exp_w1, exp_w3, exp_w2,
              shared_w1, shared_w3, shared_w2, final_norm_g):
    B = x.shape[0]
    c_act = jax.nn.silu(c)
    for l in range(DEPTH):
        mod = (c_act @ ada_w[l] + ada_b[l]).reshape(B, N_MOD, D_MODEL)
        shift_m, scale_m, gate_m = mod[:, 0, None], mod[:, 1, None], mod[:, 2, None]
        shift_f, scale_f, gate_f = mod[:, 3, None], mod[:, 4, None], mod[:, 5, None]
        h = rms_norm(x, mix_norm_g[l]) * (1.0 + scale_m) + shift_m
        mix = mixer_sublayer(h, w_in[l], b_f[l], pool_w[l], pool_scale[l], sg_ln_g[l], sg_ln_b[l],
                             sg_w[l], sg_b[l], conv_w[l], conv_b[l], conv_ln_g[l], conv_ln_b[l],
                             w_branch[l], w_out[l])
        x = x + gate_m * mix
        h = rms_norm(x, ffn_norm_g[l]) * (1.0 + scale_f) + shift_f
        ffn = moe_ffn(h, router_w[l], router_bias[l], exp_w1[l], exp_w3[l], exp_w2[l],
                      shared_w1[l], shared_w3[l], shared_w2[l])
        x = x + gate_f * ffn
    return rms_norm(x, final_norm_g)
```

```cpp
#include <hip/hip_runtime.h>
#include <cstdio>
#include <cstdint>
#include <cstring>

#ifndef MK_ONE_LAUNCH
#define MK_ONE_LAUNCH 0
#endif

#define LAS __attribute__((address_space(3)))
#define TIDX (g_wave * 64 + lane_id())
#define GAS __attribute__((address_space(1)))
typedef unsigned short bf16_t;
typedef short bf16x8 __attribute__((ext_vector_type(8)));
typedef float f32x4 __attribute__((ext_vector_type(4)));
typedef float f32x2 __attribute__((ext_vector_type(2)));
typedef unsigned u32x4 __attribute__((ext_vector_type(4)));
typedef unsigned u32x2 __attribute__((ext_vector_type(2)));
typedef int i32x4 __attribute__((ext_vector_type(4)));

constexpr int NB = 2, SEQ = 8192, M = NB * SEQ, D = 1024, NL = 2;
constexpr int COLT = 6148;
constexpr int NE = 64, TOPK = 6, EFF = 256;
constexpr int NPAIR = M * TOPK;
constexpr float EPS = 1e-6f;
constexpr float LOG2E = 1.4426950408889634f;
constexpr float QSCALE = 0.125f * LOG2E;
constexpr int NWAVES = 8, NTHREADS = 512;

constexpr size_t MiB = 1u << 20;
constexpr size_t WS_CTL = 0;
constexpr size_t CTL_ZERO_BYTES = 1 * MiB;
constexpr size_t WS_SMALL = 1 * MiB;
constexpr size_t WS_WB = 16 * MiB;
constexpr size_t WS_X = 130 * MiB;
constexpr size_t WS_H = 194 * MiB;
constexpr size_t WS_YS = 226 * MiB;
constexpr size_t WS_MRG = 258 * MiB;
constexpr size_t WS_HID = 290 * MiB;
constexpr size_t WS_R1 = 346 * MiB;
constexpr size_t WS_END = 538 * MiB;
constexpr size_t WB_WIN = 0;
constexpr size_t WB_WBR = WB_WIN + (size_t)6144 * 1024;
constexpr size_t WB_WOUT = WB_WBR + (size_t)4 * 1024 * 256;
constexpr size_t WB_WR = WB_WOUT + (size_t)1024 * 1024;
constexpr size_t WB_W13 = WB_WR + (size_t)256 * 1024;
constexpr size_t WB_W2 = WB_W13 + (size_t)65 * 512 * 1024;
constexpr size_t WB_ELEMS = WB_W2 + (size_t)65 * 1024 * 256;
static_assert(WB_ELEMS * 2 <= 114 * MiB, "weights region");
constexpr size_t SM_MOD = 0;
constexpr size_t SM_LOGF = 128 * 1024;
constexpr size_t SM_CUM = SM_LOGF + (size_t)M * 16;
constexpr size_t SM_CB = SM_CUM + (size_t)8 * SEQ * 4;
constexpr size_t SM_RLOG = SM_CB + (size_t)8 * SEQ * 16;
constexpr size_t SM_TE = SM_RLOG + (size_t)M * 64 * 4;
constexpr size_t SM_TW = SM_TE + (size_t)NPAIR * 4;
constexpr size_t SM_TP = SM_TW + (size_t)NPAIR * 4;
constexpr size_t SM_SLOT = SM_TP + (size_t)NPAIR * 4;
constexpr size_t SM_IDX = SM_SLOT + (size_t)NPAIR * 4;
constexpr size_t SM_GW = SM_IDX + (size_t)(NPAIR + 64 * 256) * 4;
constexpr size_t SM_END = SM_GW + (size_t)NPAIR * 4;
static_assert(SM_END <= 15 * MiB, "small region");
constexpr int CW_BAR = 4096;
constexpr int CW_CNT = 16384;

constexpr int RING_BYTES = 131072;
constexpr int LDSCTL_OFF = RING_BYTES;
constexpr int MISC_OFF = LDSCTL_OFF;
constexpr int TL_OFF = LDSCTL_OFF + 256;
constexpr int TLN_OFF = TL_OFF + 512 * 16;
constexpr int EOFF_OFF = TLN_OFF + 16;
constexpr int PTRS_OFF = EOFF_OFF + 3 * 64 * 4;
constexpr int LDS_BYTES = 147456;
static_assert(PTRS_OFF + 32 * 8 <= LDS_BYTES, "LDS map");

__device__ __forceinline__ int lane_id() { int r; asm volatile("v_mbcnt_lo_u32_b32 %0, -1, 0\n\tv_mbcnt_hi_u32_b32 %0, -1, %0" : "=v"(r)); return r; }
__device__ __forceinline__ int opaque(int v) { asm volatile("" : "+v"(v)); return v; }
#define LDS_WAIT() asm volatile("s_waitcnt lgkmcnt(0)" ::: "memory")
#define VM_WAIT() asm volatile("s_waitcnt vmcnt(0)" ::: "memory")
__device__ __forceinline__ unsigned cvt_pk_bf16(float lo, float hi) { unsigned r; asm volatile("v_cvt_pk_bf16_f32 %0, %1, %2" : "=v"(r) : "v"(lo), "v"(hi)); return r; }
__device__ __forceinline__ float bflo(unsigned w) { return __uint_as_float(w << 16); }
__device__ __forceinline__ float bfhi(unsigned w) { return __uint_as_float(w & 0xffff0000u); }
__device__ __forceinline__ float bf2f(bf16_t h) { return __uint_as_float((unsigned)h << 16); }
__device__ __forceinline__ bf16_t f2bf(float f) { return (bf16_t)(cvt_pk_bf16(f, 0.f) & 0xffffu); }
__device__ __forceinline__ float wave_sum(float v) {
#pragma unroll
    for (int o = 1; o < 64; o <<= 1) v += __shfl_xor(v, o);
    return v;
}
__device__ __forceinline__ float fexp2(float x) { return __builtin_amdgcn_exp2f(x); }
__device__ __forceinline__ float frcp(float x) { return __builtin_amdgcn_rcpf(x); }
__device__ __forceinline__ float sigmoidf_(float x) { return frcp(1.f + fexp2(-LOG2E * x)); }
__device__ __forceinline__ float siluf_(float x) { return x * sigmoidf_(x); }
__device__ __forceinline__ float gelu_tanh(float x) {
    const float u = x + 0.044715f * x * x * x;
    return x * frcp(1.f + fexp2(-2.f * 0.7978845608028654f * LOG2E * u));
}

namespace pg8 {
constexpr int BM = 256, BK = 64, HALF = 128, HTB = HALF * BK * 2, STAGE_BYTES = 8 * HTB, NXCD = 8, WGM = 8;
__host__ __device__ __forceinline__ int lds_byte(int r, int c) { const int st = (r >> 4) * 2 + (c >> 5), rr = r & 15, cc = c & 31, ob = rr * 64 + cc * 2; return st * 1024 + (ob ^ (((ob >> 9) & 1) << 5)); }
__host__ __device__ __forceinline__ void stage_rc(int b, int& R, int& C) { const int st = b / 1024, sb = b % 1024, swz = sb ^ (((sb >> 9) & 1) << 5); R = (st >> 1) * 16 + swz / 64; C = (st & 1) * 32 + (swz % 64) / 2; }
__host__ __device__ __forceinline__ int perm32(int rho) { const int n = rho >> 4, i = rho & 15; return 8 * (i >> 2) + 4 * n + (i & 3); }

struct Unit { int pm, pn; int a, b, c, e; size_t aoff, boff; };
struct Gemm { const bf16_t* A; const bf16_t* Bt; int lda, ldb, K; const int* idx; };

__device__ __forceinline__ bool static_tile(int i, int G, int c, int nM, int nN, int& pm, int& pn) {
    const int nwg = nM * nN; const long L = (long)i * G + c; if (L >= nwg) return false;
    int wgid = (int)L; { const int q = nwg / NXCD, r = nwg % NXCD, xcd = wgid % NXCD, off = wgid / NXCD; wgid = (xcd < r ? xcd * (q + 1) : r * (q + 1) + (xcd - r) * q) + off; }
    const int nig = WGM * nN, gid = wgid / nig, fm = gid * WGM, gsz = (nM - fm) < WGM ? (nM - fm) : WGM;
    pm = fm + ((wgid % nig) % gsz); pn = (wgid % nig) / gsz; return true;
}

template <class Epi, class Sched, bool GATHER = false>
__device__ __forceinline__ void gemm_phase(LAS unsigned char* lds, const Gemm g, const Sched& S, const Epi& E, const int g_wave) {
    const int tid = TIDX, wid = __builtin_amdgcn_readfirstlane(tid >> 6), lane = tid & 63, wr = wid >> 2, wc = wid & 3, fr = lane & 15, fq = lane >> 4;
    const int K = g.K, nt = K / BK;
    unsigned voffA[2], voffB[2]; int RA[2], CA[2];
#pragma unroll
    for (int i = 0; i < 2; ++i) { int R, C; stage_rc(tid * 16 + i * 8192, R, C); const int Rb = Epi::PERM ? ((R & ~31) + perm32(R & 31)) : R;
        RA[i] = R; CA[i] = C; voffA[i] = (unsigned)(R * g.lda + C) * 2u; voffB[i] = (unsigned)(Rb * g.ldb + C) * 2u; }
    const size_t kstep = (size_t)(BK * 2);
    const size_t hstepA = GATHER ? 0 : (size_t)HALF * g.lda * 2, hstepB = (size_t)HALF * g.ldb * 2;
    const unsigned ldsw = (unsigned)wid * 1024u;
    const int aoff = lds_byte(wr * 64 + fr, fq * 8), boff = lds_byte(wc * 32 + fr, fq * 8);
    unsigned vC[2][2], vN[2][2];
#define PG8_SA(b, h) (((b) * 2 + (h)) * HTB)
#define PG8_SB(b, h) ((4 + (b) * 2 + (h)) * HTB)
#define PG8_STAGE(bufoff, gbase, voff) do { _Pragma("unroll") for (int _i = 0; _i < 2; ++_i) \
        __builtin_amdgcn_global_load_lds((const unsigned*)((const char*)(gbase) + (voff)[_i]), (LAS unsigned*)(lds + (bufoff) + ldsw + _i * 8192), 16, 0, 0); } while (0)
#define PG8_STAGEA(bufoff, p, h, nx) do { if constexpr (GATHER) { unsigned _v[2]; _v[0] = (nx) ? vN[h][0] : vC[h][0]; _v[1] = (nx) ? vN[h][1] : vC[h][1]; PG8_STAGE(bufoff, p, _v); } \
        else { PG8_STAGE(bufoff, (p) + (h) * hstepA, voffA); } } while (0)
#define PG8_LDA(dst, b, h) do { _Pragma("unroll") for (int m = 0; m < 4; ++m) _Pragma("unroll") for (int k = 0; k < 2; ++k) dst[m][k] = *(const LAS bf16x8*)(lds + PG8_SA(b, h) + aoff + m * 2048 + k * 1024); } while (0)
#define PG8_LDB(dst, b, h) do { _Pragma("unroll") for (int n = 0; n < 2; ++n) _Pragma("unroll") for (int k = 0; k < 2; ++k) dst[n][k] = *(const LAS bf16x8*)(lds + PG8_SB(b, h) + boff + n * 2048 + k * 1024); } while (0)
#define PG8_MMA(ai, bj, At, Bt) do { __builtin_amdgcn_s_setprio(1); _Pragma("unroll") for (int m = 0; m < 4; ++m) _Pragma("unroll") for (int n = 0; n < 2; ++n) _Pragma("unroll") for (int k = 0; k < 2; ++k) \
        acc[ai][bj][m][n] = __builtin_amdgcn_mfma_f32_16x16x32_bf16(Bt[n][k], At[m][k], acc[ai][bj][m][n], 0, 0, 0); __builtin_amdgcn_s_setprio(0); } while (0)
#define PG8_WAIT_V(n) asm volatile("s_waitcnt vmcnt(" #n ")" ::: "memory")
#define PG8_WAIT_L(n) asm volatile("s_waitcnt lgkmcnt(" #n ")" ::: "memory")
#define PG8_BAR __builtin_amdgcn_s_barrier()
#define PG8_SCHED __builtin_amdgcn_sched_barrier(0)
#define PG8_GLOAD(dst, U) do { _Pragma("unroll") for (int _h = 0; _h < 2; ++_h) _Pragma("unroll") for (int _i = 0; _i < 2; ++_i) { \
        const int _row = g.idx[(U).c + _h * HALF + RA[_i]]; dst[_h][_i] = (unsigned)(_row * g.lda + CA[_i]) * 2u; } } while (0)
    Unit cur, nxt; int ui = 0;
    if (!S.next(0, cur)) return;
    f32x4 acc[2][2][4][2];
#pragma unroll
    for (int a = 0; a < 2; ++a)
#pragma unroll
        for (int b = 0; b < 2; ++b)
#pragma unroll
            for (int m = 0; m < 4; ++m)
#pragma unroll
                for (int n = 0; n < 2; ++n) acc[a][b][m][n] = (f32x4){0.f, 0.f, 0.f, 0.f};
    bf16x8 At[4][2], B0[2][2], B1[2][2];
    const char* cA = (const char*)g.A + cur.aoff; const char* cB = (const char*)g.Bt + cur.boff;
    if constexpr (GATHER) { PG8_GLOAD(vC, cur); PG8_GLOAD(vN, cur); }
    PG8_STAGE(PG8_SB(0, 0), cB, voffB); PG8_STAGE(PG8_SB(0, 1), cB + hstepB, voffB); PG8_STAGEA(PG8_SA(0, 0), cA, 0, false); PG8_STAGEA(PG8_SA(0, 1), cA, 1, false);
    if (wr == 1) PG8_BAR;
    PG8_WAIT_V(2); PG8_BAR;
    PG8_STAGE(PG8_SB(1, 0), cB + kstep, voffB); PG8_STAGEA(PG8_SA(1, 0), cA + kstep, 0, false); PG8_STAGE(PG8_SB(1, 1), cB + hstepB + kstep, voffB);
    PG8_WAIT_V(6); PG8_BAR;
    for (;;) {
        const bool has_next = S.next(ui + 1, nxt);
        const char* nA = has_next ? (const char*)g.A + nxt.aoff : cA; const char* nB = has_next ? (const char*)g.Bt + nxt.boff : cB;
        if constexpr (GATHER) { if (has_next) { PG8_GLOAD(vN, nxt); } else { vN[0][0] = vC[0][0]; vN[0][1] = vC[0][1]; vN[1][0] = vC[1][0]; vN[1][1] = vC[1][1]; }
            asm volatile("s_waitcnt vmcnt(0)" : "+v"(vN[0][0]), "+v"(vN[0][1]), "+v"(vN[1][0]), "+v"(vN[1][1]) :: "memory"); }
#pragma unroll 1
        for (int t = 0; t < nt; t += 2) {
            const bool last = (t == nt - 2);
            const char* a1 = cA + (size_t)(t + 1) * kstep;
            const char* a2 = last ? nA : cA + (size_t)(t + 2) * kstep; const char* b2 = last ? nB : cB + (size_t)(t + 2) * kstep;
            const char* a3 = a2 + kstep; const char* b3 = b2 + kstep;
            PG8_LDB(B0, 0, 0); PG8_LDB(B1, 0, 1); PG8_SCHED; PG8_LDA(At, 0, 0); PG8_STAGEA(PG8_SA(1, 1), a1, 1, false);
            PG8_WAIT_V(8); PG8_WAIT_L(0); PG8_BAR; PG8_MMA(0, 0, At, B0); PG8_MMA(0, 1, At, B1); PG8_BAR; PG8_SCHED;
            PG8_LDA(At, 0, 1); PG8_STAGE(PG8_SB(0, 0), b2, voffB); PG8_STAGE(PG8_SB(0, 1), b2 + hstepB, voffB); PG8_STAGEA(PG8_SA(0, 0), a2, 0, last);
            PG8_WAIT_V(8); PG8_WAIT_L(0); PG8_BAR; PG8_MMA(1, 0, At, B0); PG8_MMA(1, 1, At, B1); PG8_BAR; PG8_SCHED;
            PG8_LDB(B0, 1, 0); PG8_LDB(B1, 1, 1); PG8_SCHED; PG8_LDA(At, 1, 0); PG8_STAGEA(PG8_SA(0, 1), a2, 1, last);
            PG8_WAIT_V(8); PG8_WAIT_L(0); PG8_BAR; PG8_MMA(0, 0, At, B0); PG8_MMA(0, 1, At, B1); PG8_BAR; PG8_SCHED;
            PG8_LDA(At, 1, 1); PG8_STAGE(PG8_SB(1, 0), b3, voffB); PG8_STAGE(PG8_SB(1, 1), b3 + hstepB, voffB); PG8_STAGEA(PG8_SA(1, 0), a3, 0, last);
            PG8_WAIT_V(8); PG8_WAIT_L(0); PG8_BAR; PG8_MMA(1, 0, At, B0); PG8_MMA(1, 1, At, B1); PG8_BAR; PG8_SCHED;
        }
        if (wr == 0) PG8_BAR;
        E(acc, cur, wr, wc, fr, fq);
        if (!has_next) break;
#pragma unroll
        for (int a = 0; a < 2; ++a)
#pragma unroll
            for (int b = 0; b < 2; ++b)
#pragma unroll
                for (int m = 0; m < 4; ++m)
#pragma unroll
                    for (int n = 0; n < 2; ++n) acc[a][b][m][n] = (f32x4){0.f, 0.f, 0.f, 0.f};
        cur = nxt; cA = nA; cB = nB; ++ui;
        if constexpr (GATHER) { vC[0][0] = vN[0][0]; vC[0][1] = vN[0][1]; vC[1][0] = vN[1][0]; vC[1][1] = vN[1][1]; }
        if (wr == 1) PG8_BAR;
    }
    PG8_WAIT_V(0);
    PG8_BAR;
#undef PG8_SA
#undef PG8_SB
#undef PG8_STAGE
#undef PG8_STAGEA
#undef PG8_LDA
#undef PG8_LDB
#undef PG8_MMA
#undef PG8_WAIT_V
#undef PG8_WAIT_L
#undef PG8_BAR
#undef PG8_SCHED
#undef PG8_GLOAD
}
}

#define XB_TMO      128
#define XB_XCNT(j)  (256  + 64 * (j))
#define XB_XSUB(j)  (1280 + 64 * (j))
#define XB_XGEN(j)  (2304 + 64 * (j))
#define XB_TOP      3328
#define XB_TOPGEN   3392
#define XCD_BAR_WORDS 3456
#define XB_SPIN_CAP (1u << 18)
__device__ __forceinline__ unsigned xb_ld(unsigned* p)              { return __hip_atomic_load(p, __ATOMIC_RELAXED, __HIP_MEMORY_SCOPE_AGENT); }
__device__ __forceinline__ unsigned xb_add(unsigned* p, unsigned v) { return __hip_atomic_fetch_add(p, v, __ATOMIC_RELAXED, __HIP_MEMORY_SCOPE_AGENT); }
__device__ __forceinline__ unsigned xb_xcc_id() { return (unsigned)__builtin_amdgcn_s_getreg((3 << 11) | 20) & 0xFu; }
#define XB_SPIN(cond, bar) do { unsigned _sp = 0; while (cond) { __builtin_amdgcn_s_sleep(1); \
    if ((++_sp & 255u) == 0u) { if (xb_ld(&(bar)[XB_TMO])) break; if (_sp > XB_SPIN_CAP) { atomicAdd(&(bar)[XB_TMO], 1u); break; } } } } while (0)
struct XcdBarrier { unsigned* bar; unsigned x; volatile LAS unsigned* st; };
__device__ __forceinline__ XcdBarrier xcd_barrier_post(unsigned* bar, volatile LAS unsigned* st, const int g_wave) {
    XcdBarrier b; b.bar = bar; b.x = xb_xcc_id(); b.st = st;
    if (TIDX == 0) (void)xb_add(&bar[XB_XCNT(b.x)], 1u);
    return b;
}
__device__ __forceinline__ void xcd_barrier_complete(unsigned* bar, unsigned x, unsigned& nloc, unsigned& nx) {
    const unsigned G = gridDim.x * gridDim.y * gridDim.z;
    unsigned sum, cnt, mine, sp = 0u;
    for (;;) {
        sum = 0u; cnt = 0u; mine = 0u;
#pragma unroll
        for (unsigned j = 0; j < 16; ++j) { const unsigned c = xb_ld(&bar[XB_XCNT(j)]); sum += c; cnt += (c > 0u) ? 1u : 0u; mine = (j == x) ? c : mine; }
        if (sum == G) break;
        __builtin_amdgcn_s_sleep(1);
        if ((++sp & 255u) == 0u) { if (xb_ld(&bar[XB_TMO])) break; if (sp > XB_SPIN_CAP) { atomicAdd(&bar[XB_TMO], 1u); break; } }
    }
    nloc = mine > 0u ? mine : 1u; nx = cnt > 0u ? cnt : 1u;
}
__device__ __forceinline__ void xcd_barrier(const XcdBarrier& b, const int g_wave) {
    asm volatile("s_waitcnt vmcnt(0)" ::: "memory");
    __syncthreads();
    if (TIDX == 0) {
        unsigned* bar = b.bar;
        __builtin_amdgcn_s_waitcnt(0);
        unsigned nloc = b.st[0], nx = b.st[1];
        if (nloc == 0u) { xcd_barrier_complete(bar, b.x, nloc, nx); b.st[0] = nloc; b.st[1] = nx; }
        const unsigned old = xb_add(&bar[XB_XSUB(b.x)], 1u);
        const unsigned gen = old / nloc;
        if (old + 1u == (gen + 1u) * nloc) {
            __builtin_amdgcn_fence(__ATOMIC_RELEASE, "agent");
            asm volatile("s_waitcnt vmcnt(0)" ::: "memory");
            const unsigned og = xb_add(&bar[XB_TOP], 1u);
            const unsigned tg = og / nx;
            if (og + 1u == (tg + 1u) * nx) xb_add(&bar[XB_TOPGEN], 1u);
            else XB_SPIN(xb_ld(&bar[XB_TOPGEN]) == tg, bar);
            __builtin_amdgcn_fence(__ATOMIC_ACQUIRE, "agent");
            xb_add(&bar[XB_XGEN(b.x)], 1u);
            asm volatile("s_waitcnt vmcnt(0)" ::: "memory");
        } else {
            XB_SPIN(xb_ld(&bar[XB_XGEN(b.x)]) == gen, bar);
            __builtin_amdgcn_fence(__ATOMIC_ACQUIRE, "agent");
            asm volatile("s_waitcnt vmcnt(0)" ::: "memory");
        }
    }
    __syncthreads();
}

struct Params { const float* in[29]; float* out; unsigned char* ws; int ph_lo, ph_hi; };
extern __shared__ __attribute__((aligned(16))) unsigned char lds_raw[];
__device__ __forceinline__ const float* inptr(int i) { u32x2 v = *(const LAS u32x2*)((LAS unsigned char*)lds_raw + PTRS_OFF + 8 * i); asm volatile("" : "+v"(v));
    return (const float*)(((unsigned long long)(unsigned)__builtin_amdgcn_readfirstlane((int)v.y) << 32) | (unsigned long long)(unsigned)__builtin_amdgcn_readfirstlane((int)v.x)); }
__device__ __forceinline__ unsigned char* wsptr(const Params& P) { unsigned char* p = P.ws; asm volatile("" : "+s"(p)); return p; }
enum { I_X = 0, I_C, I_WIN, I_BF, I_POOLW, I_POOLS, I_SGLG, I_SGLB, I_SGW, I_SGB, I_CONVW, I_CONVB, I_CLG, I_CLB, I_WBR, I_WOUT, I_MNG, I_FNG, I_ADAW, I_ADAB,
       I_RW, I_RB, I_EW1, I_EW3, I_EW2, I_SW1, I_SW3, I_SW2, I_FING };

__device__ __forceinline__ void phase_ada(const Params& P, LAS unsigned char* lds, int bid, int G, const int g_wave) {
    const int tid = TIDX, lane = tid & 63, wave = tid >> 6;
    LAS float* sc = (LAS float*)lds; LAS float* red = (LAS float*)(lds + 8192);
    const float* c = inptr(I_C); float* MOD = (float*)(wsptr(P) + WS_SMALL + SM_MOD);
    for (int i = tid; i < 2048; i += NTHREADS) { const float v = c[i]; sc[i] = v / (1.f + __expf(-v)); }
    __syncthreads();
    for (int ch = bid; ch < 192; ch += G) {
        const int l = ch / 96, n0 = (ch % 96) * 64;
        const float* W = inptr(I_ADAW) + (size_t)l * 1024 * 6144 + n0 + lane;
        float a0 = 0.f, a1 = 0.f;
#pragma unroll 16
        for (int k = 0; k < 128; ++k) { const int kk = wave * 128 + k; const float w = W[(size_t)kk * 6144]; a0 += sc[kk] * w; a1 += sc[1024 + kk] * w; }
        red[(wave * 2 + 0) * 64 + lane] = a0; red[(wave * 2 + 1) * 64 + lane] = a1;
        __syncthreads();
        if (tid < 128) { const int b = tid >> 6; float s = 0.f;
#pragma unroll
            for (int w = 0; w < 8; ++w) s += red[(w * 2 + b) * 64 + lane];
            MOD[(size_t)(l * 2 + b) * 6144 + n0 + lane] = s + inptr(I_ADAB)[l * 6144 + n0 + lane]; }
        __syncthreads();
    }
}

__device__ __forceinline__ void cvt_item(const float* __restrict__ src, int ldw, bf16_t* __restrict__ dst, int ldd, LAS unsigned* T, int lane) {
    const int kp = lane >> 4, ng = lane & 15;
    f32x4 v[16];
#pragma unroll
    for (int j = 0; j < 8; ++j)
#pragma unroll
        for (int h = 0; h < 2; ++h) v[2 * j + h] = *(const f32x4*)(src + (size_t)(8 * j + 2 * kp + h) * ldw + 4 * ng);
#pragma unroll
    for (int j = 0; j < 8; ++j)
#pragma unroll
        for (int i = 0; i < 4; ++i) T[(4 * ng + i) * 33 + 4 * j + kp] = cvt_pk_bf16(v[2 * j][i], v[2 * j + 1][i]);
    LDS_WAIT();
#pragma unroll 8
    for (int s = 0; s < 32; ++s) { const int n = 2 * s + (lane >> 5), kd = lane & 31; ((unsigned*)(dst + (size_t)n * ldd))[kd] = T[n * 33 + kd]; }
    LDS_WAIT();
}
__device__ __forceinline__ void phase_convert(const Params& P, LAS unsigned char* lds, int l, int gw, int NGW, const int g_wave) {
    const int tid_ = TIDX, lane = tid_ & 63, wave = tid_ >> 6;
    LAS unsigned* T = (LAS unsigned*)(lds + wave * 8448);
    bf16_t* WB = (bf16_t*)(wsptr(P) + WS_WB);
    constexpr int C0 = 512, C1 = 1024, C2 = 256, C3 = 256, C4 = 16, C5 = 65 * 64, C6 = 65 * 64, C7 = 65 * 64;
    constexpr int NITEMS = C0 + C1 + C2 + C3 + C4 + C5 + C6 + C7;
    for (int it = gw; it < NITEMS; it += NGW) {
        int r = it;
        if (r < C0) { const int nb = r & 31, kb = r >> 5; cvt_item(inptr(I_WIN) + (size_t)l * 1024 * COLT + (size_t)kb * 64 * COLT + 64 * nb, COLT, WB + WB_WIN + (size_t)(64 * nb) * 1024 + kb * 64, 1024, T, lane); continue; } r -= C0;
        if (r < C1) { const int nb = r & 63, kb = r >> 6; cvt_item(inptr(I_WIN) + (size_t)l * 1024 * COLT + (size_t)kb * 64 * COLT + 2052 + 64 * nb, COLT, WB + WB_WIN + (size_t)(2048 + 64 * nb) * 1024 + kb * 64, 1024, T, lane); continue; } r -= C1;
        if (r < C2) { const int nb = r & 15, kb = (r >> 4) & 3, n = r >> 6; cvt_item(inptr(I_WBR) + (size_t)(l * 4 + n) * 256 * 1024 + (size_t)kb * 64 * 1024 + 64 * nb, 1024, WB + WB_WBR + (size_t)(n * 1024 + 64 * nb) * 256 + kb * 64, 256, T, lane); continue; } r -= C2;
        if (r < C3) { const int nb = r & 15, kb = r >> 4; cvt_item(inptr(I_WOUT) + (size_t)l * 1024 * 1024 + (size_t)kb * 64 * 1024 + 64 * nb, 1024, WB + WB_WOUT + (size_t)(64 * nb) * 1024 + kb * 64, 1024, T, lane); continue; } r -= C3;
        if (r < C4) { const int kb = r; cvt_item(inptr(I_RW) + (size_t)l * 1024 * 64 + (size_t)kb * 64 * 64, 64, WB + WB_WR + kb * 64, 1024, T, lane); continue; } r -= C4;
        if (r < C5 + C6) { const int w3 = r >= C5; if (w3) r -= C5; const int nb = r & 3, kb = (r >> 2) & 15, e = r >> 6;
            const float* src = (e < 64) ? P.in[w3 ? I_EW3 : I_EW1] + ((size_t)(l * 64 + e)) * 1024 * 256 : P.in[w3 ? I_SW3 : I_SW1] + (size_t)l * 1024 * 256;
            cvt_item(src + (size_t)kb * 64 * 256 + 64 * nb, 256, WB + WB_W13 + ((size_t)e * 512 + (nb >> 1) * 256 + w3 * 128 + (nb & 1) * 64) * 1024 + kb * 64, 1024, T, lane); continue; } r -= C5 + C6;
        { const int nb = r & 15, kb = (r >> 4) & 3, e = r >> 6;
            const float* src = (e < 64) ? inptr(I_EW2) + ((size_t)(l * 64 + e)) * 256 * 1024 : inptr(I_SW2) + (size_t)l * 256 * 1024;
            cvt_item(src + (size_t)kb * 64 * 1024 + 64 * nb, 1024, WB + WB_W2 + ((size_t)e * 1024 + 64 * nb) * 256 + kb * 64, 256, T, lane); }
    }
    { u32x4* z = (u32x4*)(WB + WB_WR + 64 * 1024); const int gt = gw * 64 + lane, NT = NGW * 64;
      for (int i = gt; i < 192 * 1024 * 2 / 16; i += NT) z[i] = (u32x4){0u, 0u, 0u, 0u}; }
}

template <int MODE>
__device__ __forceinline__ void phase_norm1(const Params& P, LAS unsigned char* lds, int l, int gw, int NGW, const int g_wave) {
    const int tid = TIDX, lane = tid & 63;
    const float* MOD = (const float*)(wsptr(P) + WS_SMALL + SM_MOD);
    float* X = (float*)(wsptr(P) + WS_X); bf16_t* H = (bf16_t*)(wsptr(P) + WS_H);
    LAS f32x4* wf = (LAS f32x4*)lds;
    if (MODE != 2) {
        const float* win = inptr(I_WIN) + (size_t)l * 1024 * COLT + 2048;
        for (int d = tid; d < 1024; d += NTHREADS) wf[d] = *(const f32x4*)(win + (size_t)d * COLT);
        __syncthreads();
    }
    const int* SLOT = (const int*)(wsptr(P) + WS_SMALL + SM_SLOT); const bf16_t* Y2 = (const bf16_t*)(wsptr(P) + WS_R1);
    float* LOGF = (float*)(wsptr(P) + WS_SMALL + SM_LOGF);
    for (int row = gw; row < M; row += NGW) {
        const int b = row >> 13;
        f32x4 v[4];
        if (MODE == 0) {
#pragma unroll
            for (int j = 0; j < 4; ++j) v[j] = *(const f32x4*)(inptr(I_X) + (size_t)row * D + 256 * j + 4 * lane);
        } else {
            const float* gf = MOD + (size_t)((l - 1) * 2 + b) * 6144 + 5 * 1024;
            f32x4 a[4];
#pragma unroll
            for (int j = 0; j < 4; ++j) { v[j] = *(const f32x4*)(X + (size_t)row * D + 256 * j + 4 * lane); a[j] = (f32x4){0.f, 0.f, 0.f, 0.f}; }
#pragma unroll
            for (int k = 0; k < TOPK; ++k) { const int slot = SLOT[row * TOPK + k];
#pragma unroll
                for (int j = 0; j < 4; ++j) { const u32x2 w = *(const u32x2*)(Y2 + (size_t)slot * D + 256 * j + 4 * lane);
                    a[j][0] += bflo(w.x); a[j][1] += bfhi(w.x); a[j][2] += bflo(w.y); a[j][3] += bfhi(w.y); } }
#pragma unroll
            for (int j = 0; j < 4; ++j) { const f32x4 g4 = *(const f32x4*)(gf + 256 * j + 4 * lane); v[j] = v[j] + g4 * a[j];
                if (MODE == 1) *(f32x4*)(X + (size_t)row * D + 256 * j + 4 * lane) = v[j]; }
        }
        float ss = 0.f;
#pragma unroll
        for (int j = 0; j < 4; ++j) ss += (v[j][0] * v[j][0] + v[j][1] * v[j][1]) + (v[j][2] * v[j][2] + v[j][3] * v[j][3]);
        const float rms = 1.0f / sqrtf(wave_sum(ss) * (1.f / D) + EPS);
        if (MODE == 2) {
#pragma unroll
            for (int j = 0; j < 4; ++j) { const f32x4 g4 = *(const f32x4*)(inptr(I_FING) + 256 * j + 4 * lane); *(f32x4*)(P.out + (size_t)row * D + 256 * j + 4 * lane) = v[j] * rms * g4; }
        } else {
            const float* md = MOD + (size_t)(l * 2 + b) * 6144;
            float fl[4] = {0.f, 0.f, 0.f, 0.f};
#pragma unroll
            for (int j = 0; j < 4; ++j) { const int d0 = 256 * j + 4 * lane;
                const f32x4 g4 = *(const f32x4*)(inptr(I_MNG) + l * D + d0), sh = *(const f32x4*)(md + d0), scl = *(const f32x4*)(md + 1024 + d0);
                const f32x4 h = v[j] * rms * g4 * (scl + 1.0f) + sh;
                u32x2 w; w.x = cvt_pk_bf16(h[0], h[1]); w.y = cvt_pk_bf16(h[2], h[3]); *(u32x2*)(H + (size_t)row * D + d0) = w;
#pragma unroll
                for (int i = 0; i < 4; ++i) { const f32x4 wv = wf[d0 + i]; fl[0] += h[i] * wv[0]; fl[1] += h[i] * wv[1]; fl[2] += h[i] * wv[2]; fl[3] += h[i] * wv[3]; } }
#pragma unroll
            for (int hh = 0; hh < 4; ++hh) fl[hh] = wave_sum(fl[hh]);
            if (lane == 0) { f32x4 o;
#pragma unroll
                for (int hh = 0; hh < 4; ++hh) { const float f = fl[hh] + inptr(I_BF)[l * 4 + hh]; o[hh] = fminf(f, 0.f) - log1pf(__expf(-fabsf(f))); }
                *(f32x4*)(LOGF + (size_t)row * 4) = o; }
        }
    }
}
__device__ __forceinline__ void phase_norm2(const Params& P, int l, int gw, int NGW, const int g_wave) {
    const int lane = TIDX & 63;
    const float* MOD = (const float*)(wsptr(P) + WS_SMALL + SM_MOD);
    const float* X = (const float*)(wsptr(P) + WS_X); bf16_t* H = (bf16_t*)(wsptr(P) + WS_H);
    for (int row = gw; row < M; row += NGW) {
        const int b = row >> 13; f32x4 v[4]; float ss = 0.f;
#pragma unroll
        for (int j = 0; j < 4; ++j) { v[j] = *(const f32x4*)(X + (size_t)row * D + 256 * j + 4 * lane); ss += (v[j][0] * v[j][0] + v[j][1] * v[j][1]) + (v[j][2] * v[j][2] + v[j][3] * v[j][3]); }
        const float rms = 1.0f / sqrtf(wave_sum(ss) * (1.f / D) + EPS);
        const float* md = MOD + (size_t)(l * 2 + b) * 6144;
#pragma unroll
        for (int j = 0; j < 4; ++j) { const int d0 = 256 * j + 4 * lane;
            const f32x4 g4 = *(const f32x4*)(inptr(I_FNG) + l * D + d0), sh = *(const f32x4*)(md + 3 * 1024 + d0), scl = *(const f32x4*)(md + 4 * 1024 + d0);
            const f32x4 h = v[j] * rms * g4 * (scl + 1.0f) + sh;
            u32x2 w; w.x = cvt_pk_bf16(h[0], h[1]); w.y = cvt_pk_bf16(h[2], h[3]); *(u32x2*)(H + (size_t)row * D + d0) = w; }
    }
}

__device__ __forceinline__ void scan_logf(const Params& P, const int g_wave) {
    const int tid_ = TIDX, lane = tid_ & 63, seq = tid_ >> 6, b = seq >> 2, hh = seq & 3;
    const float* LOGF = (const float*)(wsptr(P) + WS_SMALL + SM_LOGF);
    float* CUM = (float*)(wsptr(P) + WS_SMALL + SM_CUM); bf16_t* CB = (bf16_t*)(wsptr(P) + WS_SMALL + SM_CB);
    float carry = 0.f;
#pragma unroll 4
    for (int it = 0; it < SEQ / 64; ++it) {
        const int pos = it * 64 + lane;
        float v = LOGF[(size_t)(b * SEQ + pos) * 4 + hh];
#pragma unroll
        for (int o = 1; o < 64; o <<= 1) { const float t = __shfl_up(v, o); if (lane >= o) v += t; }
        const float cl = (carry + v) * LOG2E;
        CUM[(size_t)seq * SEQ + pos] = cl;
        const float kb = -cl;
        const unsigned c1 = cvt_pk_bf16(kb, 0.f) & 0xffffu; const float r1 = kb - __uint_as_float(c1 << 16);
        const unsigned c2 = cvt_pk_bf16(r1, 0.f) & 0xffffu; const float r2 = r1 - __uint_as_float(c2 << 16);
        const unsigned c3 = cvt_pk_bf16(r2, 0.f) & 0xffffu;
        *(u32x4*)(CB + ((size_t)seq * SEQ + pos) * 8) = (u32x4){c1 | (c2 << 16), c3, 0u, 0u};
        carry += __shfl(v, 63);
    }
}

__device__ __forceinline__ void pool_unit(const Params& P, LAS unsigned char* lds, int l, int tile, const int g_wave) {
    const int tid = TIDX;
    const bf16_t* PROJ = (const bf16_t*)(wsptr(P) + WS_R1); bf16_t* YS = (bf16_t*)(wsptr(P) + WS_YS);
    LAS bf16_t* zs = (LAS bf16_t*)lds;
    LAS float* pl = (LAS float*)(lds + 40960);
    const int t0 = tile * 64, sp0 = t0 & (SEQ - 1);
    for (int p = tid; p < 79 * 32; p += NTHREADS) { const int r = p >> 5, ch = p & 31; const int pos = sp0 - 15 + r;
        u32x4 v = (u32x4){0u, 0u, 0u, 0u};
        if (pos >= 0) v = *(const u32x4*)(PROJ + (size_t)(t0 - 15 + r) * 2048 + ch * 8);
        *(LAS u32x4*)(zs + r * 256 + ch * 8) = v; }
    __syncthreads();
    { const int c = tid & 255, half = tid >> 8, g = c >> 6, w = 2 << g;
      for (int i = 0; i < 32; ++i) { const int tt = half * 32 + i, pos = sp0 + tt; const int cnt = (pos + 1 < w) ? pos + 1 : w;
          float s = 0.f;
          for (int j = 0; j < cnt; ++j) s += bf2f(zs[(tt + 15 - j) * 256 + c]);
          pl[tt * 256 + c] = s / (float)cnt - bf2f(zs[(tt + 15) * 256 + c]); } }
    __syncthreads();
    { const int col = tid & 255, half = tid >> 8, g = col >> 6, d = col & 63;
      const float* W = inptr(I_POOLW) + (size_t)(l * 4 + g) * 64 * 64 + d;
      float wc[64];
#pragma unroll
      for (int cc = 0; cc < 64; ++cc) wc[cc] = W[cc * 64];
      const float scl = inptr(I_POOLS)[l * 256 + col];
      for (int i = 0; i < 32; ++i) { const int tt = half * 32 + i; const LAS f32x4* pr = (const LAS f32x4*)(pl + tt * 256 + g * 64);
          float a = 0.f;
#pragma unroll
          for (int q = 0; q < 16; ++q) { const f32x4 pv = pr[q]; a += pv[0] * wc[4 * q] + pv[1] * wc[4 * q + 1] + pv[2] * wc[4 * q + 2] + pv[3] * wc[4 * q + 3]; }
          YS[(size_t)(t0 + tt) * 1024 + col] = f2bf(a * scl); } }
    __syncthreads();
}

__device__ __forceinline__ void sg_unit(const Params& P, LAS unsigned char* lds, int l, int u, const int g_wave) {
    const int tid = TIDX, lane = tid & 63, wave = __builtin_amdgcn_readfirstlane(tid >> 6);
    const bf16_t* PROJ = (const bf16_t*)(wsptr(P) + WS_R1); bf16_t* YS = (bf16_t*)(wsptr(P) + WS_YS);
    LAS float* vn = (LAS float*)lds;
    const int chunk = u >> 1, hp = u & 1, t0 = chunk * 128;
    for (int i = 0; i < 16; ++i) { const int s = wave * 16 + i;
        const u32x2 w = *(const u32x2*)(PROJ + (size_t)(t0 + s) * 2048 + 512 + 4 * lane);
        float x0 = bflo(w.x), x1 = bfhi(w.x), x2 = bflo(w.y), x3 = bfhi(w.y);
        const float mu = wave_sum((x0 + x1) + (x2 + x3)) * (1.f / 256.f);
        x0 -= mu; x1 -= mu; x2 -= mu; x3 -= mu;
        const float var = wave_sum((x0 * x0 + x1 * x1) + (x2 * x2 + x3 * x3)) * (1.f / 256.f);
        const float rstd = 1.0f / sqrtf(var + EPS);
        if ((lane >> 5) == hp) { const int c0 = 4 * lane; const f32x4 g4 = *(const f32x4*)(inptr(I_SGLG) + l * 256 + c0), b4 = *(const f32x4*)(inptr(I_SGLB) + l * 256 + c0);
            *(LAS f32x4*)(vn + s * 128 + (c0 - 128 * hp)) = (f32x4){x0 * rstd * g4[0] + b4[0], x1 * rstd * g4[1] + b4[1], x2 * rstd * g4[2] + b4[2], x3 * rstd * g4[3] + b4[3]}; } }
    __syncthreads();
    { const int cl = tid & 127, tq = __builtin_amdgcn_readfirstlane(tid >> 7), h = 2 * hp + __builtin_amdgcn_readfirstlane((tid >> 6) & 1);
      const float* Wh = inptr(I_SGW) + (size_t)(l * 4 + h) * 128 * 128;
      for (int i = 0; i < 32; ++i) { const int t = tq + 4 * i; const float* Wr = Wh + t * 128;
          float a = 0.f; const int nq = (t + 1) >> 2;
          for (int q = 0; q < nq; ++q) { const f32x4 w4 = *(const f32x4*)(Wr + 4 * q);
              a += w4[0] * vn[(4 * q) * 128 + cl] + w4[1] * vn[(4 * q + 1) * 128 + cl] + w4[2] * vn[(4 * q + 2) * 128 + cl] + w4[3] * vn[(4 * q + 3) * 128 + cl]; }
          for (int s = 4 * nq; s <= t; ++s) a += Wr[s] * vn[s * 128 + cl];
          a += inptr(I_SGB)[(l * 4 + h) * 128 + t];
          const float uu = bf2f(PROJ[(size_t)(t0 + t) * 2048 + 256 + 128 * hp + cl]);
          YS[(size_t)(t0 + t) * 1024 + 256 + 128 * hp + cl] = f2bf(uu * a); } }
    __syncthreads();
}

__device__ __forceinline__ void conv_unit(const Params& P, LAS unsigned char* lds, int l, int tile, const int g_wave) {
    const int tid = TIDX, lane = tid & 63, wave = tid >> 6;
    const bf16_t* PROJ = (const bf16_t*)(wsptr(P) + WS_R1); bf16_t* YS = (bf16_t*)(wsptr(P) + WS_YS);
    LAS float* ys = (LAS float*)lds;
    const int t0 = tile * 64, sp0 = t0 & (SEQ - 1);
    for (int p = tid; p < 94 * 32; p += NTHREADS) { const int r = p >> 5, ch = p & 31; const int pos = sp0 - 30 + r;
        f32x4 o0 = (f32x4){0.f, 0.f, 0.f, 0.f}, o1 = o0;
        if (pos >= 0) { const bf16_t* rp = PROJ + (size_t)(t0 - 30 + r) * 2048 + ch * 8;
            const u32x4 a = *(const u32x4*)(rp + 768), g = *(const u32x4*)(rp + 1024);
            o0 = (f32x4){bflo(a.x) * sigmoidf_(bflo(g.x)), bfhi(a.x) * sigmoidf_(bfhi(g.x)), bflo(a.y) * sigmoidf_(bflo(g.y)), bfhi(a.y) * sigmoidf_(bfhi(g.y))};
            o1 = (f32x4){bflo(a.z) * sigmoidf_(bflo(g.z)), bfhi(a.z) * sigmoidf_(bfhi(g.z)), bflo(a.w) * sigmoidf_(bflo(g.w)), bfhi(a.w) * sigmoidf_(bfhi(g.w))}; }
        *(LAS f32x4*)(ys + r * 256 + ch * 8) = o0; *(LAS f32x4*)(ys + r * 256 + ch * 8 + 4) = o1; }
    __syncthreads();
    float outv[32];
    { const int c = tid & 255, half = tid >> 8;
      float w[31], yv[62];
#pragma unroll
      for (int j = 0; j < 31; ++j) w[j] = inptr(I_CONVW)[(size_t)(l * 31 + j) * 256 + c];
#pragma unroll
      for (int r = 0; r < 62; ++r) yv[r] = ys[(half * 32 + r) * 256 + c];
      const float cb = inptr(I_CONVB)[l * 256 + c];
#pragma unroll
      for (int i = 0; i < 32; ++i) { float a = cb;
#pragma unroll
          for (int j = 0; j < 31; ++j) a += w[j] * yv[i + j];
          outv[i] = a; } }
    __syncthreads();
    { const int c = tid & 255, half = tid >> 8;
#pragma unroll
      for (int i = 0; i < 32; ++i) ys[(half * 32 + i) * 256 + c] = outv[i]; }
    __syncthreads();
    for (int i = 0; i < 8; ++i) { const int tt = wave * 8 + i; f32x4 x = *(const LAS f32x4*)(ys + tt * 256 + 4 * lane);
        const float mu = wave_sum((x[0] + x[1]) + (x[2] + x[3])) * (1.f / 256.f);
        x = x - mu;
        const float var = wave_sum((x[0] * x[0] + x[1] * x[1]) + (x[2] * x[2] + x[3] * x[3])) * (1.f / 256.f);
        const float rstd = 1.0f / sqrtf(var + EPS);
        const f32x4 g4 = *(const f32x4*)(inptr(I_CLG) + l * 256 + 4 * lane), b4 = *(const f32x4*)(inptr(I_CLB) + l * 256 + 4 * lane);
        const f32x4 y = x * rstd * g4 + b4;
        u32x2 o; o.x = cvt_pk_bf16(siluf_(y[0]), siluf_(y[1])); o.y = cvt_pk_bf16(siluf_(y[2]), siluf_(y[3]));
        *(u32x2*)(YS + (size_t)(t0 + tt) * 1024 + 512 + 4 * lane) = o; }
    __syncthreads();
}

__device__ __forceinline__ void attn_naive_unit(const Params& P, LAS unsigned char* lds, int u, const int g_wave) {
    const int tid = TIDX;
    const bf16_t* PROJ = (const bf16_t*)(wsptr(P) + WS_R1); bf16_t* YS = (bf16_t*)(wsptr(P) + WS_YS);
    const float* CUM = (const float*)(wsptr(P) + WS_SMALL + SM_CUM);
    LAS float* Ks = (LAS float*)lds;
    LAS float* Vs = (LAS float*)(lds + 64 * 64 * 4);
    LAS float* cks = (LAS float*)(lds + 2 * 64 * 64 * 4);
    const int bh = u >> 7, qt = u & 127, b = bh >> 2, hh = bh & 3;
    const int q = tid >> 3, p = tid & 7;
    const int qpos = qt * 64 + q; const size_t qrow = (size_t)b * SEQ + qpos;
    float qv[8], o[8];
    { const u32x4 w = *(const u32x4*)(PROJ + qrow * 2048 + 1280 + hh * 64 + p * 8);
      qv[0] = bflo(w.x); qv[1] = bfhi(w.x); qv[2] = bflo(w.y); qv[3] = bfhi(w.y); qv[4] = bflo(w.z); qv[5] = bfhi(w.z); qv[6] = bflo(w.w); qv[7] = bfhi(w.w); }
#pragma unroll
    for (int d = 0; d < 8; ++d) o[d] = 0.f;
    const float cq = CUM[(size_t)bh * SEQ + qpos];
    float mrun = -INFINITY, lrun = 0.f;
    for (int kt = 0; kt <= qt; ++kt) {
        __syncthreads();
        { const int r = tid >> 3, c8 = tid & 7; const size_t krow = (size_t)b * SEQ + kt * 64 + r;
          const u32x4 kw = *(const u32x4*)(PROJ + krow * 2048 + 1536 + hh * 64 + c8 * 8), vw = *(const u32x4*)(PROJ + krow * 2048 + 1792 + hh * 64 + c8 * 8);
          *(LAS f32x4*)(Ks + r * 64 + c8 * 8) = (f32x4){bflo(kw.x), bfhi(kw.x), bflo(kw.y), bfhi(kw.y)}; *(LAS f32x4*)(Ks + r * 64 + c8 * 8 + 4) = (f32x4){bflo(kw.z), bfhi(kw.z), bflo(kw.w), bfhi(kw.w)};
          *(LAS f32x4*)(Vs + r * 64 + c8 * 8) = (f32x4){bflo(vw.x), bfhi(vw.x), bflo(vw.y), bfhi(vw.y)}; *(LAS f32x4*)(Vs + r * 64 + c8 * 8 + 4) = (f32x4){bflo(vw.z), bfhi(vw.z), bflo(vw.w), bfhi(vw.w)};
          if (tid < 64) cks[tid] = CUM[(size_t)bh * SEQ + kt * 64 + tid]; }
        __syncthreads();
        const int jmax = (kt == qt) ? q : 63;
#pragma unroll 4
        for (int j = 0; j < 64; ++j) {
            const f32x4 k0 = *(const LAS f32x4*)(Ks + j * 64 + p * 8), k1 = *(const LAS f32x4*)(Ks + j * 64 + p * 8 + 4);
            float a = (qv[0] * k0[0] + qv[1] * k0[1]) + (qv[2] * k0[2] + qv[3] * k0[3]) + (qv[4] * k1[0] + qv[5] * k1[1]) + (qv[6] * k1[2] + qv[7] * k1[3]);
            a += __shfl_xor(a, 1); a += __shfl_xor(a, 2); a += __shfl_xor(a, 4);
            if (j <= jmax) {
                const float sc = a + (cq - cks[j]);
                const float mn = fmaxf(mrun, sc), f = fexp2(mrun - mn), pe = fexp2(sc - mn);
                const f32x4 v0 = *(const LAS f32x4*)(Vs + j * 64 + p * 8), v1 = *(const LAS f32x4*)(Vs + j * 64 + p * 8 + 4);
                lrun = lrun * f + pe; mrun = mn;
                o[0] = o[0] * f + pe * v0[0]; o[1] = o[1] * f + pe * v0[1]; o[2] = o[2] * f + pe * v0[2]; o[3] = o[3] * f + pe * v0[3];
                o[4] = o[4] * f + pe * v1[0]; o[5] = o[5] * f + pe * v1[1]; o[6] = o[6] * f + pe * v1[2]; o[7] = o[7] * f + pe * v1[3];
            }
        }
    }
    const float inv = 1.0f / lrun;
    u32x4 w; w.x = cvt_pk_bf16(o[0] * inv, o[1] * inv); w.y = cvt_pk_bf16(o[2] * inv, o[3] * inv); w.z = cvt_pk_bf16(o[4] * inv, o[5] * inv); w.w = cvt_pk_bf16(o[6] * inv, o[7] * inv);
    *(u32x4*)(YS + qrow * 1024 + 768 + hh * 64 + p * 8) = w;
    __syncthreads();
}

using pg8::Unit;
struct SchedDense { int nM, nN, G, c, lda, ldb;
    __device__ __forceinline__ bool next(int i, Unit& u) const { int pm, pn; if (!pg8::static_tile(i, G, c, nM, nN, pm, pn)) return false;
        u.pm = pm; u.pn = pn; u.a = 0; u.b = 0; u.c = 0; u.e = 0; u.aoff = (size_t)pm * 256 * lda * 2; u.boff = (size_t)pn * 256 * ldb * 2; return true; } };
struct SchedG2 { int G, c;
    __device__ __forceinline__ bool next(int i, Unit& u) const { int pm, pn; if (!pg8::static_tile(i >> 2, G, c, 64, 4, pm, pn)) return false; const int n = i & 3;
        u.pm = pm; u.pn = pn; u.a = n; u.b = 0; u.c = 0; u.e = 0; u.aoff = ((size_t)pm * 256 * 1024 + n * 256) * 2; u.boff = ((size_t)(n * 1024 + pn * 256) * 256) * 2; return true; } };
struct SchedG4 { int G, c;
    __device__ __forceinline__ bool next(int i, Unit& u) const { const long L = (long)i * G + c; if (L >= 192) return false;
        if (L < 128) { u.pm = (int)(L >> 1); u.pn = (int)(L & 1); u.e = 1; u.boff = (WB_W13 + ((size_t)64 * 512 + u.pn * 256) * 1024) * 2; }
        else { u.pm = (int)(L - 128); u.pn = 0; u.e = 0; u.boff = WB_WR * 2; }
        u.a = NPAIR + u.pm * 256; u.b = 256; u.c = 0; u.aoff = (size_t)u.pm * 256 * 1024 * 2; return true; } };
template <int NPN, bool DOWN> struct SchedMoe { LAS const i32x4* TL; int ntile, per, j;
    __device__ __forceinline__ bool next(int i, Unit& u) const { const int L = i * per + j; if (L >= ntile * NPN) return false;
        const int tile = L / NPN, pn = L % NPN; const i32x4 t = TL[tile];
        const int e = __builtin_amdgcn_readfirstlane(t[0]), sb = __builtin_amdgcn_readfirstlane(t[1]), nv = __builtin_amdgcn_readfirstlane(t[2]), ib = __builtin_amdgcn_readfirstlane(t[3]);
        u.pm = tile; u.pn = pn; u.e = e; u.a = sb; u.b = nv; u.c = ib;
        if (DOWN) { u.aoff = (size_t)sb * 256 * 2; u.boff = (WB_W2 + ((size_t)e * 1024 + pn * 256) * 256) * 2; }
        else { u.aoff = 0; u.boff = (WB_W13 + ((size_t)e * 512 + pn * 256) * 1024) * 2; }
        return true; } };

typedef f32x4 Acc[2][2][4][2];
struct Epi1 { static constexpr bool PERM = true; bf16_t* PROJ; bf16_t* SG;
    __device__ __forceinline__ void operator()(const Acc& acc, const Unit& u, int wr, int wc, int fr, int fq) const {
        asm volatile("" : "+v"(fr), "+v"(fq));
        const int pn = u.pn; const int mode = (pn >= 8) ? 2 : ((pn == 1 || pn == 2) ? 1 : (pn == 5 ? 3 : 0));
        bf16_t* base = (pn >= 8) ? SG + (pn - 8) * 256 : PROJ + pn * 256; const int ldc = (pn >= 8) ? 4096 : 2048;
        const int row0 = u.pm * 256 + wr * 64 + fr, col0 = wc * 32 + 8 * fq;
#pragma unroll
        for (int ai = 0; ai < 2; ++ai)
#pragma unroll
            for (int m = 0; m < 4; ++m) { bf16_t* rowp = base + (size_t)(row0 + ai * 128 + m * 16) * ldc + col0;
#pragma unroll
                for (int bj = 0; bj < 2; ++bj) { float v[8];
#pragma unroll
                    for (int n = 0; n < 2; ++n)
#pragma unroll
                        for (int q = 0; q < 4; ++q) { float x = acc[ai][bj][m][n][q];
                            if (mode == 1) x = gelu_tanh(x); else if (mode == 2) x = sigmoidf_(x); else if (mode == 3) x *= QSCALE;
                            v[4 * n + q] = x; }
                    u32x4 w; w.x = cvt_pk_bf16(v[0], v[1]); w.y = cvt_pk_bf16(v[2], v[3]); w.z = cvt_pk_bf16(v[4], v[5]); w.w = cvt_pk_bf16(v[6], v[7]);
                    *(u32x4*)(rowp + bj * 128) = w; } }
    } };
struct Epi2 { static constexpr bool PERM = true; const bf16_t* SG; bf16_t* MRG;
    __device__ __forceinline__ void operator()(const Acc& acc, const Unit& u, int wr, int wc, int fr, int fq) const {
        asm volatile("" : "+v"(fr), "+v"(fq));
        const int n_ = u.a; const int row0 = u.pm * 256 + wr * 64 + fr, col0 = u.pn * 256 + wc * 32 + 8 * fq;
#pragma unroll
        for (int ai = 0; ai < 2; ++ai)
#pragma unroll
            for (int m = 0; m < 4; ++m) { const size_t row = (size_t)(row0 + ai * 128 + m * 16);
#pragma unroll
                for (int bj = 0; bj < 2; ++bj) { const u32x4 g = *(const u32x4*)(SG + row * 4096 + n_ * 1024 + col0 + bj * 128);
                    bf16_t* op = MRG + row * 1024 + col0 + bj * 128;
                    u32x4 p = (u32x4){0u, 0u, 0u, 0u}; if (n_ > 0) p = *(const u32x4*)op;
                    const f32x4 a0 = acc[ai][bj][m][0], a1 = acc[ai][bj][m][1];
                    u32x4 w;
                    w.x = cvt_pk_bf16(bflo(p.x) + bflo(g.x) * a0[0], bfhi(p.x) + bfhi(g.x) * a0[1]); w.y = cvt_pk_bf16(bflo(p.y) + bflo(g.y) * a0[2], bfhi(p.y) + bfhi(g.y) * a0[3]);
                    w.z = cvt_pk_bf16(bflo(p.z) + bflo(g.z) * a1[0], bfhi(p.z) + bfhi(g.z) * a1[1]); w.w = cvt_pk_bf16(bflo(p.w) + bflo(g.w) * a1[2], bfhi(p.w) + bfhi(g.w) * a1[3]);
                    *(u32x4*)op = w; }
                asm volatile("" ::: "memory"); }
    } };
struct Epi3 { static constexpr bool PERM = false; const float* xin; float* X; const float* gate;
    __device__ __forceinline__ void operator()(const Acc& acc, const Unit& u, int wr, int wc, int fr, int fq) const {
        asm volatile("" : "+v"(fr), "+v"(fq));
        const int b = u.pm >> 5; const float* gp = gate + (size_t)b * 6144 + 2 * 1024;
        const int row0 = u.pm * 256 + wr * 64 + fr, col0 = u.pn * 256 + wc * 32 + 4 * fq;
#pragma unroll
        for (int bj = 0; bj < 2; ++bj)
#pragma unroll
            for (int n = 0; n < 2; ++n) { const int col = col0 + bj * 128 + n * 16; const f32x4 gv = *(const f32x4*)(gp + col);
#pragma unroll
                for (int ai = 0; ai < 2; ++ai)
#pragma unroll
                    for (int m = 0; m < 4; ++m) { const size_t off = (size_t)(row0 + ai * 128 + m * 16) * 1024 + col;
                        *(f32x4*)(X + off) = *(const f32x4*)(xin + off) + gv * acc[ai][bj][m][n]; } }
    } };
struct EpiUp { static constexpr bool PERM = true; float* RLOG; bf16_t* HID; const float* GW;
    __device__ __forceinline__ void operator()(const Acc& acc, const Unit& u, int wr, int wc, int fr, int fq) const {
        asm volatile("" : "+v"(fr), "+v"(fq));
        if (u.e == 0 && RLOG) {
            if (wc < 2) {
#pragma unroll
                for (int ai = 0; ai < 2; ++ai)
#pragma unroll
                    for (int m = 0; m < 4; ++m) { const size_t row = (size_t)(u.pm * 256 + ai * 128 + wr * 64 + m * 16 + fr);
#pragma unroll
                        for (int n = 0; n < 2; ++n) *(f32x4*)(RLOG + row * 64 + wc * 32 + 8 * fq + 4 * n) = acc[ai][0][m][n]; } }
            return; }
#pragma unroll
        for (int ai = 0; ai < 2; ++ai)
#pragma unroll
            for (int m = 0; m < 4; ++m) { const int r = ai * 128 + wr * 64 + m * 16 + fr;
                if (r < u.b) { const size_t slot = (size_t)u.a + r; const float gw = GW ? GW[slot] : 1.f; float v[8];
#pragma unroll
                    for (int n = 0; n < 2; ++n)
#pragma unroll
                        for (int q = 0; q < 4; ++q) v[4 * n + q] = siluf_(acc[ai][0][m][n][q]) * acc[ai][1][m][n][q] * gw;
                    u32x4 w; w.x = cvt_pk_bf16(v[0], v[1]); w.y = cvt_pk_bf16(v[2], v[3]); w.z = cvt_pk_bf16(v[4], v[5]); w.w = cvt_pk_bf16(v[6], v[7]);
                    *(u32x4*)(HID + slot * 256 + u.pn * 128 + wc * 32 + 8 * fq) = w; } }
    } };
struct EpiDown { static constexpr bool PERM = true; bf16_t* Y2; float* X; const float* gate;
    __device__ __forceinline__ void operator()(const Acc& acc, const Unit& u, int wr, int wc, int fr, int fq) const {
        asm volatile("" : "+v"(fr), "+v"(fq));
        if (u.e == 64) { const int tok0 = u.a - NPAIR; const int b = tok0 >> 13; const float* gp = gate + (size_t)b * 6144 + 5 * 1024;
#pragma unroll
            for (int bj = 0; bj < 2; ++bj)
#pragma unroll
                for (int n = 0; n < 2; ++n) { const int col = u.pn * 256 + bj * 128 + wc * 32 + 8 * fq + 4 * n; const f32x4 gv = *(const f32x4*)(gp + col);
#pragma unroll
                    for (int ai = 0; ai < 2; ++ai)
#pragma unroll
                        for (int m = 0; m < 4; ++m) { const size_t off = (size_t)(tok0 + ai * 128 + wr * 64 + m * 16 + fr) * 1024 + col;
                            *(f32x4*)(X + off) = *(const f32x4*)(X + off) + gv * acc[ai][bj][m][n]; }
                    asm volatile("" ::: "memory"); }
            return; }
#pragma unroll
        for (int ai = 0; ai < 2; ++ai)
#pragma unroll
            for (int m = 0; m < 4; ++m) { const int r = ai * 128 + wr * 64 + m * 16 + fr;
                if (r < u.b) { bf16_t* rowp = Y2 + ((size_t)u.a + r) * 1024 + u.pn * 256 + wc * 32 + 8 * fq;
#pragma unroll
                    for (int bj = 0; bj < 2; ++bj) { const f32x4 a0 = acc[ai][bj][m][0], a1 = acc[ai][bj][m][1];
                        u32x4 w; w.x = cvt_pk_bf16(a0[0], a0[1]); w.y = cvt_pk_bf16(a0[2], a0[3]); w.z = cvt_pk_bf16(a1[0], a1[1]); w.w = cvt_pk_bf16(a1[2], a1[3]);
                        *(u32x4*)(rowp + bj * 128) = w; } } }
    } };

__device__ __forceinline__ void phase_route(const Params& P, LAS unsigned char* lds, int l, int bid, int G, const int g_wave) {
    const int tid = TIDX, lane = tid & 63, wave = tid >> 6;
    const float* RLOG = (const float*)(wsptr(P) + WS_SMALL + SM_RLOG);
    int* TE = (int*)(wsptr(P) + WS_SMALL + SM_TE); float* TW = (float*)(wsptr(P) + WS_SMALL + SM_TW); int* TP = (int*)(wsptr(P) + WS_SMALL + SM_TP);
    unsigned* CNT = (unsigned*)(wsptr(P) + WS_CTL) + CW_CNT + l * 64;
    LAS int* cntw = (LAS int*)lds; LAS int* basew = (LAS int*)(lds + 8 * 64 * 4);
    const float rb = inptr(I_RB)[l * 64 + lane];
    for (int grp = bid; grp < M / 64; grp += G) {
        int selk[8]; float selw[8]; int cnt = 0;
#pragma unroll
        for (int i = 0; i < 8; ++i) { const int t = grp * 64 + wave * 8 + i; asm volatile("" ::: "memory");
            const float score = sigmoidf_(RLOG[(size_t)t * 64 + lane]); const float sel = score + rb;
            float m1 = sel;
#pragma unroll
            for (int o = 1; o < 8; o <<= 1) m1 = fmaxf(m1, __shfl_xor(m1, o));
            int i1 = (sel == m1) ? lane : 64;
#pragma unroll
            for (int o = 1; o < 8; o <<= 1) i1 = min(i1, __shfl_xor(i1, o));
            float m2 = (lane == i1) ? -INFINITY : sel;
#pragma unroll
            for (int o = 1; o < 8; o <<= 1) m2 = fmaxf(m2, __shfl_xor(m2, o));
            const float gs = m1 + m2; const int grp_id = lane >> 3;
            int grank = 0;
#pragma unroll
            for (int j = 0; j < 8; ++j) { const float o = __shfl(gs, 8 * j); grank += (o > gs || (o == gs && j < grp_id)) ? 1 : 0; }
            const float msel = (grank < 4) ? sel : -INFINITY;
            int rank = 0;
#pragma unroll 8
            for (int j = 0; j < 64; ++j) { const float o = __shfl(msel, j); rank += (o > msel || (o == msel && j < lane)) ? 1 : 0; }
            const bool chosen = rank < TOPK;
            const float den = wave_sum(chosen ? score : 0.f);
            selk[i] = chosen ? rank : -1; selw[i] = score / den * 2.5f; cnt += chosen ? 1 : 0; }
        cntw[wave * 64 + lane] = cnt;
        __syncthreads();
        if (tid < 64) { int tot = 0; int pre[8];
#pragma unroll
            for (int w = 0; w < 8; ++w) { pre[w] = tot; tot += cntw[w * 64 + tid]; }
            int base = 0; if (tot > 0) base = (int)__hip_atomic_fetch_add(CNT + tid, (unsigned)tot, __ATOMIC_RELAXED, __HIP_MEMORY_SCOPE_AGENT);
#pragma unroll
            for (int w = 0; w < 8; ++w) basew[w * 64 + tid] = base + pre[w]; }
        __syncthreads();
        int run = basew[wave * 64 + lane];
#pragma unroll
        for (int i = 0; i < 8; ++i) { const int t = grp * 64 + wave * 8 + i;
            if (selk[i] >= 0) { const int o = t * TOPK + selk[i]; TE[o] = lane; TW[o] = selw[i]; TP[o] = run; ++run; } }
        __syncthreads();
    }
}
__device__ __forceinline__ void moe_offsets(const Params& P, LAS unsigned char* lds, int l, const int g_wave) {
    LAS int* eo = (LAS int*)(lds + EOFF_OFF);
    if (TIDX == 0) { const unsigned* CNT = (const unsigned*)(wsptr(P) + WS_CTL) + CW_CNT + l * 64; int off = 0, poff = 0;
#pragma unroll 1
        for (int e = 0; e < 64; ++e) { const int n = (int)__hip_atomic_load(CNT + e, __ATOMIC_RELAXED, __HIP_MEMORY_SCOPE_AGENT); eo[e] = off; eo[64 + e] = poff; eo[128 + e] = n; off += n; poff += ((n + 255) >> 8) << 8; } }
    __syncthreads();
}
__device__ __forceinline__ void phase_lists(const Params& P, LAS unsigned char* lds, int l, int bid, int G, const int g_wave) {
    const int tid = TIDX;
    moe_offsets(P, lds, l, g_wave);
    LAS const int* eo = (LAS const int*)(lds + EOFF_OFF);
    const int* TE = (const int*)(wsptr(P) + WS_SMALL + SM_TE); const float* TW = (const float*)(wsptr(P) + WS_SMALL + SM_TW); const int* TP = (const int*)(wsptr(P) + WS_SMALL + SM_TP);
    int* SLOT = (int*)(wsptr(P) + WS_SMALL + SM_SLOT); int* IDX = (int*)(wsptr(P) + WS_SMALL + SM_IDX); float* GW = (float*)(wsptr(P) + WS_SMALL + SM_GW);
    for (int i = bid * NTHREADS + tid; i < NPAIR; i += G * NTHREADS) { const int e = TE[i], pos = TP[i]; const int slot = eo[e] + pos;
        SLOT[i] = slot; IDX[eo[64 + e] + pos] = i / TOPK; GW[slot] = TW[i]; }
    for (int e = bid; e < 64; e += G) { const int n = eo[128 + e], pend = ((n + 255) >> 8) << 8; for (int p = n + tid; p < pend; p += NTHREADS) IDX[eo[64 + e] + p] = 0; }
    __syncthreads();
}
__device__ __forceinline__ int moe_tile_list(const Params& P, LAS unsigned char* lds, int l, int x, bool down, const int g_wave) {
    moe_offsets(P, lds, l, g_wave);
    LAS const int* eo = (LAS const int*)(lds + EOFF_OFF); LAS i32x4* TL = (LAS i32x4*)(lds + TL_OFF); LAS int* tln = (LAS int*)(lds + TLN_OFF);
    if (TIDX == 0) { int nt = 0;
#pragma unroll 1
        for (int e = x; e < 64; e += 8) { const int n = eo[128 + e];
#pragma unroll 1
            for (int j = 0; j * 256 < n; ++j) { TL[nt] = (i32x4){e, eo[e] + j * 256, (n - j * 256 < 256) ? n - j * 256 : 256, eo[64 + e] + j * 256}; ++nt; } }
        if (down)
#pragma unroll 1
            for (int s = 0; s < 8; ++s) { TL[nt] = (i32x4){64, NPAIR + (x * 8 + s) * 256, 256, 0}; ++nt; }
        tln[0] = nt; }
    __syncthreads();
    return tln[0];
}

constexpr int PH_PER_LAYER = 11, N_PHASES = 1 + NL * PH_PER_LAYER + 1;
__global__ void __launch_bounds__(NTHREADS, 2) fwd_kernel(Params P) {
    LAS unsigned char* lds = (LAS unsigned char*)lds_raw;
    const int wave = __builtin_amdgcn_readfirstlane((int)threadIdx.x >> 6);
    const int bid = blockIdx.x, G = gridDim.x;
    const int g_wave = wave; const int tid = TIDX;
    const int gw = bid * NWAVES + wave, NGW = G * NWAVES;
    if (tid < 64) ((LAS unsigned*)(lds + LDSCTL_OFF))[tid] = 0u;
    if (tid == 0) {
#pragma unroll
        for (int i = 0; i < 29; ++i) *(LAS unsigned long long*)(lds + PTRS_OFF + 8 * i) = (unsigned long long)P.in[i]; }
    __syncthreads();
    unsigned* ctl = (unsigned*)(wsptr(P) + WS_CTL);
#if MK_ONE_LAUNCH
    XcdBarrier bar = xcd_barrier_post(ctl + CW_BAR, (volatile LAS unsigned*)(lds + MISC_OFF) + 8, wave);
#define SEAM() xcd_barrier(bar, wave)
#else
#define SEAM() do {} while (0)
#endif
    const int lo = P.ph_lo, hi = P.ph_hi;
#ifndef KMASK
#define KMASK 0xffff
#endif
#define IN(k) (lo <= (k) && (k) < hi)
#define KIND(j) ((KMASK >> (j)) & 1)
#define BOTH(k) (IN(k) && IN((k) + 1))
    bf16_t* WB = (bf16_t*)(wsptr(P) + WS_WB); float* X = (float*)(wsptr(P) + WS_X); bf16_t* H = (bf16_t*)(wsptr(P) + WS_H);
    bf16_t* YS = (bf16_t*)(wsptr(P) + WS_YS); bf16_t* MRG = (bf16_t*)(wsptr(P) + WS_MRG); bf16_t* HID = (bf16_t*)(wsptr(P) + WS_HID);
    bf16_t* PROJ = (bf16_t*)(wsptr(P) + WS_R1); bf16_t* SG = PROJ + (size_t)M * 2048; bf16_t* Y2 = (bf16_t*)(wsptr(P) + WS_R1);
    const float* MOD = (const float*)(wsptr(P) + WS_SMALL + SM_MOD);

    if (KIND(0) && IN(0)) { phase_ada(P, lds, bid, G, wave); if (BOTH(0)) SEAM(); }

    for (int l = 0; l < NL; ++l) {
        const int pb = 1 + l * PH_PER_LAYER;
        if (KIND(1) && IN(pb + 0)) {
            phase_convert(P, lds, l, gw, NGW, wave);
            __syncthreads();
            if (l == 0) phase_norm1<0>(P, lds, l, gw, NGW, wave); else phase_norm1<1>(P, lds, l, gw, NGW, wave);
            if (BOTH(pb + 0)) SEAM();
        }
        if (KIND(2) && IN(pb + 1)) {
            if (bid == 0) { scan_logf(P, wave); VM_WAIT(); __syncthreads(); }
            pg8::Gemm g{H, WB + WB_WIN, 1024, 1024, 1024, nullptr}; SchedDense S{64, 24, G, bid, 1024, 1024}; Epi1 E{PROJ, SG};
            pg8::gemm_phase<Epi1, SchedDense, false>(lds, g, S, E, wave);
            if (BOTH(pb + 1)) SEAM();
        }
        if (KIND(3) && IN(pb + 2)) {
#ifndef MMASK
#define MMASK 15
#endif
            if (MMASK & 1) for (int u = bid; u < 256; u += G) pool_unit(P, lds, l, u, wave);
            if (MMASK & 2) for (int u = bid; u < 256; u += G) sg_unit(P, lds, l, u, wave);
            if (MMASK & 4) for (int u = bid; u < 256; u += G) conv_unit(P, lds, l, u, wave);
            if (MMASK & 8) for (int i = 0, u = bid; u < 1024; u += G, ++i) { const int bh = u >> 7, qt = u & 127; attn_naive_unit(P, lds, (bh << 7) | ((i & 1) ? 127 - qt : qt), wave); }
            if (BOTH(pb + 2)) SEAM();
        }
        if (KIND(4) && IN(pb + 3)) {
            pg8::Gemm g{YS, WB + WB_WBR, 1024, 256, 256, nullptr}; SchedG2 S{G, bid}; Epi2 E{SG, MRG};
            pg8::gemm_phase<Epi2, SchedG2, false>(lds, g, S, E, wave);
            if (BOTH(pb + 3)) SEAM();
        }
        if (KIND(5) && IN(pb + 4)) {
            pg8::Gemm g{MRG, WB + WB_WOUT, 1024, 1024, 1024, nullptr}; SchedDense S{64, 4, G, bid, 1024, 1024}; Epi3 E{l == 0 ? inptr(I_X) : X, X, MOD + (size_t)l * 2 * 6144};
            pg8::gemm_phase<Epi3, SchedDense, false>(lds, g, S, E, wave);
            if (BOTH(pb + 4)) SEAM();
        }
        if (KIND(6) && IN(pb + 5)) { phase_norm2(P, l, gw, NGW, wave); if (BOTH(pb + 5)) SEAM(); }
        if (KIND(7) && IN(pb + 6)) {
            pg8::Gemm g{H, WB, 1024, 1024, 1024, nullptr}; SchedG4 S{G, bid}; EpiUp E{(float*)(wsptr(P) + WS_SMALL + SM_RLOG), HID, nullptr};
            pg8::gemm_phase<EpiUp, SchedG4, false>(lds, g, S, E, wave);
            if (BOTH(pb + 6)) SEAM();
        }
        if (KIND(8) && IN(pb + 7)) { phase_route(P, lds, l, bid, G, wave); if (BOTH(pb + 7)) SEAM(); }
        if (KIND(9) && IN(pb + 8)) { phase_lists(P, lds, l, bid, G, wave); if (BOTH(pb + 8)) SEAM(); }
        if (KIND(10) && IN(pb + 9)) {
            const int x = bid & 7, j = bid >> 3, per = (G - x + 7) >> 3;
            const int nt = moe_tile_list(P, lds, l, x, false, wave);
            pg8::Gemm g{H, WB, 1024, 1024, 1024, (const int*)(wsptr(P) + WS_SMALL + SM_IDX)}; SchedMoe<2, false> S{(LAS const i32x4*)(lds + TL_OFF), nt, per, j};
            EpiUp E{nullptr, HID, (const float*)(wsptr(P) + WS_SMALL + SM_GW)};
            pg8::gemm_phase<EpiUp, SchedMoe<2, false>, true>(lds, g, S, E, wave);
            if (BOTH(pb + 9)) SEAM();
        }
        if (KIND(11) && IN(pb + 10)) {
            const int x = bid & 7, j = bid >> 3, per = (G - x + 7) >> 3;
            const int nt = moe_tile_list(P, lds, l, x, true, wave);
            pg8::Gemm g{HID, WB, 256, 256, 256, nullptr}; SchedMoe<4, true> S{(LAS const i32x4*)(lds + TL_OFF), nt, per, j};
            EpiDown E{Y2, X, MOD + (size_t)l * 2 * 6144};
            pg8::gemm_phase<EpiDown, SchedMoe<4, true>, false>(lds, g, S, E, wave);
            if (BOTH(pb + 10)) SEAM();
        }
    }
    if (KIND(12) && IN(N_PHASES - 1)) phase_norm1<2>(P, lds, NL, gw, NGW, wave);
#undef IN
#undef BOTH
#undef SEAM
}

extern "C" void kernel_launch(void* const* d_in, const int* in_sizes, int n_in, void* d_out, int out_size, void* d_ws, size_t ws_size, hipStream_t stream) {
    static int grid = 0;
    if (grid == 0) {
        if (n_in != 29 || out_size != M * D || ws_size < WS_END) { fprintf(stderr, "kernel_launch: unexpected shapes (n_in %d, out %d, ws %zu)\n", n_in, out_size, ws_size); grid = -1; return; }
        int dev = 0, cus = 0;
        if (hipGetDevice(&dev) != hipSuccess || hipDeviceGetAttribute(&cus, hipDeviceAttributeMultiprocessorCount, dev) != hipSuccess) { grid = -1; return; }
        if (hipFuncSetAttribute((const void*)fwd_kernel, hipFuncAttributeMaxDynamicSharedMemorySize, LDS_BYTES) != hipSuccess) { fprintf(stderr, "kernel_launch: hipFuncSetAttribute failed\n"); grid = -1; return; }
        int per_cu = 0;
        if (hipOccupancyMaxActiveBlocksPerMultiprocessor(&per_cu, (const void*)fwd_kernel, NTHREADS, LDS_BYTES) != hipSuccess || per_cu < 1) { fprintf(stderr, "kernel_launch: occupancy query says %d\n", per_cu); }
        (void)hipGetLastError();
        grid = cus;
    }
    if (grid < 0) return;
    (void)hipMemsetAsync((char*)d_ws + WS_CTL, 0, CTL_ZERO_BYTES, stream);
    Params p; memset(&p, 0, sizeof(p));
    for (int i = 0; i < 29; ++i) p.in[i] = (const float*)d_in[i];
    p.out = (float*)d_out; p.ws = (unsigned char*)d_ws;
#if MK_ONE_LAUNCH
    p.ph_lo = 0; p.ph_hi = N_PHASES;
    hipLaunchKernelGGL(fwd_kernel, dim3(grid), dim3(NTHREADS), LDS_BYTES, stream, p);
#else
    for (int k = 0; k < N_PHASES; ++k) { p.ph_lo = k; p.ph_hi = k + 1; hipLaunchKernelGGL(fwd_kernel, dim3(grid), dim3(NTHREADS), LDS_BYTES, stream, p); }
#endif
}
```

```cpp
#include <hip/hip_runtime.h>
#include <cstdio>
#include <cstdint>
#include <cstring>

#ifndef MK_ONE_LAUNCH
#define MK_ONE_LAUNCH 1
#endif

#ifndef FP8_G1
#define FP8_G1 1
#endif
#ifndef FP8_GB
#define FP8_GB 1
#endif
#ifndef FP8_GA
#define FP8_GA 1
#endif
#define LAS __attribute__((address_space(3)))
#define TIDX (g_wave * 64 + lane_id())
#define GAS __attribute__((address_space(1)))
typedef unsigned short bf16_t;
typedef short bf16x8 __attribute__((ext_vector_type(8)));
typedef float f32x4 __attribute__((ext_vector_type(4)));
typedef float f32x2 __attribute__((ext_vector_type(2)));
typedef unsigned u32x4 __attribute__((ext_vector_type(4)));
typedef unsigned u32x2 __attribute__((ext_vector_type(2)));
typedef int i32x4 __attribute__((ext_vector_type(4)));
typedef int i32x8 __attribute__((ext_vector_type(8)));

constexpr int NB = 2, SEQ = 8192, M = NB * SEQ, D = 1024, NL = 2;
constexpr int COLT = 6148;
constexpr int NE = 64, TOPK = 6, EFF = 256;
constexpr int NPAIR = M * TOPK;
constexpr float EPS = 1e-6f;
constexpr float LOG2E = 1.4426950408889634f;
constexpr float QSCALE = 0.125f * LOG2E;
constexpr int NWAVES = 8, NTHREADS = 512;

constexpr size_t MiB = 1u << 20;
constexpr size_t WS_CTL = 0;
constexpr size_t CTL_ZERO_BYTES = 1 * MiB;
constexpr size_t WS_SMALL = 1 * MiB;
constexpr size_t WS_WB = 24 * MiB;
constexpr size_t WS_X = 138 * MiB;
constexpr size_t WS_H = 202 * MiB;
constexpr size_t WS_YS = 234 * MiB;
constexpr size_t WS_MRG = 266 * MiB;
constexpr size_t WS_HID = 298 * MiB;
constexpr size_t WS_R1 = 354 * MiB;
constexpr size_t Y2SC_OFF = 112 * MiB;
constexpr size_t WS_HF8 = 546 * MiB;
constexpr size_t WS_END = 562 * MiB;
constexpr size_t WB_WIN = 0;
constexpr size_t WB_WBR = WB_WIN + (size_t)6144 * 1024;
constexpr size_t WB_WOUT = WB_WBR + (size_t)4 * 1024 * 256;
constexpr size_t WB_WR = WB_WOUT + (size_t)1024 * 1024;
constexpr size_t WB_W13 = WB_WR + (size_t)256 * 1024;
constexpr size_t WB_W2 = WB_W13 + (size_t)65 * 512 * 1024;
constexpr size_t WB_ELEMS = WB_W2 + (size_t)65 * 1024 * 256;
static_assert(WB_ELEMS * 2 <= 114 * MiB, "weights region");
constexpr size_t SM_MOD = 0;
constexpr size_t SM_LOGF = 128 * 1024;
constexpr size_t SM_CUM = SM_LOGF + (size_t)M * 16;
constexpr size_t SM_CB = SM_CUM + (size_t)8 * SEQ * 4;
constexpr int CAP = 16384;
constexpr size_t SM_TE = SM_CB + (size_t)8 * SEQ * 32;
constexpr size_t SM_TP = SM_TE + (size_t)NPAIR * 4;
constexpr size_t SM_IDXP = SM_TP + (size_t)NPAIR * 4;
constexpr size_t SM_GWP = SM_IDXP + (size_t)65 * CAP * 4;
constexpr size_t SM_SGWM = SM_GWP + (size_t)64 * CAP * 4;
constexpr size_t SM_PWT = SM_SGWM + (size_t)4 * 128 * 128 * 2;
constexpr size_t SM_END = SM_PWT + (size_t)4 * 64 * 64 * 2;
static_assert(SM_END <= 23 * MiB, "small region");
constexpr int CW_BAR = 4096;
constexpr int CW_CNT = 16384;
constexpr int CW_Q = 16384 + 256;
constexpr int CW_QS = 16384 + 4096;
constexpr int CW_NRM = 16384 + 512;

constexpr int RING_BYTES = 131072;
constexpr int LDSCTL_OFF = RING_BYTES;
constexpr int MISC_OFF = LDSCTL_OFF;
constexpr int TL_OFF = LDSCTL_OFF + 256;
constexpr int TLN_OFF = TL_OFF + 512 * 16;
constexpr int EOFF_OFF = TLN_OFF + 16;
constexpr int PTRS_OFF = EOFF_OFF + 3 * 64 * 4;
constexpr int LDS_BYTES = 147456;
static_assert(PTRS_OFF + 32 * 8 <= LDS_BYTES, "LDS map");

__device__ __forceinline__ int lane_id() { int r; asm volatile("v_mbcnt_lo_u32_b32 %0, -1, 0\n\tv_mbcnt_hi_u32_b32 %0, -1, %0" : "=v"(r)); return r; }
__device__ __forceinline__ int opaque(int v) { asm volatile("" : "+v"(v)); return v; }
#define LDS_WAIT() asm volatile("s_waitcnt lgkmcnt(0)" ::: "memory")
#define VM_WAIT() asm volatile("s_waitcnt vmcnt(0)" ::: "memory")
__device__ __forceinline__ unsigned cvt_pk_bf16(float lo, float hi) { unsigned r; asm volatile("v_cvt_pk_bf16_f32 %0, %1, %2" : "=v"(r) : "v"(lo), "v"(hi)); return r; }
__device__ __forceinline__ float bflo(unsigned w) { return __uint_as_float(w << 16); }
__device__ __forceinline__ float bfhi(unsigned w) { return __uint_as_float(w & 0xffff0000u); }
__device__ __forceinline__ float bf2f(bf16_t h) { return __uint_as_float((unsigned)h << 16); }
__device__ __forceinline__ bf16_t f2bf(float f) { return (bf16_t)(cvt_pk_bf16(f, 0.f) & 0xffffu); }
#define DPPI(old, src, ctrl, rm, bm) __builtin_amdgcn_update_dpp((int)(old), (int)(src), ctrl, rm, bm, false)
#define DPPF(old, src, ctrl, rm, bm) __builtin_bit_cast(float, __builtin_amdgcn_update_dpp(__builtin_bit_cast(int, (float)(old)), __builtin_bit_cast(int, (float)(src)), ctrl, rm, bm, false))
__device__ __forceinline__ float wave_max_dpp(float v) {
    v = fmaxf(v, DPPF(v, v, 0x111, 0xf, 0xf)); v = fmaxf(v, DPPF(v, v, 0x112, 0xf, 0xf)); v = fmaxf(v, DPPF(v, v, 0x114, 0xf, 0xf)); v = fmaxf(v, DPPF(v, v, 0x118, 0xf, 0xf));
    v = fmaxf(v, DPPF(v, v, 0x142, 0xa, 0xf)); v = fmaxf(v, DPPF(v, v, 0x143, 0xc, 0xf));
    return __builtin_bit_cast(float, __builtin_amdgcn_readlane(__builtin_bit_cast(int, v), 63));
}
__device__ __forceinline__ float wave_sum_dpp(float v) {
    v += DPPF(0.f, v, 0x111, 0xf, 0xf); v += DPPF(0.f, v, 0x112, 0xf, 0xf); v += DPPF(0.f, v, 0x114, 0xf, 0xf); v += DPPF(0.f, v, 0x118, 0xf, 0xf);
    v += DPPF(0.f, v, 0x142, 0xa, 0xf); v += DPPF(0.f, v, 0x143, 0xc, 0xf);
    return __builtin_bit_cast(float, __builtin_amdgcn_readlane(__builtin_bit_cast(int, v), 63));
}
__device__ __forceinline__ float grp8_max_dpp(float v) { v = fmaxf(v, DPPF(v, v, 0xB1, 0xf, 0xf)); v = fmaxf(v, DPPF(v, v, 0x4E, 0xf, 0xf)); v = fmaxf(v, DPPF(v, v, 0x141, 0xf, 0xf)); return v; }
__device__ __forceinline__ int grp8_min_dpp(int v) { v = min(v, DPPI(v, v, 0xB1, 0xf, 0xf)); v = min(v, DPPI(v, v, 0x4E, 0xf, 0xf)); v = min(v, DPPI(v, v, 0x141, 0xf, 0xf)); return v; }
__device__ __forceinline__ float wave_sum(float v) { return wave_sum_dpp(v); }
__device__ __forceinline__ float fq_max(float m) {
    auto r = __builtin_amdgcn_permlane16_swap(__float_as_uint(m), __float_as_uint(m), false, false); m = fmaxf(__uint_as_float(r[0]), __uint_as_float(r[1]));
    auto r2 = __builtin_amdgcn_permlane32_swap(__float_as_uint(m), __float_as_uint(m), false, false); return fmaxf(__uint_as_float(r2[0]), __uint_as_float(r2[1])); }
__device__ __forceinline__ float fq_sum(float m) {
    auto r = __builtin_amdgcn_permlane16_swap(__float_as_uint(m), __float_as_uint(m), false, false); m = __uint_as_float(r[0]) + __uint_as_float(r[1]);
    auto r2 = __builtin_amdgcn_permlane32_swap(__float_as_uint(m), __float_as_uint(m), false, false); return __uint_as_float(r2[0]) + __uint_as_float(r2[1]); }
__device__ __forceinline__ float row16_max_dpp(float v) { v = grp8_max_dpp(v); return fmaxf(v, DPPF(v, v, 0x140, 0xf, 0xf)); }
__device__ __forceinline__ float wave_scan_dpp(float v) {
    v += DPPF(0.f, v, 0x111, 0xf, 0xf); v += DPPF(0.f, v, 0x112, 0xf, 0xf); v += DPPF(0.f, v, 0x114, 0xf, 0xf); v += DPPF(0.f, v, 0x118, 0xf, 0xf);
    v += DPPF(0.f, v, 0x142, 0xa, 0xf); v += DPPF(0.f, v, 0x143, 0xc, 0xf); return v; }
__device__ __forceinline__ float fexp2(float x) { return __builtin_amdgcn_exp2f(x); }
__device__ __forceinline__ float frcp(float x) { return __builtin_amdgcn_rcpf(x); }
__device__ __forceinline__ float sigmoidf_(float x) { return frcp(1.f + fexp2(-LOG2E * x)); }
__device__ __forceinline__ float siluf_(float x) { return x * sigmoidf_(x); }
__device__ __forceinline__ float gelu_tanh(float x) {
    const float u = x + 0.044715f * x * x * x;
    return x * frcp(1.f + fexp2(-2.f * 0.7978845608028654f * LOG2E * u));
}

namespace pg8 {
constexpr int BM = 256, BK = 64, HALF = 128, HTB = HALF * BK * 2, STAGE_BYTES = 8 * HTB, NXCD = 8, WGM = 8;
__host__ __device__ __forceinline__ int lds_byte(int r, int c) { const int st = (r >> 4) * 2 + (c >> 5), rr = r & 15, cc = c & 31, ob = rr * 64 + cc * 2; return st * 1024 + (ob ^ (((ob >> 9) & 1) << 5)); }
__host__ __device__ __forceinline__ void stage_rc(int b, int& R, int& C) { const int st = b / 1024, sb = b % 1024, swz = sb ^ (((sb >> 9) & 1) << 5); R = (st >> 1) * 16 + swz / 64; C = (st & 1) * 32 + (swz % 64) / 2; }
__host__ __device__ __forceinline__ int perm32(int rho) { const int n = rho >> 4, i = rho & 15; return 8 * (i >> 2) + 4 * n + (i & 3); }

struct Unit { int pm, pn; int a, b, c, e; size_t aoff, boff; };
struct Gemm { const bf16_t* A; const bf16_t* Bt; int lda, ldb, K; const int* idx; };

__device__ __forceinline__ bool static_tile(int i, int G, int c, int nM, int nN, int& pm, int& pn) {
    const int nwg = nM * nN; const long L = (long)i * G + c; if (L >= nwg) return false;
    int wgid = (int)L; { const int q = nwg / NXCD, r = nwg % NXCD, xcd = wgid % NXCD, off = wgid / NXCD; wgid = (xcd < r ? xcd * (q + 1) : r * (q + 1) + (xcd - r) * q) + off; }
    const int nig = WGM * nN, gid = wgid / nig, fm = gid * WGM, gsz = (nM - fm) < WGM ? (nM - fm) : WGM;
    pm = fm + ((wgid % nig) % gsz); pn = (wgid % nig) / gsz; return true;
}

template <class Epi, class Sched, bool GATHER = false, bool FP8 = false>
__device__ __forceinline__ void gemm_phase(LAS unsigned char* lds, const Gemm g, const Sched& S, const Epi& E, const int g_wave) {
    const int tid = TIDX, wid = __builtin_amdgcn_readfirstlane(tid >> 6), lane = tid & 63, wr = wid >> 2, wc = wid & 3, fr = lane & 15, fq = lane >> 4;
    constexpr int NBJ = Epi::NBJ;
    const int K = g.K, nt = K / BK;
    unsigned voffA[2], voffB[2];
#pragma unroll
    for (int i = 0; i < 2; ++i) { int R, C; stage_rc(tid * 16 + i * 8192, R, C); const int Rb = Epi::PERM ? ((R & ~31) + perm32(R & 31)) : R;
        voffA[i] = (unsigned)(R * g.lda + C) * 2u; voffB[i] = (unsigned)(Rb * g.ldb + C) * 2u; }
    const size_t kstep = (size_t)(BK * 2);
    const size_t hstepA = GATHER ? 0 : (size_t)HALF * g.lda * 2, hstepB = (size_t)HALF * g.ldb * 2;
    const unsigned ldsw = (unsigned)wid * 1024u;
    const int aoff = lds_byte(wr * 64 + fr, fq * 8), boff = lds_byte(wc * 32 + fr, fq * 8);
    unsigned vC[2], vN[2];
#define PG8_SA(b, h) (((b) * 2 + (h)) * HTB)
#define PG8_SB(b, h) ((4 + (b) * 2 + (h)) * HTB)
#define PG8_STAGE(bufoff, gbase, voff) do { _Pragma("unroll") for (int _i = 0; _i < 2; ++_i) { unsigned _vo = (voff)[_i]; asm volatile("" : "+v"(_vo)); \
        __builtin_amdgcn_global_load_lds((const unsigned*)((const char*)(gbase) + _vo), (LAS unsigned*)(lds + (bufoff) + ldsw + _i * 8192), 16, 0, 0); } } while (0)
#define PG8_STAGEA(bufoff, p, h, nx) do { if constexpr (GATHER) { const unsigned _pk = (nx) ? vN[h] : vC[h]; unsigned _v[2]; int _R, _C; \
            stage_rc(tid * 16, _R, _C); _v[0] = ((_pk & 0xffffu) * (unsigned)g.lda + (unsigned)_C) * 2u; stage_rc(tid * 16 + 8192, _R, _C); _v[1] = ((_pk >> 16) * (unsigned)g.lda + (unsigned)_C) * 2u; PG8_STAGE(bufoff, p, _v); } \
        else { PG8_STAGE(bufoff, (p) + (h) * hstepA, voffA); } } while (0)
#define PG8_LD8(p) __builtin_shufflevector(*(const LAS i32x4*)(p), *(const LAS i32x4*)((p) + 1024), 0, 1, 2, 3, 4, 5, 6, 7)
#define PG8_LDA(dst, b, h) do { _Pragma("unroll") for (int m = 0; m < 4; ++m) dst[m] = PG8_LD8(lds + PG8_SA(b, h) + aoff + m * 2048); } while (0)
#define PG8_LDB(dst, b, h) do { _Pragma("unroll") for (int n = 0; n < 2; ++n) dst[n] = PG8_LD8(lds + PG8_SB(b, h) + boff + n * 2048); } while (0)
#define PG8_HALF(F, k) __builtin_bit_cast(bf16x8, __builtin_shufflevector(F, F, 4 * (k), 4 * (k) + 1, 4 * (k) + 2, 4 * (k) + 3))
#define PG8_MMA(ai, bj, At, Bt) do { __builtin_amdgcn_s_setprio(1); _Pragma("unroll") for (int m = 0; m < 4; ++m) _Pragma("unroll") for (int n = 0; n < 2; ++n) { \
        if constexpr (FP8) asm("v_mfma_f32_16x16x128_f8f6f4 %0, %1, %2, %0" : "+v"(acc[ai][bj][m][n]) : "v"(Bt[n]), "v"(At[m])); \
        else { acc[ai][bj][m][n] = __builtin_amdgcn_mfma_f32_16x16x32_bf16(PG8_HALF(Bt[n], 0), PG8_HALF(At[m], 0), acc[ai][bj][m][n], 0, 0, 0); \
               acc[ai][bj][m][n] = __builtin_amdgcn_mfma_f32_16x16x32_bf16(PG8_HALF(Bt[n], 1), PG8_HALF(At[m], 1), acc[ai][bj][m][n], 0, 0, 0); } } \
        __builtin_amdgcn_s_setprio(0); } while (0)
#define PG8_WAIT_V(n) asm volatile("s_waitcnt vmcnt(" #n ")" ::: "memory")
#define PG8_WAIT_L(n) asm volatile("s_waitcnt lgkmcnt(" #n ")" ::: "memory")
#define PG8_BAR __builtin_amdgcn_s_barrier()
#define PG8_SCHED __builtin_amdgcn_sched_barrier(0)
#define PG8_GLOAD(dst, U) do { _Pragma("unroll") for (int _h = 0; _h < 2; ++_h) { unsigned _pk = 0u; _Pragma("unroll") for (int _i = 0; _i < 2; ++_i) { int _R, _C; stage_rc(tid * 16 + _i * 8192, _R, _C); \
        const int _r = _h * HALF + _R; int _row = g.idx[(U).c + _r]; _row = (_r < (U).b) ? _row : 0; _pk |= (unsigned)_row << (16 * _i); } dst[_h] = _pk; } } while (0)
    Unit cur, nxt; int ui = 0;
    if (!S.next(0, cur)) return;
    f32x4 acc[2][2][4][2];
#pragma unroll
    for (int a = 0; a < 2; ++a)
#pragma unroll
        for (int b = 0; b < 2; ++b)
#pragma unroll
            for (int m = 0; m < 4; ++m)
#pragma unroll
                for (int n = 0; n < 2; ++n) acc[a][b][m][n] = (f32x4){0.f, 0.f, 0.f, 0.f};
    i32x8 At[4], B0[2], B1[2];
    const char* cA = (const char*)g.A + cur.aoff; const char* cB = (const char*)g.Bt + cur.boff;
    if constexpr (GATHER) { PG8_GLOAD(vC, cur); PG8_GLOAD(vN, cur); }
    PG8_STAGE(PG8_SB(0, 0), cB, voffB); if constexpr (NBJ == 2) PG8_STAGE(PG8_SB(0, 1), cB + hstepB, voffB); PG8_STAGEA(PG8_SA(0, 0), cA, 0, false); PG8_STAGEA(PG8_SA(0, 1), cA, 1, false);
    if (wr == 1) PG8_BAR;
    PG8_WAIT_V(2); PG8_BAR;
    PG8_STAGE(PG8_SB(1, 0), cB + kstep, voffB); PG8_STAGEA(PG8_SA(1, 0), cA + kstep, 0, false); if constexpr (NBJ == 2) PG8_STAGE(PG8_SB(1, 1), cB + hstepB + kstep, voffB);
    if constexpr (NBJ == 2) PG8_WAIT_V(6); else PG8_WAIT_V(4);
    PG8_BAR;
    for (;;) {
        const bool has_next = S.next(ui + 1, nxt);
        const char* nA = has_next ? (const char*)g.A + nxt.aoff : cA; const char* nB = has_next ? (const char*)g.Bt + nxt.boff : cB;
        if constexpr (GATHER) { if (has_next) { PG8_GLOAD(vN, nxt); } else { vN[0] = vC[0]; vN[1] = vC[1]; }
            asm volatile("s_waitcnt vmcnt(0)" : "+v"(vN[0]), "+v"(vN[1]) :: "memory"); }
#pragma unroll 1
        for (int t = 0; t < nt; t += 2) {
            const bool last = (t == nt - 2);
            const char* a1 = cA + (size_t)(t + 1) * kstep;
            const char* a2 = last ? nA : cA + (size_t)(t + 2) * kstep; const char* b2 = last ? nB : cB + (size_t)(t + 2) * kstep;
            const char* a3 = a2 + kstep; const char* b3 = b2 + kstep;
#define PG8_WAIT_K() do { if constexpr (NBJ == 2) PG8_WAIT_V(8); else PG8_WAIT_V(6); } while (0)
            PG8_LDB(B0, 0, 0); if constexpr (NBJ == 2) PG8_LDB(B1, 0, 1); PG8_SCHED; PG8_LDA(At, 0, 0); PG8_STAGEA(PG8_SA(1, 1), a1, 1, false);
            PG8_WAIT_K(); PG8_WAIT_L(0); PG8_BAR; PG8_MMA(0, 0, At, B0); if constexpr (NBJ == 2) PG8_MMA(0, 1, At, B1); PG8_BAR; PG8_SCHED;
            PG8_LDA(At, 0, 1); PG8_STAGE(PG8_SB(0, 0), b2, voffB); if constexpr (NBJ == 2) PG8_STAGE(PG8_SB(0, 1), b2 + hstepB, voffB); PG8_STAGEA(PG8_SA(0, 0), a2, 0, last);
            PG8_WAIT_K(); PG8_WAIT_L(0); PG8_BAR; PG8_MMA(1, 0, At, B0); if constexpr (NBJ == 2) PG8_MMA(1, 1, At, B1); PG8_BAR; PG8_SCHED;
            PG8_LDB(B0, 1, 0); if constexpr (NBJ == 2) PG8_LDB(B1, 1, 1); PG8_SCHED; PG8_LDA(At, 1, 0); PG8_STAGEA(PG8_SA(0, 1), a2, 1, last);
            PG8_WAIT_K(); PG8_WAIT_L(0); PG8_BAR; PG8_MMA(0, 0, At, B0); if constexpr (NBJ == 2) PG8_MMA(0, 1, At, B1); PG8_BAR; PG8_SCHED;
            PG8_LDA(At, 1, 1); PG8_STAGE(PG8_SB(1, 0), b3, voffB); if constexpr (NBJ == 2) PG8_STAGE(PG8_SB(1, 1), b3 + hstepB, voffB); PG8_STAGEA(PG8_SA(1, 0), a3, 0, last);
            PG8_WAIT_K(); PG8_WAIT_L(0); PG8_BAR; PG8_MMA(1, 0, At, B0); if constexpr (NBJ == 2) PG8_MMA(1, 1, At, B1); PG8_BAR; PG8_SCHED;
#undef PG8_WAIT_K
        }
        if (wr == 0) PG8_BAR;
        if constexpr (FP8) asm volatile("s_nop 15\n\ts_nop 15" ::: "memory");
        E(acc, cur, wr, wc, fr, fq);
        if (!has_next) break;
#pragma unroll
        for (int a = 0; a < 2; ++a)
#pragma unroll
            for (int b = 0; b < 2; ++b)
#pragma unroll
                for (int m = 0; m < 4; ++m)
#pragma unroll
                    for (int n = 0; n < 2; ++n) acc[a][b][m][n] = (f32x4){0.f, 0.f, 0.f, 0.f};
        cur = nxt; cA = nA; cB = nB; ++ui;
        if constexpr (GATHER) { vC[0] = vN[0]; vC[1] = vN[1]; }
        if (wr == 1) PG8_BAR;
    }
    PG8_WAIT_V(0);
    PG8_BAR;
#undef PG8_SA
#undef PG8_SB
#undef PG8_STAGE
#undef PG8_STAGEA
#undef PG8_LDA
#undef PG8_LDB
#undef PG8_MMA
#undef PG8_HALF
#undef PG8_LD8
#undef PG8_WAIT_V
#undef PG8_WAIT_L
#undef PG8_BAR
#undef PG8_SCHED
#undef PG8_GLOAD
}
}

#define XB_TMO      128
#define XB_XCNT(j)  (256  + 64 * (j))
#define XB_XSUB(j)  (1280 + 64 * (j))
#define XB_XGEN(j)  (2304 + 64 * (j))
#define XB_TOP      3328
#define XB_TOPGEN   3392
#define XCD_BAR_WORDS 3456
#define XB_SPIN_CAP (1u << 18)
__device__ __forceinline__ unsigned xb_ld(unsigned* p)              { return __hip_atomic_load(p, __ATOMIC_RELAXED, __HIP_MEMORY_SCOPE_AGENT); }
__device__ __forceinline__ unsigned xb_add(unsigned* p, unsigned v) { return __hip_atomic_fetch_add(p, v, __ATOMIC_RELAXED, __HIP_MEMORY_SCOPE_AGENT); }
__device__ __forceinline__ unsigned xb_xcc_id() { return (unsigned)__builtin_amdgcn_s_getreg((3 << 11) | 20) & 0xFu; }
#define XB_SPIN(cond, bar) do { unsigned _sp = 0; while (cond) { __builtin_amdgcn_s_sleep(1); \
    if ((++_sp & 255u) == 0u) { if (xb_ld(&(bar)[XB_TMO])) break; if (_sp > XB_SPIN_CAP) { atomicAdd(&(bar)[XB_TMO], 1u); break; } } } } while (0)
struct XcdBarrier { unsigned* bar; unsigned x; volatile LAS unsigned* st; };
__device__ __forceinline__ XcdBarrier xcd_barrier_post(unsigned* bar, volatile LAS unsigned* st, const int g_wave) {
    XcdBarrier b; b.bar = bar; b.x = xb_xcc_id(); b.st = st;
    if (TIDX == 0) (void)xb_add(&bar[XB_XCNT(b.x)], 1u);
    return b;
}
__device__ __forceinline__ void xcd_barrier_complete(unsigned* bar, unsigned x, unsigned& nloc, unsigned& nx) {
    const unsigned G = gridDim.x * gridDim.y * gridDim.z;
    unsigned sum, cnt, mine, sp = 0u;
    for (;;) {
        sum = 0u; cnt = 0u; mine = 0u;
#pragma unroll
        for (unsigned j = 0; j < 16; ++j) { const unsigned c = xb_ld(&bar[XB_XCNT(j)]); sum += c; cnt += (c > 0u) ? 1u : 0u; mine = (j == x) ? c : mine; }
        if (sum == G) break;
        __builtin_amdgcn_s_sleep(1);
        if ((++sp & 255u) == 0u) { if (xb_ld(&bar[XB_TMO])) break; if (sp > XB_SPIN_CAP) { atomicAdd(&bar[XB_TMO], 1u); break; } }
    }
    nloc = mine > 0u ? mine : 1u; nx = cnt > 0u ? cnt : 1u;
}
__device__ __forceinline__ void xcd_barrier(const XcdBarrier& b, const int g_wave) {
    asm volatile("s_waitcnt vmcnt(0)" ::: "memory");
    __syncthreads();
    if (TIDX == 0) {
        unsigned* bar = b.bar;
        __builtin_amdgcn_s_waitcnt(0);
        unsigned nloc = b.st[0], nx = b.st[1];
        if (nloc == 0u) { xcd_barrier_complete(bar, b.x, nloc, nx); b.st[0] = nloc; b.st[1] = nx; }
        const unsigned old = xb_add(&bar[XB_XSUB(b.x)], 1u);
        const unsigned gen = old / nloc;
        if (old + 1u == (gen + 1u) * nloc) {
            __builtin_amdgcn_fence(__ATOMIC_RELEASE, "agent");
            asm volatile("s_waitcnt vmcnt(0)" ::: "memory");
            const unsigned og = xb_add(&bar[XB_TOP], 1u);
            const unsigned tg = og / nx;
            if (og + 1u == (tg + 1u) * nx) xb_add(&bar[XB_TOPGEN], 1u);
            else XB_SPIN(xb_ld(&bar[XB_TOPGEN]) == tg, bar);
            __builtin_amdgcn_fence(__ATOMIC_ACQUIRE, "agent");
            xb_add(&bar[XB_XGEN(b.x)], 1u);
            asm volatile("s_waitcnt vmcnt(0)" ::: "memory");
        } else {
            XB_SPIN(xb_ld(&bar[XB_XGEN(b.x)]) == gen, bar);
            __builtin_amdgcn_fence(__ATOMIC_ACQUIRE, "agent");
            asm volatile("s_waitcnt vmcnt(0)" ::: "memory");
        }
    }
    __syncthreads();
}

struct Params { const float* in[29]; float* out; unsigned char* ws; int ph_lo, ph_hi; };
extern __shared__ __attribute__((aligned(16))) unsigned char lds_raw[];
__device__ __forceinline__ const float* inptr(int i) { u32x2 v = *(const LAS u32x2*)((LAS unsigned char*)lds_raw + PTRS_OFF + 8 * i); asm volatile("" : "+v"(v));
    GAS const float* gp = (GAS const float*)(((unsigned long long)(unsigned)__builtin_amdgcn_readfirstlane((int)v.y) << 32) | (unsigned long long)(unsigned)__builtin_amdgcn_readfirstlane((int)v.x));
    return (const float*)gp; }
__device__ __forceinline__ unsigned char* wsptr(const Params&) { return (unsigned char*)inptr(29); }
enum { I_X = 0, I_C, I_WIN, I_BF, I_POOLW, I_POOLS, I_SGLG, I_SGLB, I_SGW, I_SGB, I_CONVW, I_CONVB, I_CLG, I_CLB, I_WBR, I_WOUT, I_MNG, I_FNG, I_ADAW, I_ADAB,
       I_RW, I_RB, I_EW1, I_EW3, I_EW2, I_SW1, I_SW3, I_SW2, I_FING };

__device__ __forceinline__ void phase_ada(const Params& P, LAS unsigned char* lds, int bid, int G, const int g_wave) {
    const int tid = TIDX, lane = tid & 63, wave = tid >> 6;
    LAS float* sc = (LAS float*)lds; LAS float* red = (LAS float*)(lds + 8192);
    const float* c = inptr(I_C); float* MOD = (float*)(wsptr(P) + WS_SMALL + SM_MOD);
    for (int i = tid; i < 2048; i += NTHREADS) { const float v = c[i]; sc[i] = v / (1.f + __expf(-v)); }
    __syncthreads();
    for (int ch = bid; ch < 192; ch += G) {
        const int l = ch / 96, n0 = (ch % 96) * 64;
        const float* W = inptr(I_ADAW) + (size_t)l * 1024 * 6144 + n0 + lane;
        float a0 = 0.f, a1 = 0.f;
#pragma unroll 16
        for (int k = 0; k < 128; ++k) { const int kk = wave * 128 + k; const float w = W[(size_t)kk * 6144]; a0 += sc[kk] * w; a1 += sc[1024 + kk] * w; }
        red[(wave * 2 + 0) * 64 + lane] = a0; red[(wave * 2 + 1) * 64 + lane] = a1;
        __syncthreads();
        if (tid < 128) { const int b = tid >> 6; float s = 0.f;
#pragma unroll
            for (int w = 0; w < 8; ++w) s += red[(w * 2 + b) * 64 + lane];
            MOD[(size_t)(l * 2 + b) * 6144 + n0 + lane] = s + inptr(I_ADAB)[l * 6144 + n0 + lane]; }
        __syncthreads();
    }
}

__device__ __forceinline__ float clamp448(float x) { return __builtin_fminf(__builtin_fmaxf(x, -448.f), 448.f); }
__device__ __forceinline__ unsigned pk4_fp8(float a, float b, float c, float d) { a = clamp448(a); b = clamp448(b); c = clamp448(c); d = clamp448(d); int w = __builtin_amdgcn_cvt_pk_fp8_f32(a, b, 0, false); w = __builtin_amdgcn_cvt_pk_fp8_f32(c, d, w, true); return (unsigned)w; }
__device__ __forceinline__ void cvt_item_fp8(const float* __restrict__ src, int ldw, unsigned char* __restrict__ dst, int ldd, float scale, LAS unsigned* T, int lane) {
    const int kp = lane >> 4, ng = lane & 15;
    f32x4 v[16];
#pragma unroll
    for (int j = 0; j < 4; ++j)
#pragma unroll
        for (int h = 0; h < 4; ++h) v[4 * j + h] = __builtin_nontemporal_load((const f32x4*)(src + (size_t)(16 * j + 4 * kp + h) * ldw + 4 * ng));
#pragma unroll
    for (int j = 0; j < 4; ++j)
#pragma unroll
        for (int i = 0; i < 4; ++i) T[(4 * ng + i) * 17 + 4 * j + kp] = pk4_fp8(v[4 * j][i] * scale, v[4 * j + 1][i] * scale, v[4 * j + 2][i] * scale, v[4 * j + 3][i] * scale);
    LDS_WAIT();
#pragma unroll 8
    for (int s = 0; s < 16; ++s) { const int n = 4 * s + (lane >> 4), kd = lane & 15; ((unsigned*)(dst + (size_t)n * ldd))[kd] = T[n * 17 + kd]; }
    LDS_WAIT();
}
__device__ __forceinline__ void cvt_item(const float* __restrict__ src, int ldw, bf16_t* __restrict__ dst, int ldd, LAS unsigned* T, int lane) {
    const int kp = lane >> 4, ng = lane & 15;
    f32x4 v[16];
#pragma unroll
    for (int j = 0; j < 8; ++j)
#pragma unroll
        for (int h = 0; h < 2; ++h) v[2 * j + h] = __builtin_nontemporal_load((const f32x4*)(src + (size_t)(8 * j + 2 * kp + h) * ldw + 4 * ng));
#pragma unroll
    for (int j = 0; j < 8; ++j)
#pragma unroll
        for (int i = 0; i < 4; ++i) T[(4 * ng + i) * 33 + 4 * j + kp] = cvt_pk_bf16(v[2 * j][i], v[2 * j + 1][i]);
    LDS_WAIT();
#pragma unroll 8
    for (int s = 0; s < 32; ++s) { const int n = 2 * s + (lane >> 5), kd = lane & 31; ((unsigned*)(dst + (size_t)n * ldd))[kd] = T[n * 33 + kd]; }
    LDS_WAIT();
}
constexpr int CVT_EARLY = 512 + 1024 + 256 + 256, CVT_ALL = CVT_EARLY + 3 * 65 * 64;
template <bool SMALLS>
__device__ __forceinline__ void phase_convert(const Params& P, LAS unsigned char* lds, int l, int gw, int NGW, const int g_wave, int it0, int it1) {
    const int tid_ = TIDX, lane = tid_ & 63, wave = tid_ >> 6;
    LAS unsigned* T = (LAS unsigned*)(lds + wave * 8448);
    bf16_t* WB = (bf16_t*)(wsptr(P) + WS_WB);
    constexpr int C0 = 512, C1 = 1024, C2 = 256, C3 = 256, C4 = 0, C5 = 65 * 64, C6 = 65 * 64, C7 = 65 * 64;
    constexpr int NITEMS = C0 + C1 + C2 + C3 + C4 + C5 + C6 + C7;
    for (int it = it0 + gw; it < it1; it += NGW) {
        int r = it;
#if FP8_G1
        if (r < C0) { const int nb = r & 31, kb = r >> 5; cvt_item_fp8(inptr(I_WIN) + (size_t)l * 1024 * COLT + (size_t)kb * 64 * COLT + 64 * nb, COLT, (unsigned char*)(WB + WB_WIN) + (size_t)(64 * nb) * 1024 + kb * 64, 1024, 64.f, T, lane); continue; } r -= C0;
        if (r < C1) { const int nb = r & 63, kb = r >> 6; cvt_item_fp8(inptr(I_WIN) + (size_t)l * 1024 * COLT + (size_t)kb * 64 * COLT + 2052 + 64 * nb, COLT, (unsigned char*)(WB + WB_WIN) + (size_t)(2048 + 64 * nb) * 1024 + kb * 64, 1024, 64.f, T, lane); continue; } r -= C1;
#else
        if (r < C0) { const int nb = r & 31, kb = r >> 5; cvt_item(inptr(I_WIN) + (size_t)l * 1024 * COLT + (size_t)kb * 64 * COLT + 64 * nb, COLT, WB + WB_WIN + (size_t)(64 * nb) * 1024 + kb * 64, 1024, T, lane); continue; } r -= C0;
        if (r < C1) { const int nb = r & 63, kb = r >> 6; cvt_item(inptr(I_WIN) + (size_t)l * 1024 * COLT + (size_t)kb * 64 * COLT + 2052 + 64 * nb, COLT, WB + WB_WIN + (size_t)(2048 + 64 * nb) * 1024 + kb * 64, 1024, T, lane); continue; } r -= C1;
#endif
        if (r < C2) { const int nb = r & 15, kb = (r >> 4) & 3, n = r >> 6; cvt_item(inptr(I_WBR) + (size_t)(l * 4 + n) * 256 * 1024 + (size_t)kb * 64 * 1024 + 64 * nb, 1024, WB + WB_WBR + (size_t)(n * 1024 + 64 * nb) * 256 + kb * 64, 256, T, lane); continue; } r -= C2;
        if (r < C3) { const int nb = r & 15, kb = r >> 4; cvt_item(inptr(I_WOUT) + (size_t)l * 1024 * 1024 + (size_t)kb * 64 * 1024 + 64 * nb, 1024, WB + WB_WOUT + (size_t)(64 * nb) * 1024 + kb * 64, 1024, T, lane); continue; } r -= C3;
        if (r < C5 + C6) { const int w3 = r >= C5; if (w3) r -= C5; const int nb = r & 3, kb = (r >> 2) & 15, e = r >> 6;
            const float* src = (e < 64) ? P.in[w3 ? I_EW3 : I_EW1] + ((size_t)(l * 64 + e)) * 1024 * 256 : P.in[w3 ? I_SW3 : I_SW1] + (size_t)l * 1024 * 256;
#if FP8_GA
            cvt_item_fp8(src + (size_t)kb * 64 * 256 + 64 * nb, 256, (unsigned char*)(WB + WB_W13) + ((size_t)e * 512 + (nb >> 1) * 256 + w3 * 128 + (nb & 1) * 64) * 1024 + kb * 64, 1024, 64.f, T, lane); continue; } r -= C5 + C6;
#else
            cvt_item(src + (size_t)kb * 64 * 256 + 64 * nb, 256, WB + WB_W13 + ((size_t)e * 512 + (nb >> 1) * 256 + w3 * 128 + (nb & 1) * 64) * 1024 + kb * 64, 1024, T, lane); continue; } r -= C5 + C6;
#endif
        { const int nb = r & 15, kb = (r >> 4) & 3, e = r >> 6;
            const float* src = (e < 64) ? inptr(I_EW2) + ((size_t)(l * 64 + e)) * 256 * 1024 : inptr(I_SW2) + (size_t)l * 256 * 1024;
#if FP8_GB
            cvt_item_fp8(src + (size_t)kb * 64 * 1024 + 64 * nb, 1024, (unsigned char*)(WB + WB_W2) + ((size_t)e * 1024 + 64 * nb) * 256 + kb * 64, 256, 64.f, T, lane); }
#else
            cvt_item(src + (size_t)kb * 64 * 1024 + 64 * nb, 1024, WB + WB_W2 + ((size_t)e * 1024 + 64 * nb) * 256 + kb * 64, 256, T, lane); }
#endif
    }
    if (SMALLS) {
    { const int gt = gw * 64 + lane, NT = NGW * 64;
      bf16_t* SGWM = (bf16_t*)(wsptr(P) + WS_SMALL + SM_SGWM); const float* sgw = inptr(I_SGW) + (size_t)l * 4 * 128 * 128;
      for (int i = gt; i < 4 * 128 * 128 / 8; i += NT) { const int e0 = i * 8, t = (e0 >> 7) & 127, s0 = e0 & 127; const f32x4 a = *(const f32x4*)(sgw + e0), b = *(const f32x4*)(sgw + e0 + 4);
          u32x4 w; w.x = cvt_pk_bf16(s0 + 0 <= t ? a[0] : 0.f, s0 + 1 <= t ? a[1] : 0.f); w.y = cvt_pk_bf16(s0 + 2 <= t ? a[2] : 0.f, s0 + 3 <= t ? a[3] : 0.f);
          w.z = cvt_pk_bf16(s0 + 4 <= t ? b[0] : 0.f, s0 + 5 <= t ? b[1] : 0.f); w.w = cvt_pk_bf16(s0 + 6 <= t ? b[2] : 0.f, s0 + 7 <= t ? b[3] : 0.f);
          *(u32x4*)(SGWM + e0) = w; }
      bf16_t* PWT = (bf16_t*)(wsptr(P) + WS_SMALL + SM_PWT); const float* pw = inptr(I_POOLW) + (size_t)l * 4 * 64 * 64;
      for (int i = gt; i < 4 * 64 * 64; i += NT) { const int g = i >> 12, d = (i >> 6) & 63, c = i & 63; PWT[i] = f2bf(pw[(g * 64 + c) * 64 + d]); } }
    { const int gt = gw * 64 + lane, NT = NGW * 64; const float* rw = inptr(I_RW) + (size_t)l * 1024 * 64; bf16_t* WRT = WB + WB_WR;
      for (int i = gt; i < 65536; i += NT) { const int k = i >> 6, e = i & 63; const float v = rw[i]; const bf16_t hi = f2bf(v); WRT[e * 1024 + k] = hi; WRT[65536 + e * 1024 + k] = f2bf(v - bf2f(hi)); }
      int* IDXP = (int*)(wsptr(P) + WS_SMALL + SM_IDXP) + 64 * CAP;
      for (int i = gt; i < M; i += NT) IDXP[i] = i; }
    }
}

__device__ __forceinline__ void moe_offsets(const Params& P, LAS unsigned char* lds, int l, const int g_wave) {
    LAS int* eo = (LAS int*)(lds + EOFF_OFF);
    if (TIDX == 0) { const unsigned* CNT = (const unsigned*)(wsptr(P) + WS_CTL) + CW_CNT + l * 64; int off = 0, tp = 0;
#pragma unroll 1
        for (int e = 0; e < 64; ++e) { const int n = (int)__hip_atomic_load(CNT + e, __ATOMIC_RELAXED, __HIP_MEMORY_SCOPE_AGENT); eo[e] = off; eo[64 + e] = tp; eo[128 + e] = n; off += n; tp += (n + 255) >> 8; } }
    __syncthreads();
}
template <int MODE>
__device__ __forceinline__ void phase_norm1(const Params& P, LAS unsigned char* lds, int l, int gw, int NGW, const int g_wave) {
    const int tid = TIDX, lane = tid & 63;
    const float* MOD = (const float*)(wsptr(P) + WS_SMALL + SM_MOD);
    bf16_t* XB = (bf16_t*)(wsptr(P) + WS_X); bf16_t* H = (bf16_t*)(wsptr(P) + WS_H);
    LAS f32x4* wf = (LAS f32x4*)lds;
    if (MODE != 2) {
        const float* win = inptr(I_WIN) + (size_t)l * 1024 * COLT + 2048;
        for (int d = tid; d < 1024; d += NTHREADS) wf[d] = *(const f32x4*)(win + (size_t)d * COLT);
        __syncthreads();
    }
    if (MODE != 0) moe_offsets(P, lds, l - 1, g_wave);
    const int* TE = (const int*)(wsptr(P) + WS_SMALL + SM_TE); const int* TP = (const int*)(wsptr(P) + WS_SMALL + SM_TP); const bf16_t* Y2 = (const bf16_t*)(wsptr(P) + WS_R1);
    LAS const int* eo = (LAS const int*)(lds + EOFF_OFF);
    const float* Y2S = (const float*)(wsptr(P) + WS_R1 + Y2SC_OFF);
    float* LOGF = (float*)(wsptr(P) + WS_SMALL + SM_LOGF);
    for (int b = 0; b < NB; ++b) {
    f32x4 mA[4], mB[4], mG[4];
#pragma unroll
    for (int j = 0; j < 4; ++j) { const int d0 = 256 * j + 4 * lane;
        if (MODE == 2) { mA[j] = *(const f32x4*)(inptr(I_FING) + d0); mB[j] = (f32x4){0.f, 0.f, 0.f, 0.f}; }
        else { const float* md = MOD + (size_t)(l * 2 + b) * 6144; mA[j] = *(const f32x4*)(inptr(I_MNG) + l * D + d0) * (*(const f32x4*)(md + 1024 + d0) + 1.0f); mB[j] = *(const f32x4*)(md + d0); }
        mG[j] = (MODE != 0) ? *(const f32x4*)(MOD + (size_t)((l - 1) * 2 + b) * 6144 + 5 * 1024 + d0) : (f32x4){0.f, 0.f, 0.f, 0.f}; }
    const float bf0 = (MODE != 2) ? inptr(I_BF)[l * 4 + 0] : 0.f, bf1 = (MODE != 2) ? inptr(I_BF)[l * 4 + 1] : 0.f, bf2 = (MODE != 2) ? inptr(I_BF)[l * 4 + 2] : 0.f, bf3 = (MODE != 2) ? inptr(I_BF)[l * 4 + 3] : 0.f;
    for (int row = b * SEQ + ((gw - b * SEQ) % NGW + NGW) % NGW; row < (b + 1) * SEQ; row += NGW) {
        f32x4 v[4];
        if (MODE == 0) {
#pragma unroll
            for (int j = 0; j < 4; ++j) v[j] = *(const f32x4*)(inptr(I_X) + (size_t)row * D + 256 * j + 4 * lane);
        } else {
            f32x4 a[4];
#pragma unroll
            for (int j = 0; j < 4; ++j) { const u32x2 w = *(const u32x2*)(XB + (size_t)row * D + 256 * j + 4 * lane); v[j] = (f32x4){bflo(w.x), bfhi(w.x), bflo(w.y), bfhi(w.y)}; a[j] = (f32x4){0.f, 0.f, 0.f, 0.f}; }
#pragma unroll
            for (int k = 0; k <= TOPK; ++k) { const int slot = (k < TOPK) ? eo[TE[row * TOPK + (k < TOPK ? k : 0)]] + TP[row * TOPK + (k < TOPK ? k : 0)] : NPAIR + row;
#pragma unroll
                for (int j = 0; j < 4; ++j) { const unsigned w = *(const unsigned*)((const unsigned char*)Y2 + (size_t)slot * D + 256 * j + 4 * lane);
                    const float sc = Y2S[(size_t)slot * 32 + 8 * j + (lane >> 3)];
                    a[j][0] += ((float)(w & 255u) - 128.f) * sc; a[j][1] += ((float)((w >> 8) & 255u) - 128.f) * sc;
                    a[j][2] += ((float)((w >> 16) & 255u) - 128.f) * sc; a[j][3] += ((float)(w >> 24) - 128.f) * sc; } }
#pragma unroll
            for (int j = 0; j < 4; ++j) { v[j] = v[j] + mG[j] * a[j];
                if (MODE == 1) { u32x2 w; w.x = cvt_pk_bf16(v[j][0], v[j][1]); w.y = cvt_pk_bf16(v[j][2], v[j][3]); *(u32x2*)(XB + (size_t)row * D + 256 * j + 4 * lane) = w; } }
        }
        float ss = 0.f;
#pragma unroll
        for (int j = 0; j < 4; ++j) ss += (v[j][0] * v[j][0] + v[j][1] * v[j][1]) + (v[j][2] * v[j][2] + v[j][3] * v[j][3]);
        const float rms = 1.0f / sqrtf(wave_sum(ss) * (1.f / D) + EPS);
        if (MODE == 2) {
#pragma unroll
            for (int j = 0; j < 4; ++j) *(f32x4*)(P.out + (size_t)row * D + 256 * j + 4 * lane) = v[j] * rms * mA[j];
        } else {
            float fl[4] = {0.f, 0.f, 0.f, 0.f};
#pragma unroll
            for (int j = 0; j < 4; ++j) { const int d0 = 256 * j + 4 * lane;
                const f32x4 h = v[j] * rms * mA[j] + mB[j];
#if FP8_G1
                *(unsigned*)((unsigned char*)(wsptr(P) + WS_HF8) + (size_t)row * D + d0) = pk4_fp8(h[0], h[1], h[2], h[3]);
#else
                u32x2 w; w.x = cvt_pk_bf16(h[0], h[1]); w.y = cvt_pk_bf16(h[2], h[3]); *(u32x2*)(H + (size_t)row * D + d0) = w;
#endif
#pragma unroll
                for (int i = 0; i < 4; ++i) { const f32x4 wv = wf[d0 + i]; fl[0] += h[i] * wv[0]; fl[1] += h[i] * wv[1]; fl[2] += h[i] * wv[2]; fl[3] += h[i] * wv[3]; } }
#pragma unroll
            for (int hh = 0; hh < 4; ++hh) fl[hh] = wave_sum(fl[hh]);
            if (lane == 0) { f32x4 o;
#pragma unroll
                for (int hh = 0; hh < 4; ++hh) { const float f = fl[hh] + (hh == 0 ? bf0 : hh == 1 ? bf1 : hh == 2 ? bf2 : bf3); o[hh] = fminf(f, 0.f) - log1pf(__expf(-fabsf(f))); }
                *(f32x4*)(LOGF + (size_t)row * 4) = o; }
        }
    }
    }
}
__device__ __forceinline__ void scan_logf(const Params& P, const int g_wave) {
    const int tid_ = TIDX, lane = tid_ & 63, seq = tid_ >> 6, b = seq >> 2, hh = seq & 3;
    const float* LOGF = (const float*)(wsptr(P) + WS_SMALL + SM_LOGF);
    float* CUM = (float*)(wsptr(P) + WS_SMALL + SM_CUM); bf16_t* CB = (bf16_t*)(wsptr(P) + WS_SMALL + SM_CB);
    float carry = 0.f;
#pragma unroll 4
    for (int it = 0; it < SEQ / 64; ++it) {
        const int pos = it * 64 + lane;
        float v = LOGF[(size_t)(b * SEQ + pos) * 4 + hh];
        v = wave_scan_dpp(v);
        const float cl = (carry + v) * LOG2E;
        CUM[(size_t)seq * SEQ + pos] = cl;
        const float kb = -cl;
        const unsigned c1 = cvt_pk_bf16(kb, 0.f) & 0xffffu; const float r1 = kb - __uint_as_float(c1 << 16);
        const unsigned c2 = cvt_pk_bf16(r1, 0.f) & 0xffffu; const float r2 = r1 - __uint_as_float(c2 << 16);
        const unsigned c3 = cvt_pk_bf16(r2, 0.f) & 0xffffu;
        u32x4* cbp = (u32x4*)(CB + ((size_t)seq * SEQ + pos) * 16);
        const unsigned z_ = (unsigned)opaque(0), one_ = 0x3F80u + z_;
        cbp[0] = (u32x4){c1 | (c2 << 16), c3 | (one_ << 16), one_, z_}; cbp[1] = (u32x4){z_, z_, z_, z_};
        carry += __builtin_bit_cast(float, __builtin_amdgcn_readlane(__builtin_bit_cast(int, v), 63));
    }
}

typedef float f32x16 __attribute__((ext_vector_type(16)));
__device__ __forceinline__ void pool_unit(const Params& P, LAS unsigned char* lds, int l, int tile, const int g_wave) {
    const int tid = TIDX, lane = tid & 63, wave = __builtin_amdgcn_readfirstlane(tid >> 6);
    const bf16_t* PROJ = (const bf16_t*)(wsptr(P) + WS_R1); bf16_t* YS = (bf16_t*)(wsptr(P) + WS_YS);
    LAS bf16_t* zs = (LAS bf16_t*)lds;
    LAS bf16_t* pl = (LAS bf16_t*)(lds + 40960);
    LAS bf16_t* ob = (LAS bf16_t*)(lds + 75776);
    const int t0 = tile * 64, sp0 = t0 & (SEQ - 1);
#pragma unroll
    for (int i_ = 0; i_ < (79 * 32 + NTHREADS - 1) / NTHREADS; ++i_) { const int p = tid + i_ * NTHREADS; if (p >= 79 * 32) break; const int r = p >> 5, ch = p & 31; const int pos = sp0 - 15 + r;
        u32x4 v = (u32x4){0u, 0u, 0u, 0u};
        if (pos >= 0) v = *(const u32x4*)(PROJ + (size_t)(t0 - 15 + r) * 2048 + ch * 8);
        *(LAS u32x4*)(zs + r * 256 + ch * 8) = v; }
    __syncthreads();
    { const int c = tid & 255, half = tid >> 8, g = c >> 6, w = 2 << g;
      float run = 0.f;
      for (int j = 1; j < w; ++j) run += bf2f(zs[(half * 32 + 15 - j) * 256 + c]);
      const float invw = 1.0f / (float)w;
      for (int i = 0; i < 32; ++i) { const int tt = half * 32 + i, pos = sp0 + tt; const float zc = bf2f(zs[(tt + 15) * 256 + c]);
          run += zc;
          const float mean = (pos + 1 < w) ? run / (float)(pos + 1) : run * invw;
          pl[tt * 264 + c] = f2bf(mean - zc);
          run -= bf2f(zs[(tt + 16 - w) * 256 + c]); } }
    __syncthreads();
    { const int g = wave >> 1, tb = wave & 1, r = lane & 31, h = lane >> 5;
      const bf16_t* PWT = (const bf16_t*)(wsptr(P) + WS_SMALL + SM_PWT);
#pragma unroll
      for (int dt = 0; dt < 2; ++dt) { f32x16 acc = {};
#pragma unroll
          for (int ks = 0; ks < 4; ++ks) { const bf16x8 af = *(const LAS bf16x8*)(pl + (32 * tb + r) * 264 + g * 64 + 16 * ks + 8 * h);
              const bf16x8 bf = *(const bf16x8*)(PWT + (size_t)(g * 64 + dt * 32 + r) * 64 + 16 * ks + 8 * h);
              acc = __builtin_amdgcn_mfma_f32_32x32x16_bf16(af, bf, acc, 0, 0, 0); }
          const int col = g * 64 + dt * 32 + r; const float scl = inptr(I_POOLS)[l * 256 + col];
#pragma unroll
          for (int q = 0; q < 16; ++q) { const int t = 32 * tb + (q & 3) + 8 * (q >> 2) + 4 * h; ob[t * 256 + col] = f2bf(acc[q] * scl); } } }
    __syncthreads();
#pragma unroll
    for (int i_ = 0; i_ < 64 * 32 / NTHREADS; ++i_) { const int p = tid + i_ * NTHREADS; const int t = p >> 5, ch = p & 31; *(u32x4*)(YS + (size_t)(t0 + t) * 1024 + ch * 8) = *(const LAS u32x4*)(ob + t * 256 + ch * 8); }
    __syncthreads();
}

__device__ __forceinline__ void sg_unit(const Params& P, LAS unsigned char* lds, int l, int chunk, const int g_wave) {
    const int tid = TIDX, lane = tid & 63, wave = __builtin_amdgcn_readfirstlane(tid >> 6);
    const bf16_t* PROJ = (const bf16_t*)(wsptr(P) + WS_R1); bf16_t* YS = (bf16_t*)(wsptr(P) + WS_YS);
    LAS bf16_t* vn = (LAS bf16_t*)lds;
    LAS bf16_t* ob = (LAS bf16_t*)(lds + 65536);
    const int t0 = chunk * 128;
    {
      const int sidx = wave * 16 + (lane >> 2), pq = lane & 3;
      const bf16_t* src = PROJ + (size_t)(t0 + sidx) * 2048 + 512 + pq * 64;
      u32x4 raw[8];
#pragma unroll
      for (int k = 0; k < 8; ++k) raw[k] = *(const u32x4*)(src + 8 * k);
      float sum = 0.f;
#pragma unroll
      for (int k = 0; k < 8; ++k) sum += ((bflo(raw[k].x) + bfhi(raw[k].x)) + (bflo(raw[k].y) + bfhi(raw[k].y))) + ((bflo(raw[k].z) + bfhi(raw[k].z)) + (bflo(raw[k].w) + bfhi(raw[k].w)));
      sum += DPPF(0.f, sum, 0xB1, 0xf, 0xf); sum += DPPF(0.f, sum, 0x4E, 0xf, 0xf);
      const float mu = sum * (1.f / 256.f); float sq = 0.f;
#pragma unroll
      for (int k = 0; k < 8; ++k) { const float d0 = bflo(raw[k].x) - mu, d1 = bfhi(raw[k].x) - mu, d2 = bflo(raw[k].y) - mu, d3 = bfhi(raw[k].y) - mu, d4 = bflo(raw[k].z) - mu, d5 = bfhi(raw[k].z) - mu, d6 = bflo(raw[k].w) - mu, d7 = bfhi(raw[k].w) - mu;
          sq += ((d0 * d0 + d1 * d1) + (d2 * d2 + d3 * d3)) + ((d4 * d4 + d5 * d5) + (d6 * d6 + d7 * d7)); }
      sq += DPPF(0.f, sq, 0xB1, 0xf, 0xf); sq += DPPF(0.f, sq, 0x4E, 0xf, 0xf);
      const float rstd = 1.0f / sqrtf(sq * (1.f / 256.f) + EPS);
      const float* gp = inptr(I_SGLG) + l * 256 + pq * 64; const float* bp = inptr(I_SGLB) + l * 256 + pq * 64;
#pragma unroll
      for (int k0 = 0; k0 < 8; ++k0) { const int k = (k0 + lane) & 7;
          u32x4 rw = raw[0];
#pragma unroll
          for (int kk = 1; kk < 8; ++kk) rw = (k == kk) ? raw[kk] : rw;
          const f32x4 g0 = *(const f32x4*)(gp + 8 * k), g1 = *(const f32x4*)(gp + 8 * k + 4), b0 = *(const f32x4*)(bp + 8 * k), b1 = *(const f32x4*)(bp + 8 * k + 4);
          u32x4 o; o.x = cvt_pk_bf16((bflo(rw.x) - mu) * rstd * g0[0] + b0[0], (bfhi(rw.x) - mu) * rstd * g0[1] + b0[1]); o.y = cvt_pk_bf16((bflo(rw.y) - mu) * rstd * g0[2] + b0[2], (bfhi(rw.y) - mu) * rstd * g0[3] + b0[3]);
          o.z = cvt_pk_bf16((bflo(rw.z) - mu) * rstd * g1[0] + b1[0], (bfhi(rw.z) - mu) * rstd * g1[1] + b1[1]); o.w = cvt_pk_bf16((bflo(rw.w) - mu) * rstd * g1[2] + b1[2], (bfhi(rw.w) - mu) * rstd * g1[3] + b1[3]);
          *(LAS u32x4*)(vn + sidx * 256 + pq * 64 + 8 * k) = o; } }
    __syncthreads();
    { const int head = wave >> 1, c0 = head * 64 + (wave & 1) * 32, r = lane & 31, h = lane >> 5;
      const bf16_t* SGWM = (const bf16_t*)(wsptr(P) + WS_SMALL + SM_SGWM) + (size_t)head * 128 * 128;
      const float* sgb = inptr(I_SGB) + (l * 4 + head) * 128;
      bf16x8 bfr[8];
#pragma unroll
      for (int ks = 0; ks < 8; ++ks) { unsigned e[8];
#pragma unroll
          for (int j = 0; j < 8; ++j) e[j] = vn[(16 * ks + 8 * h + j) * 256 + c0 + r];
          u32x4 w; w.x = e[0] | (e[1] << 16); w.y = e[2] | (e[3] << 16); w.z = e[4] | (e[5] << 16); w.w = e[6] | (e[7] << 16); bfr[ks] = __builtin_bit_cast(bf16x8, w); }
      bf16x8 wfr[20]; float bias[4];
#pragma unroll
      for (int tb = 0; tb < 4; ++tb) { bias[tb] = sgb[32 * tb + r];
#pragma unroll
          for (int ks = 0; ks < 2 * tb + 2; ++ks) wfr[tb * (tb + 1) + ks] = *(const bf16x8*)(SGWM + (size_t)(32 * tb + r) * 128 + 16 * ks + 8 * h); }
#pragma unroll
      for (int tb = 0; tb < 4; ++tb) { f32x16 acc = {};
#pragma unroll
          for (int ks = 0; ks < 2 * tb + 2; ++ks) acc = __builtin_amdgcn_mfma_f32_32x32x16_bf16(bfr[ks], wfr[tb * (tb + 1) + ks], acc, 0, 0, 0);
          const int t = 32 * tb + r;
#pragma unroll
          for (int g4 = 0; g4 < 4; ++g4) { u32x2 o; o.x = cvt_pk_bf16(acc[4 * g4] + bias[tb], acc[4 * g4 + 1] + bias[tb]); o.y = cvt_pk_bf16(acc[4 * g4 + 2] + bias[tb], acc[4 * g4 + 3] + bias[tb]);
              *(LAS u32x2*)(ob + t * 256 + ((((c0 >> 3) + g4) ^ (t & 31)) << 3) + 4 * h) = o; } } }
    __syncthreads();
#pragma unroll
    for (int i_ = 0; i_ < 128 * 32 / NTHREADS; ++i_) { const int p = tid + i_ * NTHREADS; const int t = p >> 5, ch = p & 31;
        const u32x4 u = *(const u32x4*)(PROJ + (size_t)(t0 + t) * 2048 + 256 + ch * 8), sv = *(const LAS u32x4*)(ob + t * 256 + ((ch ^ (t & 31)) << 3));
        u32x4 o; o.x = cvt_pk_bf16(bflo(u.x) * bflo(sv.x), bfhi(u.x) * bfhi(sv.x)); o.y = cvt_pk_bf16(bflo(u.y) * bflo(sv.y), bfhi(u.y) * bfhi(sv.y));
        o.z = cvt_pk_bf16(bflo(u.z) * bflo(sv.z), bfhi(u.z) * bfhi(sv.z)); o.w = cvt_pk_bf16(bflo(u.w) * bflo(sv.w), bfhi(u.w) * bfhi(sv.w));
        *(u32x4*)(YS + (size_t)(t0 + t) * 1024 + 256 + ch * 8) = o; }
    __syncthreads();
}

__device__ __forceinline__ void conv_unit(const Params& P, LAS unsigned char* lds, int l, int tile, const int g_wave) {
    const int tid = TIDX, lane = tid & 63, wave = tid >> 6;
    const bf16_t* PROJ = (const bf16_t*)(wsptr(P) + WS_R1); bf16_t* YS = (bf16_t*)(wsptr(P) + WS_YS);
    LAS float* ys = (LAS float*)lds;
    const int t0 = tile * 64, sp0 = t0 & (SEQ - 1);
#pragma unroll
    for (int i_ = 0; i_ < (94 * 32 + NTHREADS - 1) / NTHREADS; ++i_) { const int p = tid + i_ * NTHREADS; if (p >= 94 * 32) break; const int r = p >> 5, ch = p & 31; const int pos = sp0 - 30 + r;
        f32x4 o0 = (f32x4){0.f, 0.f, 0.f, 0.f}, o1 = o0;
        if (pos >= 0) { const bf16_t* rp = PROJ + (size_t)(t0 - 30 + r) * 2048 + ch * 8;
            const u32x4 a = *(const u32x4*)(rp + 768), g = *(const u32x4*)(rp + 1024);
            o0 = (f32x4){bflo(a.x) * sigmoidf_(bflo(g.x)), bfhi(a.x) * sigmoidf_(bfhi(g.x)), bflo(a.y) * sigmoidf_(bflo(g.y)), bfhi(a.y) * sigmoidf_(bfhi(g.y))};
            o1 = (f32x4){bflo(a.z) * sigmoidf_(bflo(g.z)), bfhi(a.z) * sigmoidf_(bfhi(g.z)), bflo(a.w) * sigmoidf_(bflo(g.w)), bfhi(a.w) * sigmoidf_(bfhi(g.w))}; }
        *(LAS f32x4*)(ys + r * 256 + ch * 8) = o0; *(LAS f32x4*)(ys + r * 256 + ch * 8 + 4) = o1; }
    __syncthreads();
    f32x2 outv[16];
    { const int cp = tid & 127, qt = tid >> 7;
      f32x2 w[31], yv[46];
#pragma unroll
      for (int j = 0; j < 31; ++j) w[j] = *(const f32x2*)(inptr(I_CONVW) + (size_t)(l * 31 + j) * 256 + 2 * cp);
#pragma unroll
      for (int r = 0; r < 46; ++r) yv[r] = *(const LAS f32x2*)(ys + (qt * 16 + r) * 256 + 2 * cp);
      const f32x2 cb = *(const f32x2*)(inptr(I_CONVB) + l * 256 + 2 * cp);
#pragma unroll
      for (int i = 0; i < 16; ++i) { f32x2 a = cb;
#pragma unroll
          for (int j = 0; j < 31; ++j) a = w[j] * yv[i + j] + a;
          outv[i] = a; } }
    __syncthreads();
    { const int cp = tid & 127, qt = tid >> 7;
#pragma unroll
      for (int i = 0; i < 16; ++i) *(LAS f32x2*)(ys + (qt * 16 + i) * 256 + 2 * cp) = outv[i]; }
    __syncthreads();
    for (int i = 0; i < 8; ++i) { const int tt = wave * 8 + i; f32x4 x = *(const LAS f32x4*)(ys + tt * 256 + 4 * lane);
        const float mu = wave_sum((x[0] + x[1]) + (x[2] + x[3])) * (1.f / 256.f);
        x = x - mu;
        const float var = wave_sum((x[0] * x[0] + x[1] * x[1]) + (x[2] * x[2] + x[3] * x[3])) * (1.f / 256.f);
        const float rstd = 1.0f / sqrtf(var + EPS);
        const f32x4 g4 = *(const f32x4*)(inptr(I_CLG) + l * 256 + 4 * lane), b4 = *(const f32x4*)(inptr(I_CLB) + l * 256 + 4 * lane);
        const f32x4 y = x * rstd * g4 + b4;
        u32x2 o; o.x = cvt_pk_bf16(siluf_(y[0]), siluf_(y[1])); o.y = cvt_pk_bf16(siluf_(y[2]), siluf_(y[3]));
        *(u32x2*)(YS + (size_t)(t0 + tt) * 1024 + 512 + 4 * lane) = o; }
    __syncthreads();
}

namespace fa {
using bf16x8=__attribute__((ext_vector_type(8)))short;
using s16x4=__attribute__((ext_vector_type(4)))short;
using f32x16=__attribute__((ext_vector_type(16)))float;
using u32x4=__attribute__((ext_vector_type(4)))unsigned;
constexpr int PQ=2048, PO=1024;
constexpr int NW=8,QBLK=32,QB=QBLK*NW,KVBLK=64;
__device__ __forceinline__ int crow(int r,int hi){return (r&3)+8*(r>>2)+4*hi;}
#define SBAR() __builtin_amdgcn_sched_barrier(0)
__device__ __forceinline__ void cmask(f32x16&p0,f32x16&p1,int jb,int qrel,int hi){
  const float NEG=-INFINITY; int kb=64*jb+4*hi;
  #pragma unroll
  for(int r=0;r<16;++r){int kv=kb+(r&3)+8*(r>>2); if(kv>qrel)p0[r]=NEG; if(kv+32>qrel)p1[r]=NEG;}
}
constexpr int NSLOT=3, SLOTB=8192;
constexpr int LDS_K=0, LDS_V=NSLOT*SLOTB, LDS_WS=2*NSLOT*SLOTB, LDS_OST=LDS_WS+NW*64*4, LDS_CB=LDS_OST+NW*4096, LDS_BYTES_=LDS_CB+NSLOT*2048;
__device__ __forceinline__ void glds16(const void*gsrc,unsigned lds_dst){unsigned keep;
  asm volatile("s_mov_b32 %0, m0\n\ts_mov_b32 m0, %2\n\ts_nop 0\n\tglobal_load_lds_dwordx4 %1, off\n\ts_mov_b32 m0, %0":"=&s"(keep):"v"(gsrc),"s"(lds_dst):"memory");}
__device__ __forceinline__ float max3f(float a,float b,float c){float r;asm("v_max3_f32 %0, %1, %2, %3":"=v"(r):"v"(a),"v"(b),"v"(c));return r;}
__device__ __forceinline__ float max2f(float a,float b){float r;asm("v_max_f32_e32 %0, %1, %2":"=v"(r):"v"(a),"v"(b));return r;}
__device__ __forceinline__ float fsub_s(float a,float b){float r;asm("v_sub_f32_e32 %0, %1, %2":"=v"(r):"v"(a),"v"(b));return r;}
typedef float f32x2_t __attribute__((ext_vector_type(2))); typedef __bf16 bf16x2_t __attribute__((ext_vector_type(2)));
__device__ __forceinline__ unsigned cvtpk_s(float lo,float hi){f32x2_t v={lo,hi};bf16x2_t b=__builtin_convertvector(v,bf16x2_t);return __builtin_bit_cast(unsigned,b);}
#define WAIT_BAR(N) asm volatile("s_waitcnt vmcnt(" #N ") lgkmcnt(0)\n\ts_barrier":::"memory")
typedef __attribute__((address_space(3))) const char* lds_cptr;
typedef short v4i16_t __attribute__((ext_vector_type(4)));
#define LDSB8(p) (*(const __attribute__((address_space(3))) bf16x8*)(p))
__device__ __forceinline__ void kload8(bf16x8*kf,lds_cptr kp){
  kf[0]=LDSB8(kp);      kf[1]=LDSB8(kp+512);  kf[2]=LDSB8(kp+2048); kf[3]=LDSB8(kp+2560);
  kf[4]=LDSB8(kp+4096); kf[5]=LDSB8(kp+4608); kf[6]=LDSB8(kp+6144); kf[7]=LDSB8(kp+6656);
}
__device__ __forceinline__ void kload2(bf16x8*kf,lds_cptr kp,int j){ kf[2*j]=LDSB8(kp+j*2048); kf[2*j+1]=LDSB8(kp+j*2048+512); }
__device__ __forceinline__ s16x4 vtr(lds_cptr p){ return __builtin_bit_cast(s16x4,__builtin_amdgcn_ds_read_tr16_b64_v4i16((__attribute__((address_space(3))) v4i16_t*)p)); }
__device__ __forceinline__ float rowmax(const f32x16&p0,const f32x16&p1){
  float a=max3f(p0[0],p0[1],p1[0]),b=max3f(p0[2],p0[3],p1[1]);a=max3f(a,p1[2],p1[3]);
  #pragma unroll
  for(int r=4;r<16;r+=4){a=max3f(a,p0[r],p0[r+1]);b=max3f(b,p0[r+2],p0[r+3]);a=max3f(a,p1[r],p1[r+1]);b=max3f(b,p1[r+2],p1[r+3]);}
  const float m=max2f(a,b);
  auto rr=__builtin_amdgcn_permlane32_swap(__float_as_uint(m),__float_as_uint(m),false,false);
  return max2f(__uint_as_float(rr[0]),__uint_as_float(rr[1]));
}
__device__ __forceinline__ void pv(f32x16*o,int vb,bf16x8 pa0,bf16x8 pa1,bf16x8 pa2,bf16x8 pa3){
  #pragma unroll
  for(int d0=0;d0<2;++d0){s16x4 lo[4],hi[4];
    #pragma unroll
    for(int ks=0;ks<4;++ks){
      asm volatile("ds_read_b64_tr_b16 %0,%1 offset:%c2":"=&v"(lo[ks]):"v"(vb),"i"(d0*4096+ks*1024):"memory");
      asm volatile("ds_read_b64_tr_b16 %0,%1 offset:%c2":"=&v"(hi[ks]):"v"(vb),"i"(d0*4096+ks*1024+512):"memory");}
    asm volatile("s_waitcnt lgkmcnt(0)":::"memory");SBAR();
    #define PK(k) (bf16x8){lo[k][0],lo[k][1],lo[k][2],lo[k][3],hi[k][0],hi[k][1],hi[k][2],hi[k][3]}
    o[d0]=__builtin_amdgcn_mfma_f32_32x32x16_bf16(pa0,PK(0),o[d0],0,0,0);
    o[d0]=__builtin_amdgcn_mfma_f32_32x32x16_bf16(pa1,PK(1),o[d0],0,0,0);
    o[d0]=__builtin_amdgcn_mfma_f32_32x32x16_bf16(pa2,PK(2),o[d0],0,0,0);
    o[d0]=__builtin_amdgcn_mfma_f32_32x32x16_bf16(pa3,PK(3),o[d0],0,0,0);
    #undef PK
  }
}
__device__ __forceinline__ float ref_split(float x,unsigned himask,unsigned&q1,unsigned&q2){
  const unsigned b1=cvtpk_s(x,0.f)&0xffffu; const float r1=__uint_as_float(b1<<16);
  const unsigned b2=cvtpk_s(x-r1,0.f)&0xffffu; const float r2=__uint_as_float(b2<<16);
  q1=(0x3F80u|((b1^0x8000u)<<16))&himask; q2=(b2^0x8000u)&himask; return r1+r2;
}
template<int THRL> __device__ __forceinline__ void attn_unit(int b,int h,int qb,int t0,const bf16_t*Q,const bf16_t*__restrict__ K,const bf16_t*__restrict__ V,const bf16_t*__restrict__ CB,bf16_t*O,char*shm,const int g_wave){
  const int tid=TIDX,lane=tid&63,r32=lane&31,hi=lane>>5; const int wid=__builtin_amdgcn_readfirstlane(tid>>6);
  const long rowbase=(long)b*SEQ; const int q0=qb*QB;
  const bf16_t*Qw=Q+(rowbase+q0+wid*QBLK)*PQ+h*64;
  const bf16_t*Kh=K+(rowbase+(long)t0*KVBLK)*PQ+h*64,*Vh=V+(rowbase+(long)t0*KVBLK)*PQ+h*64;
  const bf16_t*CBh=CB+((long)(b*4+h)*SEQ+(long)t0*KVBLK)*16;
  const unsigned lds0=(unsigned)(uintptr_t)shm;
  float*wsf=(float*)(shm+LDS_WS)+wid*64;
  const bf16_t*ksrc=Kh+(long)lane*PQ+wid*8;
  const bf16_t*vsrc=Vh+(long)(16*(wid&3)+(lane>>2))*PQ+(wid>>2)*32+(lane&3)*8;
  const bf16_t*csrc=CBh+(wid*8)*16+lane*8;
  const unsigned kdst=lds0+LDS_K+wid*1024, vdst=lds0+LDS_V+wid*1024, cdst=lds0+LDS_CB+wid*256;
  #define DMA_K(t,slot) do{ glds16(ksrc+(long)(t)*KVBLK*PQ,(unsigned)__builtin_amdgcn_readfirstlane(kdst+(slot))); \
      if(lane<16) glds16(csrc+(long)(t)*KVBLK*16,(unsigned)__builtin_amdgcn_readfirstlane(cdst+((slot)>>2))); }while(0)
  #define DMA_V(t,slot) glds16(vsrc+(long)(t)*KVBLK*PQ,(unsigned)__builtin_amdgcn_readfirstlane(vdst+(slot)))
  const int vb0=(int)(lds0+LDS_V)+((lane>>4)&1)*32+(lane&3)*8+(4*hi+((lane&15)>>2))*64;
  bf16x8 kf[8], kfe[2];
  const lds_cptr shm3=(lds_cptr)shm; const lds_cptr kp0=shm3+LDS_K+hi*1024+r32*16; const lds_cptr vp0=shm3+LDS_V+((lane>>4)&1)*32+(lane&3)*8+(4*hi+((lane&15)>>2))*64;
  const lds_cptr cp0=shm3+LDS_CB+r32*32+hi*16;
  const int NT=(q0+QB)/KVBLK-t0;
  DMA_K(0,0);DMA_V(0,0);DMA_K(1,SLOTB);
  bf16x8 qr[4];
  #pragma unroll
  for(int d0=0;d0<4;++d0)qr[d0]=*reinterpret_cast<const bf16x8*>(&Qw[(long)r32*PQ+d0*16+hi*8]);
  const unsigned himask=hi?0u:0xffffffffu;
  u32x4 qe; qe[0]=0x3F803F80u&himask; qe[3]=0u; float mhat; { unsigned q1_,q2_; mhat=ref_split(0.f,himask,q1_,q2_); qe[1]=q1_; qe[2]=q2_; }
  float l_reg=0.f;f32x16 o[2];o[0]=f32x16{};o[1]=f32x16{};
  const f32x16 Z=f32x16{};
  const int qrel=wid*QBLK+r32;
  #define QE() __builtin_bit_cast(bf16x8,qe)
  #define CMASK(P0,P1,t) do{int jb_=(t)-(NT-4); if(jb_>=0)cmask(P0,P1,jb_,qrel,hi);}while(0)
  bool resc=false;
  #define MOVE_REF(dl,DL_) do{ unsigned q1_,q2_; const float nr_=ref_split(mhat+(dl),himask,q1_,q2_); qe[1]=q1_; qe[2]=q2_; DL_=nr_-mhat; mhat=nr_; asm volatile("":"+v"(qe)); }while(0)
  #define START(P0,P1) do{ const float rm=rowmax(P0,P1); resc=false; \
    { float dl_; MOVE_REF(rm,dl_); \
      _Pragma("unroll") for(int r=0;r<16;++r){P0[r]=fsub_s(P0[r],dl_);P1[r]=fsub_s(P1[r],dl_);} } \
    _Pragma("unroll") for(int r=0;r<16;++r)P0[r]=__builtin_amdgcn_exp2f(P0[r]); }while(0)
  #define RESC() do{ if(resc){ asm volatile("s_waitcnt lgkmcnt(0)":::"memory"); \
      _Pragma("unroll") for(int d_=0;d_<2;++d_) _Pragma("unroll") for(int r=0;r<16;++r)o[d_][r]*=wsf[crow(r,hi)]; } }while(0)
  f32x16 pA0,pA1,pB0,pB1;
  int sl_prev=0,sl_cur=0,sl_next=SLOTB;
  #define ROT() do{sl_prev=sl_cur;sl_cur=sl_next;sl_next=(sl_next==(NSLOT-1)*SLOTB)?0:sl_next+SLOTB;}while(0)
  DMA_K(2,2*SLOTB);
  WAIT_BAR(5);
  { kfe[0]=LDSB8(cp0); kfe[1]=LDSB8(cp0+1024); kload8(kf,kp0);
    pA0=__builtin_amdgcn_mfma_f32_32x32x16_bf16(kfe[0],QE(),Z,0,0,0); pA1=__builtin_amdgcn_mfma_f32_32x32x16_bf16(kfe[1],QE(),Z,0,0,0);
    #pragma unroll
    for(int d0=0;d0<4;++d0){ pA0=__builtin_amdgcn_mfma_f32_32x32x16_bf16(kf[2*d0],qr[d0],pA0,0,0,0); pA1=__builtin_amdgcn_mfma_f32_32x32x16_bf16(kf[2*d0+1],qr[d0],pA1,0,0,0); } }
  asm volatile("s_nop 15\n\ts_nop 7":"+v"(pA0),"+v"(pA1));CMASK(pA0,pA1,0);
  START(pA0,pA1);
  _Pragma("unroll") for(int r=0;r<16;++r)pA1[r]=__builtin_amdgcn_exp2f(pA1[r]);
  WAIT_BAR(0);
  DMA_K(3,0);DMA_V(1,SLOTB);
  ROT();
  kload8(kf,kp0+sl_cur); kfe[0]=LDSB8(cp0+(sl_cur>>2)); kfe[1]=LDSB8(cp0+(sl_cur>>2)+1024);
  WAIT_BAR(3);
  s16x4 vlo[8],vhi[8]; u32x4 pw0,pw1,pw2,pw3;
  #define PKW(P,B) cvtpk_s(P[B],P[B+1])
  #define PAF(k) __builtin_bit_cast(bf16x8,pw##k)
  #define VFR(i) (bf16x8){vlo[i][0],vlo[i][1],vlo[i][2],vlo[i][3],vhi[i][0],vhi[i][1],vhi[i][2],vhi[i][3]}
  #define PIN(x) asm volatile("":"+v"(x))
  #define MX3(a,b,c) __builtin_fmaxf(__builtin_fmaxf((a),(b)),(c))
  #define GAPA(MF,A0,A1,A2,A3,W0,W1,PW) do{ MF; sacc+=A0; sacc+=A1; sacc+=A2; sacc+=A3; PIN(sacc); W0; W1; PIN(PW); SBAR(); }while(0)
  #define EX(v) __builtin_amdgcn_exp2f(v)
  #define GAPB(MF,X,B) do{ MF; X[B]=EX(X[B]); X[B+1]=EX(X[B+1]); X[B+2]=EX(X[B+2]); X[B+3]=EX(X[B+3]); PIN(X); SBAR(); }while(0)
  #define VRD(i) do{ vlo[i]=vtr(vp_+(((i)>>2)*4096+((i)&3)*1024)); vhi[i]=vtr(vp_+(((i)>>2)*4096+((i)&3)*1024+512)); }while(0)
  #define KRD(G,j) do{ if(G){ kload2(kf,kp0+sl_next,j); if((j)==0){ kfe[0]=LDSB8(cp0+(sl_next>>2)); kfe[1]=LDSB8(cp0+(sl_next>>2)+1024); } SBAR(); } }while(0)
  #define STEP(C0,C1,P0,P1,t,GK,GV,GL) do{ SBAR(); \
    const lds_cptr vp_=vp0+sl_prev; \
    C0=__builtin_amdgcn_mfma_f32_32x32x16_bf16(kfe[0],QE(),Z,0,0,0); C1=__builtin_amdgcn_mfma_f32_32x32x16_bf16(kfe[1],QE(),Z,0,0,0); SBAR(); \
    VRD(0); SBAR(); float sacc=(P0[0]+P0[1]); \
    GAPA(C0=__builtin_amdgcn_mfma_f32_32x32x16_bf16(kf[0],qr[0],C0,0,0,0), P0[2],P0[3],P0[4],P0[5],     pw0[0]=PKW(P0,0), pw0[1]=PKW(P0,2), pw0); \
    VRD(4); SBAR(); GAPA(C1=__builtin_amdgcn_mfma_f32_32x32x16_bf16(kf[1],qr[0],C1,0,0,0), P0[6],P0[7],P0[8],P0[9],     pw0[2]=PKW(P0,4), pw0[3]=PKW(P0,6), pw0); \
    VRD(1); SBAR(); GAPA(C0=__builtin_amdgcn_mfma_f32_32x32x16_bf16(kf[2],qr[1],C0,0,0,0),   P0[10],P0[11],P0[12],P0[13], pw1[0]=PKW(P0,8), pw1[1]=PKW(P0,10), pw1); \
    VRD(5); SBAR(); GAPA(C1=__builtin_amdgcn_mfma_f32_32x32x16_bf16(kf[3],qr[1],C1,0,0,0),   P0[14],P0[15],P1[0],P1[1],   pw1[2]=PKW(P0,12),pw1[3]=PKW(P0,14), pw1); \
    VRD(2); SBAR(); GAPA(C0=__builtin_amdgcn_mfma_f32_32x32x16_bf16(kf[4],qr[2],C0,0,0,0),   P1[2],P1[3],P1[4],P1[5],     pw2[0]=PKW(P1,0), pw2[1]=PKW(P1,2), pw2); \
    VRD(6); SBAR(); GAPA(C1=__builtin_amdgcn_mfma_f32_32x32x16_bf16(kf[5],qr[2],C1,0,0,0),   P1[6],P1[7],P1[8],P1[9],     pw2[2]=PKW(P1,4), pw2[3]=PKW(P1,6), pw2); \
    VRD(3); SBAR(); GAPA(C0=__builtin_amdgcn_mfma_f32_32x32x16_bf16(kf[6],qr[3],C0,0,0,0),   P1[10],P1[11],P1[12],P1[13], pw3[0]=PKW(P1,8), pw3[1]=PKW(P1,10), pw3); \
    VRD(7); SBAR(); GAPA(C1=__builtin_amdgcn_mfma_f32_32x32x16_bf16(kf[7],qr[3],C1,0,0,0),   P1[14],P1[15],0.f,0.f,       pw3[2]=PKW(P1,12),pw3[3]=PKW(P1,14), pw3); \
    l_reg+=sacc; \
    if(GK){DMA_K((t)+3,sl_cur);} if(GV){DMA_V((t)+1,sl_next);} \
    CMASK(C0,C1,t); \
    { float a=MX3(C0[0],C0[1],C1[0]),b=MX3(C0[2],C0[3],C1[1]); a=MX3(a,C1[2],C1[3]); \
      _Pragma("unroll") for(int r=4;r<16;r+=4){a=MX3(a,C0[r],C0[r+1]);b=MX3(b,C0[r+2],C0[r+3]);a=MX3(a,C1[r],C1[r+1]);b=MX3(b,C1[r+2],C1[r+3]);} \
      float rm=__builtin_fmaxf(a,b); { auto rr=__builtin_amdgcn_permlane32_swap(__float_as_uint(rm),__float_as_uint(rm),false,false); rm=__builtin_fmaxf(__uint_as_float(rr[0]),__uint_as_float(rr[1])); } \
      resc=false; \
      if(__builtin_expect(__any(rm>(float)THRL),0)){ float dl; MOVE_REF(__builtin_fmaxf(rm,0.f),dl); \
        _Pragma("unroll") for(int r=0;r<16;++r){C0[r]-=dl;C1[r]-=dl;} \
        const float f=__builtin_amdgcn_exp2f(-dl); l_reg*=f; if(hi==0)wsf[r32]=f; resc=true; } } \
    SBAR(); \
    GAPB(o[0]=__builtin_amdgcn_mfma_f32_32x32x16_bf16(PAF(0),VFR(0),o[0],0,0,0), C0,0); \
    GAPB(o[1]=__builtin_amdgcn_mfma_f32_32x32x16_bf16(PAF(0),VFR(4),o[1],0,0,0), C0,4); \
    KRD(GL,0); GAPB(o[0]=__builtin_amdgcn_mfma_f32_32x32x16_bf16(PAF(1),VFR(1),o[0],0,0,0), C0,8); \
    KRD(GL,1); GAPB(o[1]=__builtin_amdgcn_mfma_f32_32x32x16_bf16(PAF(1),VFR(5),o[1],0,0,0), C0,12); \
    KRD(GL,2); GAPB(o[0]=__builtin_amdgcn_mfma_f32_32x32x16_bf16(PAF(2),VFR(2),o[0],0,0,0), C1,0); \
    KRD(GL,3); GAPB(o[1]=__builtin_amdgcn_mfma_f32_32x32x16_bf16(PAF(2),VFR(6),o[1],0,0,0), C1,4); \
    GAPB(o[0]=__builtin_amdgcn_mfma_f32_32x32x16_bf16(PAF(3),VFR(3),o[0],0,0,0), C1,8); \
    GAPB(o[1]=__builtin_amdgcn_mfma_f32_32x32x16_bf16(PAF(3),VFR(7),o[1],0,0,0), C1,12); \
    }while(0)
  int t=1;
  #undef CMASK
  #define CMASK(P0,P1,t) do{}while(0)
  for(;t+5<NT;t+=2){
    STEP(pB0,pB1,pA0,pA1,t,true,true,true);     WAIT_BAR(3); RESC(); ROT();
    STEP(pA0,pA1,pB0,pB1,t+1,true,true,true);   WAIT_BAR(3); RESC(); ROT();
  }
  #undef CMASK
  #define CMASK(P0,P1,t) do{int jb_=(t)-(NT-4); if(jb_>=0)cmask(P0,P1,jb_,qrel,hi);}while(0)
  #define ENDW(tt) do{ if((tt)+3<NT){WAIT_BAR(3);} else if((tt)+2<NT){WAIT_BAR(1);} else {WAIT_BAR(0);} }while(0)
  for(;t+1<NT;t+=2){
    STEP(pB0,pB1,pA0,pA1,t,(t+3<NT),(t+1<NT),(t+1<NT));       ENDW(t);   RESC(); ROT();
    STEP(pA0,pA1,pB0,pB1,t+1,(t+4<NT),(t+2<NT),(t+2<NT));     ENDW(t+1); RESC(); ROT();
  }
  STEP(pB0,pB1,pA0,pA1,NT-1,false,false,false); RESC();
  { float sacc=pB0[0]+pB0[1]; _Pragma("unroll") for(int r=2;r<16;++r)sacc+=pB0[r]; _Pragma("unroll") for(int r=0;r<16;++r)sacc+=pB1[r]; l_reg+=sacc;
    pw0=(u32x4){PKW(pB0,0),PKW(pB0,2),PKW(pB0,4),PKW(pB0,6)};pw1=(u32x4){PKW(pB0,8),PKW(pB0,10),PKW(pB0,12),PKW(pB0,14)};pw2=(u32x4){PKW(pB1,0),PKW(pB1,2),PKW(pB1,4),PKW(pB1,6)};pw3=(u32x4){PKW(pB1,8),PKW(pB1,10),PKW(pB1,12),PKW(pB1,14)};
    SBAR(); pv(o,vb0+sl_cur,PAF(0),PAF(1),PAF(2),PAF(3)); }
  #undef PKW
  #undef PAF
  #undef VFR
  #undef PIN
  #undef MX3
  #undef GAPA
  #undef GAPB
  #undef EX
  #undef VRD
  #undef KRD
  #undef STEP
  #undef ENDW
  {auto rr=__builtin_amdgcn_permlane32_swap(__float_as_uint(l_reg),__float_as_uint(l_reg),false,false);l_reg=__uint_as_float(rr[0])+__uint_as_float(rr[1]);}
  if(hi==0)wsf[32+r32]=l_reg;asm volatile("s_waitcnt lgkmcnt(0)":::"memory");
  float rli[16];
  #pragma unroll
  for(int r=0;r<16;++r)rli[r]=__builtin_amdgcn_rcpf(wsf[32+crow(r,hi)]);
  bf16_t*Ow=O+(rowbase+q0+wid*QBLK)*PO+h*64;
  { bf16_t*stg=(bf16_t*)(shm+LDS_OST)+wid*2048;
    #pragma unroll
    for(int r=0;r<16;++r){const int orow=crow(r,hi);
      #pragma unroll
      for(int d0=0;d0<2;++d0)stg[orow*64+d0*32+r32]=f2bf(o[d0][r]*rli[r]);}
    asm volatile("s_waitcnt lgkmcnt(0)":::"memory");
    #pragma unroll
    for(int i=0;i<4;++i){const int row=i*8+(lane>>3),ch=lane&7; const u32x4 v=*(const u32x4*)(stg+row*64+ch*8); *(u32x4*)(Ow+(long)row*PO+ch*8)=v;} }
  asm volatile("s_waitcnt lgkmcnt(0)\n\ts_barrier":::"memory");
  #undef DMA_K
  #undef DMA_V
  #undef CMASK
  #undef START
  #undef RESC
  #undef ROT
  #undef QE
  #undef MOVE_REF
}
#undef SBAR
#undef WAIT_BAR
#undef LDSB8
}

using pg8::Unit;
struct SchedDense { int nM, nN, G, c, lda, ldb;
    __device__ __forceinline__ bool next(int i, Unit& u) const { int pm, pn; if (!pg8::static_tile(i, G, c, nM, nN, pm, pn)) return false;
        u.pm = pm; u.pn = pn; u.a = 0; u.b = 0; u.c = 0; u.e = 0; u.aoff = (size_t)pm * 256 * lda * 2; u.boff = (size_t)pn * 256 * ldb * 2; return true; } };
struct SchedG2 { int G, c;
    __device__ __forceinline__ bool next(int i, Unit& u) const { int pm, pn; if (!pg8::static_tile(i >> 2, G, c, 64, 8, pm, pn)) return false; const int n = i & 3;
        u.pm = pm; u.pn = pn; u.a = n; u.b = 0; u.c = 0; u.e = 0; u.aoff = ((size_t)pm * 256 * 1024 + n * 256) * 2; u.boff = ((size_t)(n * 1024 + pn * 128) * 256) * 2; return true; } };
template <int NPN, bool DOWN> struct SchedMoe { LAS const i32x4* TL; int u0, u1, per, j;
    __device__ __forceinline__ bool next(int i, Unit& u) const { const int L = u0 + i * per + j; if (L >= u1) return false;
        const int tile = L / NPN, pn = L % NPN; const i32x4 t = TL[tile];
        const int e = __builtin_amdgcn_readfirstlane(t[0]), sb = __builtin_amdgcn_readfirstlane(t[1]), nv = __builtin_amdgcn_readfirstlane(t[2]), ib = __builtin_amdgcn_readfirstlane(t[3]);
        u.pm = tile; u.pn = pn; u.e = e; u.a = sb; u.b = nv; u.c = ib;
        if (DOWN) { u.aoff = (size_t)sb * 256 * (FP8_GB ? 1 : 2); u.boff = WB_W2 * 2 + ((size_t)e * 1024 + pn * 256) * 256 * (FP8_GB ? 1 : 2); }
        else { u.aoff = 0; u.boff = WB_W13 * 2 + ((size_t)e * 512 + pn * 256) * 1024 * (FP8_GA ? 1 : 2); }
        return true; } };

typedef f32x4 Acc[2][2][4][2];
struct Epi1 { static constexpr bool PERM = true; static constexpr int NBJ = 2; static constexpr float ASCALE = FP8_G1 ? 1.f / 64.f : 1.f; bf16_t* PROJ; bf16_t* SG; unsigned* NRM;
    __device__ __forceinline__ void operator()(const Acc& acc, const Unit& u, int wr, int wc, int fr, int fq) const {
        asm volatile("" : "+v"(fr), "+v"(fq));
        const int pn = u.pn; const int mode = (pn >= 8) ? 2 : ((pn == 1 || pn == 2) ? 1 : (pn == 5 ? 3 : 0));
        bf16_t* base = (pn >= 8) ? SG + (pn - 8) * 256 : PROJ + pn * 256; const int ldc = (pn >= 8) ? 4096 : 2048;
        const int row0 = u.pm * 256 + wr * 64 + fr, col0 = wc * 32 + 8 * fq;
#pragma unroll
        for (int ai = 0; ai < 2; ++ai)
#pragma unroll
            for (int m = 0; m < 4; ++m) { bf16_t* rowp = base + (size_t)(row0 + ai * 128 + m * 16) * ldc + col0;
#pragma unroll
                for (int bj = 0; bj < 2; ++bj) { float v[8];
#pragma unroll
                    for (int n = 0; n < 2; ++n)
#pragma unroll
                        for (int q = 0; q < 4; ++q) { float x = acc[ai][bj][m][n][q] * ASCALE;
                            if (mode == 1) x = gelu_tanh(x); else if (mode == 2) x = sigmoidf_(x); else if (mode == 3) x *= QSCALE;
                            v[4 * n + q] = x; }
                    if (mode == 2) { u32x2 w = (u32x2){0u, 0u};
#pragma unroll
                        for (int i = 0; i < 4; ++i) { w.x = __builtin_amdgcn_cvt_pk_u8_f32(v[i] * 255.f, i, w.x); w.y = __builtin_amdgcn_cvt_pk_u8_f32(v[4 + i] * 255.f, i, w.y); }
                        *(u32x2*)((unsigned char*)SG + (size_t)(row0 + ai * 128 + m * 16) * 4096 + (pn - 8) * 256 + col0 + bj * 128) = w; }
                    else { u32x4 w; w.x = cvt_pk_bf16(v[0], v[1]); w.y = cvt_pk_bf16(v[2], v[3]); w.z = cvt_pk_bf16(v[4], v[5]); w.w = cvt_pk_bf16(v[6], v[7]);
                        *(u32x4*)(rowp + bj * 128) = w; } } }
        if (pn == 5 || pn == 6) {
            const float sc = (pn == 5) ? QSCALE : 1.f;
#pragma unroll
            for (int bj = 0; bj < 2; ++bj) { float mx = 0.f;
#pragma unroll
                for (int ai = 0; ai < 2; ++ai)
#pragma unroll
                    for (int m = 0; m < 4; ++m) { float ss = 0.f;
#pragma unroll
                        for (int n = 0; n < 2; ++n)
#pragma unroll
                            for (int q = 0; q < 4; ++q) { const float x = acc[ai][bj][m][n][q] * (sc * ASCALE); ss += x * x; }
                        ss = fq_sum(ss); mx = fmaxf(mx, ss); }
                mx = row16_max_dpp(mx);
                if (fr == 0 && fq == 0) atomicMax(NRM + ((((pn - 5) * 2 + (u.pm >> 5)) * 4 + 2 * bj + (wc >> 1)) * 2 + (wc & 1)), __float_as_uint(mx)); } }
    } };
struct Epi2 { static constexpr bool PERM = true; static constexpr int NBJ = 1; const unsigned char* SG; bf16_t* MRG; mutable f32x4 mrg[2][4][2];
    __device__ __forceinline__ void operator()(const Acc& acc, const Unit& u, int wr, int wc, int fr, int fq) const {
        asm volatile("" : "+v"(fr), "+v"(fq));
        const int n_ = u.a; const int row0 = u.pm * 256 + wr * 64 + fr, col0 = u.pn * 128 + wc * 32 + 8 * fq;
        u32x2 g[2][4];
#pragma unroll
        for (int ai = 0; ai < 2; ++ai)
#pragma unroll
            for (int m = 0; m < 4; ++m) g[ai][m] = *(const u32x2*)(SG + (size_t)(row0 + ai * 128 + m * 16) * 4096 + n_ * 1024 + col0);
#pragma unroll
        for (int ai = 0; ai < 2; ++ai)
#pragma unroll
            for (int m = 0; m < 4; ++m) { const u32x2 gg = g[ai][m]; const f32x4 a0 = acc[ai][0][m][0] * (1.f / 255.f), a1 = acc[ai][0][m][1] * (1.f / 255.f);
                const f32x4 t0 = (f32x4){(float)(gg.x & 255u) * a0[0], (float)((gg.x >> 8) & 255u) * a0[1], (float)((gg.x >> 16) & 255u) * a0[2], (float)(gg.x >> 24) * a0[3]};
                const f32x4 t1 = (f32x4){(float)(gg.y & 255u) * a1[0], (float)((gg.y >> 8) & 255u) * a1[1], (float)((gg.y >> 16) & 255u) * a1[2], (float)(gg.y >> 24) * a1[3]};
                if (n_ == 0) { mrg[ai][m][0] = t0; mrg[ai][m][1] = t1; } else { mrg[ai][m][0] = mrg[ai][m][0] + t0; mrg[ai][m][1] = mrg[ai][m][1] + t1; }
                if (n_ == 3) { const f32x4 r0 = mrg[ai][m][0], r1 = mrg[ai][m][1];
                    u32x4 w; w.x = cvt_pk_bf16(r0[0], r0[1]); w.y = cvt_pk_bf16(r0[2], r0[3]); w.z = cvt_pk_bf16(r1[0], r1[1]); w.w = cvt_pk_bf16(r1[2], r1[3]);
                    *(u32x4*)(MRG + (size_t)(row0 + ai * 128 + m * 16) * 1024 + col0) = w; } }
    } };
struct Epi3 { static constexpr bool PERM = true; static constexpr int NBJ = 2; const float* xin32; bf16_t* X; const float* gate;
    __device__ __forceinline__ void operator()(const Acc& acc, const Unit& u, int wr, int wc, int fr, int fq) const {
        asm volatile("" : "+v"(fr), "+v"(fq));
        const int b = u.pm >> 5; const float* gp = gate + (size_t)b * 6144 + 2 * 1024;
        const int row0 = u.pm * 256 + wr * 64 + fr, col0 = u.pn * 256 + wc * 32 + 8 * fq;
#pragma unroll
        for (int bj = 0; bj < 2; ++bj) { const int col = col0 + bj * 128; const f32x4 g0 = *(const f32x4*)(gp + col), g1 = *(const f32x4*)(gp + col + 4);
#pragma unroll
            for (int ai = 0; ai < 2; ++ai)
#pragma unroll
                for (int m = 0; m < 4; ++m) { const size_t off = (size_t)(row0 + ai * 128 + m * 16) * 1024 + col; f32x4 x0, x1;
                    if (xin32) { x0 = *(const f32x4*)(xin32 + off); x1 = *(const f32x4*)(xin32 + off + 4); }
                    else { const u32x4 w = *(const u32x4*)(X + off); x0 = (f32x4){bflo(w.x), bfhi(w.x), bflo(w.y), bfhi(w.y)}; x1 = (f32x4){bflo(w.z), bfhi(w.z), bflo(w.w), bfhi(w.w)}; }
                    x0 = x0 + g0 * acc[ai][bj][m][0]; x1 = x1 + g1 * acc[ai][bj][m][1];
                    u32x4 o; o.x = cvt_pk_bf16(x0[0], x0[1]); o.y = cvt_pk_bf16(x0[2], x0[3]); o.z = cvt_pk_bf16(x1[0], x1[1]); o.w = cvt_pk_bf16(x1[2], x1[3]);
                    *(u32x4*)(X + off) = o; } }
    } };
struct EpiUp { static constexpr bool PERM = true; static constexpr int NBJ = 2; static constexpr float ASCALE = FP8_GA ? 1.f / 64.f : 1.f; bf16_t* HID; const float* GWP;
    __device__ __forceinline__ void operator()(const Acc& acc, const Unit& u, int wr, int wc, int fr, int fq) const {
        asm volatile("" : "+v"(fr), "+v"(fq));
#pragma unroll
        for (int ai = 0; ai < 2; ++ai)
#pragma unroll
            for (int m = 0; m < 4; ++m) { const int r = ai * 128 + wr * 64 + m * 16 + fr;
                if (r < u.b) { const size_t slot = (size_t)u.a + r; const float gw = (u.e < 64) ? GWP[u.c + r] : 1.f; float v[8];
#pragma unroll
                    for (int n = 0; n < 2; ++n)
#pragma unroll
                        for (int q = 0; q < 4; ++q) v[4 * n + q] = siluf_(acc[ai][0][m][n][q] * ASCALE) * (acc[ai][1][m][n][q] * ASCALE) * gw;
#if FP8_GB
                    u32x2 w; w.x = pk4_fp8(v[0] * 8.f, v[1] * 8.f, v[2] * 8.f, v[3] * 8.f); w.y = pk4_fp8(v[4] * 8.f, v[5] * 8.f, v[6] * 8.f, v[7] * 8.f);
                    *(u32x2*)((unsigned char*)HID + slot * 256 + u.pn * 128 + wc * 32 + 8 * fq) = w; } }
#else
                    u32x4 w; w.x = cvt_pk_bf16(v[0], v[1]); w.y = cvt_pk_bf16(v[2], v[3]); w.z = cvt_pk_bf16(v[4], v[5]); w.w = cvt_pk_bf16(v[6], v[7]);
                    *(u32x4*)(HID + slot * 256 + u.pn * 128 + wc * 32 + 8 * fq) = w; } }
#endif
    } };
struct EpiDown { static constexpr bool PERM = true; static constexpr int NBJ = 2; static constexpr float ASCALE = FP8_GB ? 1.f / 512.f : 1.f; unsigned char* Y2Q; float* Y2S;
    __device__ __forceinline__ void operator()(const Acc& acc, const Unit& u, int wr, int wc, int fr, int fq) const {
        asm volatile("" : "+v"(fr), "+v"(fq));
#pragma unroll
        for (int ai = 0; ai < 2; ++ai)
#pragma unroll
            for (int m = 0; m < 4; ++m) { const int r = ai * 128 + wr * 64 + m * 16 + fr; const size_t slot = (size_t)u.a + r;
#pragma unroll
                for (int bj = 0; bj < 2; ++bj) { const f32x4 a0 = acc[ai][bj][m][0], a1 = acc[ai][bj][m][1];
                    float mx = fmaxf(fmaxf(fmaxf(fabsf(a0[0]), fabsf(a0[1])), fmaxf(fabsf(a0[2]), fabsf(a0[3]))), fmaxf(fmaxf(fabsf(a1[0]), fabsf(a1[1])), fmaxf(fabsf(a1[2]), fabsf(a1[3]))));
                    mx = fq_max(mx);
                    const float sc = mx * (ASCALE / 127.f), inv = mx > 0.f ? 127.f * frcp(mx) : 0.f;
                    unsigned w0 = 0u, w1 = 0u;
#pragma unroll
                    for (int i = 0; i < 4; ++i) { w0 = __builtin_amdgcn_cvt_pk_u8_f32(a0[i] * inv + 128.f, i, w0); w1 = __builtin_amdgcn_cvt_pk_u8_f32(a1[i] * inv + 128.f, i, w1); }
                    if (r < u.b) { *(u32x2*)(Y2Q + slot * 1024 + u.pn * 256 + bj * 128 + wc * 32 + 8 * fq) = (u32x2){w0, w1};
                        if (fq == 0) Y2S[slot * 32 + u.pn * 8 + bj * 4 + wc] = sc; } } }
    } };

__device__ __forceinline__ void phase_token(const Params& P, LAS unsigned char* lds, int l, int bid, int G, const int g_wave, int ctr) {
    const int tid = TIDX, lane = tid & 63, wave = __builtin_amdgcn_readfirstlane(tid >> 6);
    constexpr int AP = 1032;
    LAS bf16_t* Ahi = (LAS bf16_t*)lds; LAS bf16_t* Alo = (LAS bf16_t*)(lds + 16 * AP * 2);
    LAS float* part = (LAS float*)(lds + 2 * 16 * AP * 2);
    LAS int* cntw = (LAS int*)(lds + 2 * 16 * AP * 2 + 8192); LAS int* basew = cntw + 8 * 64;
    const float* MOD = (const float*)(wsptr(P) + WS_SMALL + SM_MOD);
    const bf16_t* X = (const bf16_t*)(wsptr(P) + WS_X); bf16_t* H = (bf16_t*)(wsptr(P) + WS_H);
    int* TE = (int*)(wsptr(P) + WS_SMALL + SM_TE); int* TP = (int*)(wsptr(P) + WS_SMALL + SM_TP);
    int* IDXP = (int*)(wsptr(P) + WS_SMALL + SM_IDXP); float* GWP = (float*)(wsptr(P) + WS_SMALL + SM_GWP);
    unsigned* CNT = (unsigned*)(wsptr(P) + WS_CTL) + CW_CNT + ctr * 64;
    const int nt = wave & 3, kh = wave >> 2, kq = lane >> 4;
    bf16x8 bhi[16], blo[16];
    { const bf16_t* WRT = (const bf16_t*)(wsptr(P) + WS_WB) + WB_WR + (size_t)(16 * nt + (lane & 15)) * 1024 + kh * 512 + 8 * kq;
#pragma unroll
      for (int ks = 0; ks < 16; ++ks) { bhi[ks] = *(const bf16x8*)(WRT + 32 * ks); blo[ks] = *(const bf16x8*)(WRT + 65536 + 32 * ks); } }
    const float rb = inptr(I_RB)[l * 64 + lane];
    for (int grp = bid; grp < M / 64; grp += G) {
        int selk[8]; float selw[8]; int cnt = 0;
        f32x4 mA[4], mB[4];
        { const float* md = MOD + (size_t)(l * 2 + ((grp * 64) >> 13)) * 6144;
#pragma unroll
          for (int j = 0; j < 4; ++j) { const int d0 = 256 * j + 4 * lane; mA[j] = *(const f32x4*)(inptr(I_FNG) + l * D + d0) * (*(const f32x4*)(md + 4 * 1024 + d0) + 1.0f); mB[j] = *(const f32x4*)(md + 3 * 1024 + d0); } }
        u32x2 vx[2][4];
#pragma unroll
        for (int i2 = 0; i2 < 2; ++i2)
#pragma unroll
            for (int j = 0; j < 4; ++j) vx[i2][j] = *(const u32x2*)(X + (size_t)(grp * 64 + 2 * wave + i2) * D + 256 * j + 4 * lane);
#pragma unroll
        for (int sub = 0; sub < 4; ++sub) {
#pragma unroll
            for (int i2 = 0; i2 < 2; ++i2) { const int tl = 2 * wave + i2, row = grp * 64 + sub * 16 + tl;
                f32x4 v[4]; float ss = 0.f;
#pragma unroll
                for (int j = 0; j < 4; ++j) { const u32x2 w_ = vx[i2][j]; v[j] = (f32x4){bflo(w_.x), bfhi(w_.x), bflo(w_.y), bfhi(w_.y)}; ss += (v[j][0] * v[j][0] + v[j][1] * v[j][1]) + (v[j][2] * v[j][2] + v[j][3] * v[j][3]); }
                if (sub < 3) {
#pragma unroll
                    for (int j = 0; j < 4; ++j) vx[i2][j] = *(const u32x2*)(X + (size_t)(row + 16) * D + 256 * j + 4 * lane); }
                const float rms = 1.0f / sqrtf(wave_sum(ss) * (1.f / D) + EPS);
#pragma unroll
                for (int j = 0; j < 4; ++j) { const int d0 = 256 * j + 4 * lane;
                    const f32x4 h = v[j] * rms * mA[j] + mB[j];
                    u32x2 w; w.x = cvt_pk_bf16(h[0], h[1]); w.y = cvt_pk_bf16(h[2], h[3]);
#if FP8_GA
                    *(unsigned*)((unsigned char*)(wsptr(P) + WS_HF8) + (size_t)row * D + d0) = pk4_fp8(h[0], h[1], h[2], h[3]);
#else
                    *(u32x2*)(H + (size_t)row * D + d0) = w;
#endif
                    *(LAS u32x2*)(Ahi + tl * AP + d0) = w;
                    u32x2 wl; wl.x = cvt_pk_bf16(h[0] - bflo(w.x), h[1] - bfhi(w.x)); wl.y = cvt_pk_bf16(h[2] - bflo(w.y), h[3] - bfhi(w.y)); *(LAS u32x2*)(Alo + tl * AP + d0) = wl; } }
            __syncthreads();
            { f32x4 a0 = (f32x4){0.f, 0.f, 0.f, 0.f}, a1 = a0, a2 = a0; const int ao = (lane & 15) * AP + kh * 512 + 8 * kq;
#pragma unroll
              for (int ks = 0; ks < 16; ++ks) { const bf16x8 ahi = *(const LAS bf16x8*)(Ahi + ao + 32 * ks), alo = *(const LAS bf16x8*)(Alo + ao + 32 * ks);
                  a0 = __builtin_amdgcn_mfma_f32_16x16x32_bf16(ahi, bhi[ks], a0, 0, 0, 0); a1 = __builtin_amdgcn_mfma_f32_16x16x32_bf16(alo, bhi[ks], a1, 0, 0, 0);
                  a2 = __builtin_amdgcn_mfma_f32_16x16x32_bf16(ahi, blo[ks], a2, 0, 0, 0); }
              const f32x4 acc = a0 + (a1 + a2);
#pragma unroll
              for (int j = 0; j < 4; ++j) part[(kh * 16 + 4 * kq + j) * 64 + 16 * nt + (lane & 15)] = acc[j]; }
            __syncthreads();
            {
                float score[2], sel[2], m1[2], m2[2], gs[2], cand[2]; int i1[2], grank[2], myrank[2];
#pragma unroll
                for (int i2 = 0; i2 < 2; ++i2) { const int tl = 2 * wave + i2; score[i2] = sigmoidf_(part[tl * 64 + lane] + part[(16 + tl) * 64 + lane]); sel[i2] = score[i2] + rb; m1[i2] = grp8_max_dpp(sel[i2]); }
#pragma unroll
                for (int i2 = 0; i2 < 2; ++i2) i1[i2] = grp8_min_dpp((sel[i2] == m1[i2]) ? lane : 64);
#pragma unroll
                for (int i2 = 0; i2 < 2; ++i2) m2[i2] = grp8_max_dpp((lane == i1[i2]) ? -INFINITY : sel[i2]);
                const int grp_id = lane >> 3;
#pragma unroll
                for (int i2 = 0; i2 < 2; ++i2) { gs[i2] = m1[i2] + m2[i2]; grank[i2] = 0; }
#pragma unroll
                for (int j = 0; j < 8; ++j)
#pragma unroll
                    for (int i2 = 0; i2 < 2; ++i2) { const float o = __builtin_bit_cast(float, __builtin_amdgcn_readlane(__builtin_bit_cast(int, gs[i2]), 8 * j)); grank[i2] += (o > gs[i2] || (o == gs[i2] && j < grp_id)) ? 1 : 0; }
#pragma unroll
                for (int i2 = 0; i2 < 2; ++i2) { cand[i2] = (grank[i2] < 4) ? sel[i2] : -INFINITY; myrank[i2] = -1; }
#pragma unroll
                for (int k = 0; k < TOPK; ++k) {
#pragma unroll
                    for (int i2 = 0; i2 < 2; ++i2) { const float mx = wave_max_dpp(cand[i2]); const int first = __ffsll((unsigned long long)__ballot(cand[i2] == mx)) - 1; if (lane == first) { myrank[i2] = k; cand[i2] = -INFINITY; } } }
#pragma unroll
                for (int i2 = 0; i2 < 2; ++i2) { const bool chosen = myrank[i2] >= 0; const float den = wave_sum_dpp(chosen ? score[i2] : 0.f);
                    selk[sub * 2 + i2] = myrank[i2]; selw[sub * 2 + i2] = score[i2] / den * 2.5f; cnt += chosen ? 1 : 0; } }
            __syncthreads();
        }
        cntw[wave * 64 + lane] = cnt;
        __syncthreads();
        if (tid < 64) { int tot = 0; int pre[8];
#pragma unroll
            for (int w = 0; w < 8; ++w) { pre[w] = tot; tot += cntw[w * 64 + tid]; }
            int base = 0; if (tot > 0) base = (int)__hip_atomic_fetch_add(CNT + tid, (unsigned)tot, __ATOMIC_RELAXED, __HIP_MEMORY_SCOPE_AGENT);
#pragma unroll
            for (int w = 0; w < 8; ++w) basew[w * 64 + tid] = base + pre[w]; }
        __syncthreads();
        int run = basew[wave * 64 + lane];
#pragma unroll
        for (int i = 0; i < 8; ++i) { const int t = grp * 64 + (i >> 1) * 16 + 2 * wave + (i & 1);
            if (selk[i] >= 0) { const int o = t * TOPK + selk[i]; TE[o] = lane; TP[o] = run; IDXP[lane * CAP + run] = t; GWP[lane * CAP + run] = selw[i]; ++run; } }
        __syncthreads();
    }
}
__device__ __forceinline__ int moe_tile_list(const Params& P, LAS unsigned char* lds, int l, const int g_wave) {
    moe_offsets(P, lds, l, g_wave);
    LAS const int* eo = (LAS const int*)(lds + EOFF_OFF); LAS i32x4* TL = (LAS i32x4*)(lds + TL_OFF);
    const int tid = TIDX; const int nrt = eo[64 + 63] + ((eo[128 + 63] + 255) >> 8);
    LAS int* TLi = (LAS int*)(lds + TL_OFF);
    if (tid < 64) { const int e = tid, n = eo[128 + e], t0 = eo[64 + e];
#pragma unroll 1
        for (int j = 0; j * 256 < n; ++j) { LAS int* q = TLi + 4 * (t0 + 8 * (e >> 3) + j); q[0] = e; q[1] = eo[e] + j * 256; q[2] = (n - j * 256 < 256) ? n - j * 256 : 256; q[3] = e * CAP + j * 256; } }
    else if (tid < 128) { const int s_ = tid - 64, g_ = s_ >> 3; LAS int* q = TLi + 4 * ((g_ < 7 ? eo[64 + 8 * (g_ + 1)] : nrt) + s_); q[0] = opaque(64); q[1] = NPAIR + s_ * 256; q[2] = opaque(256); q[3] = 64 * CAP + s_ * 256; }
    __syncthreads();
    return nrt + 64;
}

constexpr int PH_PER_LAYER = 8, N_PHASES = 1 + NL * PH_PER_LAYER + 1;
__global__ void __launch_bounds__(NTHREADS, 2) fwd_kernel(Params P) {
    LAS unsigned char* lds = (LAS unsigned char*)lds_raw;
    const int wave = __builtin_amdgcn_readfirstlane((int)threadIdx.x >> 6);
    int bid = blockIdx.x, G = gridDim.x;
    const int g_wave = wave; const int tid = TIDX;
    int gw = bid * NWAVES + wave, NGW = G * NWAVES;
    if (tid < 64) ((LAS unsigned*)(lds + LDSCTL_OFF))[tid] = 0u;
    if (tid == 0) {
#pragma unroll
        for (int i = 0; i < 29; ++i) *(LAS unsigned long long*)(lds + PTRS_OFF + 8 * i) = (unsigned long long)P.in[i];
        *(LAS unsigned long long*)(lds + PTRS_OFF + 8 * 29) = (unsigned long long)P.ws; }
    __syncthreads();
    unsigned* ctl = (unsigned*)(wsptr(P) + WS_CTL);
#if MK_ONE_LAUNCH
    XcdBarrier bar = xcd_barrier_post(ctl + CW_BAR, (volatile LAS unsigned*)(lds + MISC_OFF) + 8, wave);
#define SEAM() xcd_barrier(bar, wave)
#else
#define SEAM() do {} while (0)
#endif
    const int lo = P.ph_lo, hi = P.ph_hi;
#ifndef KMASK
#define KMASK 0xffff
#endif
#define IN(k) (lo <= (k) && (k) < hi)
#define KIND(j) ((KMASK >> (j)) & 1)
#define BOTH(k) (IN(k) && IN((k) + 1))
#define WB ((bf16_t*)(wsptr(P) + WS_WB))
#define X ((float*)(wsptr(P) + WS_X))
#define H ((bf16_t*)(wsptr(P) + WS_H))
#define YS ((bf16_t*)(wsptr(P) + WS_YS))
#define MRG ((bf16_t*)(wsptr(P) + WS_MRG))
#define HID ((bf16_t*)(wsptr(P) + WS_HID))
#define PROJ ((bf16_t*)(wsptr(P) + WS_R1))
#define SG (PROJ + (size_t)M * 2048)
#define Y2 ((bf16_t*)(wsptr(P) + WS_R1))
#define MOD ((const float*)(wsptr(P) + WS_SMALL + SM_MOD))
#define SOPQ(v) asm volatile("" : "+s"(v))
#ifndef DUPK
#define DUPK -1
#endif
#define REP(k) for (int rep_ = 0; rep_ < ((DUPK == (k)) ? 2 : 1); ++rep_, ((DUPK == (k)) && rep_ == 1 ? (SEAM(), 0) : 0))
    if (KIND(0) && IN(0)) { REP(0) phase_ada(P, lds, bid, G, wave); if (BOTH(0)) SEAM(); }

    for (int l = 0; l < NL; ++l) {
        const int pb = 1 + l * PH_PER_LAYER;
        if (KIND(1) && IN(pb + 0)) { SOPQ(bid); SOPQ(G); SOPQ(gw); SOPQ(NGW);
            REP(1) phase_convert<true>(P, lds, l, gw, NGW, wave, 0, CVT_EARLY);
            __syncthreads();
            if (l == 0) { for (int rep_ = 0; rep_ < ((DUPK == 12) ? 2 : 1); ++rep_) phase_norm1<0>(P, lds, l, gw, NGW, wave); } else phase_norm1<1>(P, lds, l, gw, NGW, wave);
            if (BOTH(pb + 0)) SEAM();
        }
        if (KIND(2) && IN(pb + 1)) { SOPQ(bid); SOPQ(G); SOPQ(gw); SOPQ(NGW);
            if (bid == 0) { scan_logf(P, wave); VM_WAIT(); __syncthreads(); }
#if FP8_G1
            pg8::Gemm g{(const bf16_t*)(wsptr(P) + WS_HF8), WB + WB_WIN, 512, 512, 512, nullptr}; SchedDense S{64, 24, G, bid, 512, 512}; Epi1 E{PROJ, SG, ctl + CW_NRM + 64 * l};
            REP(2) pg8::gemm_phase<Epi1, SchedDense, false, true>(lds, g, S, E, wave);
#else
            pg8::Gemm g{H, WB + WB_WIN, 1024, 1024, 1024, nullptr}; SchedDense S{64, 24, G, bid, 1024, 1024}; Epi1 E{PROJ, SG, ctl + CW_NRM + 64 * l};
            REP(2) pg8::gemm_phase<Epi1, SchedDense, false>(lds, g, S, E, wave);
#endif
            if (BOTH(pb + 1)) SEAM();
        }
        if (KIND(3) && IN(pb + 2)) { SOPQ(bid); SOPQ(G); SOPQ(gw); SOPQ(NGW);
            REP(3) {
            unsigned* qheads = ctl + CW_QS + ((l * 2 + rep_) * 8) * 64; LAS int* qitem = (LAS int*)(lds + MISC_OFF) + 16;
            const bf16_t* CBp = (const bf16_t*)(wsptr(P) + WS_SMALL + SM_CB);
            constexpr int NCV = (CVT_ALL - CVT_EARLY + 7) / 8, NI = 896 + NCV;
            int sh = bid & 7, dry = 0;
            for (;;) {
                if (TIDX == 0) *qitem = (int)__hip_atomic_fetch_add(qheads + 64 * sh, 1u, __ATOMIC_RELAXED, __HIP_MEMORY_SCOPE_AGENT);
                __syncthreads();
                const int it = __builtin_amdgcn_readfirstlane(*qitem) * 8 + sh;
                __syncthreads();
                if (it >= NI) { if (++dry >= 8) break; sh = (sh + 1) & 7; continue; }
                if (it >= 256 && it < 256 + NCV) { phase_convert<false>(P, lds, l, wave, 8, wave, CVT_EARLY + (it - 256) * 8, min(CVT_EARLY + (it - 256) * 8 + 8, CVT_ALL)); continue; }
                if (it < 256) {
                    const int qb = 31 - (it >> 3), bh = (it + (it >> 3)) & 7;
                    int t0 = 0;
                    { const unsigned* nq = ctl + CW_NRM + 64 * l + bh * 2; const unsigned* nk = nq + 16;
                      const float qn2 = __uint_as_float(__hip_atomic_load(nq, __ATOMIC_RELAXED, __HIP_MEMORY_SCOPE_AGENT)) + __uint_as_float(__hip_atomic_load(nq + 1, __ATOMIC_RELAXED, __HIP_MEMORY_SCOPE_AGENT));
                      const float kn2 = __uint_as_float(__hip_atomic_load(nk, __ATOMIC_RELAXED, __HIP_MEMORY_SCOPE_AGENT)) + __uint_as_float(__hip_atomic_load(nk + 1, __ATOMIC_RELAXED, __HIP_MEMORY_SCOPE_AGENT));
                      const float thr = 2.f * 1.02f * sqrtf(qn2 * kn2) + 160.f;
                      const float* cum = (const float*)(wsptr(P) + WS_SMALL + SM_CUM) + (size_t)bh * SEQ; const float ci = cum[qb * 256];
                      const int ln = lane_id(); int cnt = 0;
#pragma unroll
                      for (int k2 = 0; k2 < 2; ++k2) { const int J = ln + 64 * k2; const bool sk = (J < 4 * qb) && (cum[(J < 128 ? J : 127) * 64 + 63] - ci > thr); cnt += __popcll(__ballot(sk)); }
                      t0 = __builtin_amdgcn_readfirstlane(cnt) & ~1; }
                    fa::attn_unit<8>(bh >> 2, bh & 3, qb, t0, PROJ + 1280, PROJ + 1536, PROJ + 1792, CBp, YS + 768, (char*)lds_raw, wave);
                }
                else if (it < NCV + 384) sg_unit(P, lds, l, it - NCV - 256, wave);
                else if (it < NCV + 640) conv_unit(P, lds, l, it - NCV - 384, wave);
                else pool_unit(P, lds, l, it - NCV - 640, wave);
            }
            }
            if (BOTH(pb + 2)) SEAM();
        }
        if (KIND(4) && IN(pb + 3)) { SOPQ(bid); SOPQ(G); SOPQ(gw); SOPQ(NGW);
            pg8::Gemm g{YS, WB + WB_WBR, 1024, 256, 256, nullptr}; SchedG2 S{G, bid}; Epi2 E{(const unsigned char*)SG, MRG, {}};
            REP(4) pg8::gemm_phase<Epi2, SchedG2, false>(lds, g, S, E, wave);
            if (BOTH(pb + 3)) SEAM();
        }
        if (KIND(5) && IN(pb + 4)) { SOPQ(bid); SOPQ(G); SOPQ(gw); SOPQ(NGW);
            pg8::Gemm g{MRG, WB + WB_WOUT, 1024, 1024, 1024, nullptr}; SchedDense S{64, 4, G, bid, 1024, 1024}; Epi3 E{l == 0 ? inptr(I_X) : (const float*)nullptr, (bf16_t*)X, MOD + (size_t)l * 2 * 6144};
            for (int rep_ = 0; rep_ < ((DUPK == 5 && l == 0) ? 2 : 1); ++rep_) pg8::gemm_phase<Epi3, SchedDense, false>(lds, g, S, E, wave);
            if (BOTH(pb + 4)) SEAM();
        }
        if (KIND(6) && IN(pb + 5)) { SOPQ(bid); SOPQ(G); SOPQ(gw); SOPQ(NGW); if (DUPK == 6) { phase_token(P, lds, l, bid, G, wave, 2 + l); SEAM(); } phase_token(P, lds, l, bid, G, wave, l); if (BOTH(pb + 5)) SEAM(); }
        if (KIND(10) && IN(pb + 6)) { SOPQ(bid); SOPQ(G); SOPQ(gw); SOPQ(NGW);
            const int x = bid & 7, j = bid >> 3, per = (G - x + 7) >> 3;
            const int nt = moe_tile_list(P, lds, l, wave); const int U = nt * 2;
#if FP8_GA
            pg8::Gemm g{(const bf16_t*)(wsptr(P) + WS_HF8), WB, 512, 512, 512, (const int*)(wsptr(P) + WS_SMALL + SM_IDXP)};
#else
            pg8::Gemm g{H, WB, 1024, 1024, 1024, (const int*)(wsptr(P) + WS_SMALL + SM_IDXP)};
#endif
            SchedMoe<2, false> S{(LAS const i32x4*)(lds + TL_OFF), (int)((long)U * x / 8), (int)((long)U * (x + 1) / 8), per, j};
            EpiUp E{HID, (const float*)(wsptr(P) + WS_SMALL + SM_GWP)};
            REP(10) pg8::gemm_phase<EpiUp, SchedMoe<2, false>, true, FP8_GA != 0>(lds, g, S, E, wave);
            if (BOTH(pb + 6)) SEAM();
        }
        if (KIND(11) && IN(pb + 7)) { SOPQ(bid); SOPQ(G); SOPQ(gw); SOPQ(NGW);
            const int x = bid & 7, j = bid >> 3, per = (G - x + 7) >> 3;
            const int nt = moe_tile_list(P, lds, l, wave); const int U = nt * 4;
#if FP8_GB
            pg8::Gemm g{HID, WB, 128, 128, 128, nullptr};
#else
            pg8::Gemm g{HID, WB, 256, 256, 256, nullptr};
#endif
            SchedMoe<4, true> S{(LAS const i32x4*)(lds + TL_OFF), (int)((long)U * x / 8), (int)((long)U * (x + 1) / 8), per, j};
            EpiDown E{(unsigned char*)Y2, (float*)(wsptr(P) + WS_R1 + Y2SC_OFF)};
            REP(11) pg8::gemm_phase<EpiDown, SchedMoe<4, true>, false, FP8_GB != 0>(lds, g, S, E, wave);
            if (BOTH(pb + 7)) SEAM();
        }
    }
    if (KIND(12) && IN(N_PHASES - 1)) { REP(13) phase_norm1<2>(P, lds, NL, gw, NGW, wave); }
#undef IN
#undef BOTH
#undef SEAM
#undef WB
#undef X
#undef H
#undef YS
#undef MRG
#undef HID
#undef PROJ
#undef SG
#undef Y2
#undef MOD
}

extern "C" void kernel_launch(void* const* d_in, const int* in_sizes, int n_in, void* d_out, int out_size, void* d_ws, size_t ws_size, hipStream_t stream) {
    static int grid = 0;
    if (grid == 0) {
        if (n_in != 29 || out_size != M * D || ws_size < WS_END) { fprintf(stderr, "kernel_launch: unexpected shapes (n_in %d, out %d, ws %zu)\n", n_in, out_size, ws_size); grid = -1; return; }
        int dev = 0, cus = 0;
        if (hipGetDevice(&dev) != hipSuccess || hipDeviceGetAttribute(&cus, hipDeviceAttributeMultiprocessorCount, dev) != hipSuccess) { grid = -1; return; }
        if (hipFuncSetAttribute((const void*)fwd_kernel, hipFuncAttributeMaxDynamicSharedMemorySize, LDS_BYTES) != hipSuccess) { fprintf(stderr, "kernel_launch: hipFuncSetAttribute failed\n"); grid = -1; return; }
        int per_cu = 0;
        if (hipOccupancyMaxActiveBlocksPerMultiprocessor(&per_cu, (const void*)fwd_kernel, NTHREADS, LDS_BYTES) != hipSuccess || per_cu < 1) { fprintf(stderr, "kernel_launch: occupancy query says %d\n", per_cu); }
        (void)hipGetLastError();
        grid = cus;
    }
    if (grid < 0) return;
    (void)hipMemsetAsync((char*)d_ws + WS_CTL, 0, CTL_ZERO_BYTES, stream);
    Params p; memset(&p, 0, sizeof(p));
    for (int i = 0; i < 29; ++i) p.in[i] = (const float*)d_in[i];
    p.out = (float*)d_out; p.ws = (unsigned char*)d_ws;
#if MK_ONE_LAUNCH
    p.ph_lo = 0; p.ph_hi = N_PHASES;
    hipLaunchKernelGGL(fwd_kernel, dim3(grid), dim3(NTHREADS), LDS_BYTES, stream, p);
#else
    for (int k = 0; k < N_PHASES; ++k) { p.ph_lo = k; p.ph_hi = k + 1; hipLaunchKernelGGL(fwd_kernel, dim3(grid), dim3(NTHREADS), LDS_BYTES, stream, p); }
#endif
}
```

```cpp
#include <hip/hip_runtime.h>
#include <cstdio>
#include <cstdint>
#include <cstring>

#ifndef MK_ONE_LAUNCH
#define MK_ONE_LAUNCH 1
#endif

#ifndef FP8_G1
#define FP8_G1 1
#endif
#ifndef FP8_GB
#define FP8_GB 1
#endif
#ifndef FP8_GA
#define FP8_GA 1
#endif
#define LAS __attribute__((address_space(3)))
#define TIDX (g_wave * 64 + lane_id())
#define GAS __attribute__((address_space(1)))
typedef unsigned short bf16_t;
typedef short bf16x8 __attribute__((ext_vector_type(8)));
typedef float f32x4 __attribute__((ext_vector_type(4)));
typedef float f32x2 __attribute__((ext_vector_type(2)));
typedef unsigned u32x4 __attribute__((ext_vector_type(4)));
typedef unsigned u32x2 __attribute__((ext_vector_type(2)));
typedef int i32x4 __attribute__((ext_vector_type(4)));
typedef int i32x8 __attribute__((ext_vector_type(8)));

constexpr int NB = 2, SEQ = 8192, M = NB * SEQ, D = 1024, NL = 2;
constexpr int COLT = 6148;
constexpr int NE = 64, TOPK = 6, EFF = 256;
constexpr int NPAIR = M * TOPK;
constexpr float EPS = 1e-6f;
constexpr float LOG2E = 1.4426950408889634f;
constexpr float QSCALE = 0.125f * LOG2E;
constexpr int NWAVES = 8, NTHREADS = 512;

constexpr size_t MiB = 1u << 20;
constexpr size_t WS_CTL = 0;
constexpr size_t CTL_ZERO_BYTES = 1 * MiB;
constexpr size_t WS_SMALL = 1 * MiB;
constexpr size_t WS_WB = 24 * MiB;
constexpr size_t WS_X = 138 * MiB;
constexpr size_t WS_H = 202 * MiB;
constexpr size_t WS_YS = 234 * MiB;
constexpr size_t WS_MRG = 266 * MiB;
constexpr size_t WS_HID = 298 * MiB;
constexpr size_t WS_R1 = 354 * MiB;
constexpr size_t Y2SC_OFF = 112 * MiB;
constexpr size_t WS_HF8 = 546 * MiB;
constexpr size_t WS_END = 562 * MiB;
constexpr size_t WB_WIN = 0;
constexpr size_t WB_WBR = WB_WIN + (size_t)6144 * 1024;
constexpr size_t WB_WOUT = WB_WBR + (size_t)4 * 1024 * 256;
constexpr size_t WB_WR = WB_WOUT + (size_t)1024 * 1024;
constexpr size_t WB_W13 = WB_WR + (size_t)256 * 1024;
constexpr size_t WB_W2 = WB_W13 + (size_t)65 * 512 * 1024;
constexpr size_t WB_ELEMS = WB_W2 + (size_t)65 * 1024 * 256;
static_assert(WB_ELEMS * 2 <= 114 * MiB, "weights region");
constexpr size_t SM_MOD = 0;
constexpr size_t SM_LOGF = 128 * 1024;
constexpr size_t SM_CUM = SM_LOGF + (size_t)M * 16;
constexpr size_t SM_CB = SM_CUM + (size_t)8 * SEQ * 4;
constexpr int CAP = 16384;
constexpr size_t SM_TE = SM_CB + (size_t)8 * SEQ * 32;
constexpr size_t SM_TP = SM_TE + (size_t)NPAIR * 4;
constexpr size_t SM_IDXP = SM_TP + (size_t)NPAIR * 4;
constexpr size_t SM_GWP = SM_IDXP + (size_t)65 * CAP * 4;
constexpr size_t SM_SGWM = SM_GWP + (size_t)64 * CAP * 4;
constexpr size_t SM_PWT = SM_SGWM + (size_t)4 * 128 * 128 * 2;
constexpr size_t SM_END = SM_PWT + (size_t)4 * 64 * 64 * 2;
static_assert(SM_END <= 23 * MiB, "small region");
constexpr int CW_BAR = 4096;
constexpr int CW_CNT = 16384;
constexpr int CW_Q = 16384 + 256;
constexpr int CW_QS = 16384 + 4096;
constexpr int CW_NRM = 16384 + 512;

constexpr int RING_BYTES = 131072;
constexpr int LDSCTL_OFF = RING_BYTES;
constexpr int MISC_OFF = LDSCTL_OFF;
constexpr int TL_OFF = LDSCTL_OFF + 256;
constexpr int TLN_OFF = TL_OFF + 512 * 16;
constexpr int EOFF_OFF = TLN_OFF + 16;
constexpr int PTRS_OFF = EOFF_OFF + 3 * 64 * 4;
constexpr int LDS_BYTES = 147456;
static_assert(PTRS_OFF + 32 * 8 <= LDS_BYTES, "LDS map");

__device__ __forceinline__ int lane_id() { int r; asm volatile("v_mbcnt_lo_u32_b32 %0, -1, 0\n\tv_mbcnt_hi_u32_b32 %0, -1, %0" : "=v"(r)); return r; }
__device__ __forceinline__ int opaque(int v) { asm volatile("" : "+v"(v)); return v; }
#define LDS_WAIT() asm volatile("s_waitcnt lgkmcnt(0)" ::: "memory")
#define VM_WAIT() asm volatile("s_waitcnt vmcnt(0)" ::: "memory")
__device__ __forceinline__ unsigned cvt_pk_bf16(float lo, float hi) { unsigned r; asm volatile("v_cvt_pk_bf16_f32 %0, %1, %2" : "=v"(r) : "v"(lo), "v"(hi)); return r; }
__device__ __forceinline__ float bflo(unsigned w) { return __uint_as_float(w << 16); }
__device__ __forceinline__ float bfhi(unsigned w) { return __uint_as_float(w & 0xffff0000u); }
__device__ __forceinline__ float bf2f(bf16_t h) { return __uint_as_float((unsigned)h << 16); }
__device__ __forceinline__ bf16_t f2bf(float f) { return (bf16_t)(cvt_pk_bf16(f, 0.f) & 0xffffu); }
#define DPPI(old, src, ctrl, rm, bm) __builtin_amdgcn_update_dpp((int)(old), (int)(src), ctrl, rm, bm, false)
#define DPPF(old, src, ctrl, rm, bm) __builtin_bit_cast(float, __builtin_amdgcn_update_dpp(__builtin_bit_cast(int, (float)(old)), __builtin_bit_cast(int, (float)(src)), ctrl, rm, bm, false))
__device__ __forceinline__ float wave_max_dpp(float v) {
    v = fmaxf(v, DPPF(v, v, 0x111, 0xf, 0xf)); v = fmaxf(v, DPPF(v, v, 0x112, 0xf, 0xf)); v = fmaxf(v, DPPF(v, v, 0x114, 0xf, 0xf)); v = fmaxf(v, DPPF(v, v, 0x118, 0xf, 0xf));
    v = fmaxf(v, DPPF(v, v, 0x142, 0xa, 0xf)); v = fmaxf(v, DPPF(v, v, 0x143, 0xc, 0xf));
    return __builtin_bit_cast(float, __builtin_amdgcn_readlane(__builtin_bit_cast(int, v), 63));
}
__device__ __forceinline__ float wave_sum_dpp(float v) {
    v += DPPF(0.f, v, 0x111, 0xf, 0xf); v += DPPF(0.f, v, 0x112, 0xf, 0xf); v += DPPF(0.f, v, 0x114, 0xf, 0xf); v += DPPF(0.f, v, 0x118, 0xf, 0xf);
    v += DPPF(0.f, v, 0x142, 0xa, 0xf); v += DPPF(0.f, v, 0x143, 0xc, 0xf);
    return __builtin_bit_cast(float, __builtin_amdgcn_readlane(__builtin_bit_cast(int, v), 63));
}
__device__ __forceinline__ float grp8_max_dpp(float v) { v = fmaxf(v, DPPF(v, v, 0xB1, 0xf, 0xf)); v = fmaxf(v, DPPF(v, v, 0x4E, 0xf, 0xf)); v = fmaxf(v, DPPF(v, v, 0x141, 0xf, 0xf)); return v; }
__device__ __forceinline__ int grp8_min_dpp(int v) { v = min(v, DPPI(v, v, 0xB1, 0xf, 0xf)); v = min(v, DPPI(v, v, 0x4E, 0xf, 0xf)); v = min(v, DPPI(v, v, 0x141, 0xf, 0xf)); return v; }
__device__ __forceinline__ float wave_sum(float v) { return wave_sum_dpp(v); }
__device__ __forceinline__ float fq_max(float m) {
    auto r = __builtin_amdgcn_permlane16_swap(__float_as_uint(m), __float_as_uint(m), false, false); m = fmaxf(__uint_as_float(r[0]), __uint_as_float(r[1]));
    auto r2 = __builtin_amdgcn_permlane32_swap(__float_as_uint(m), __float_as_uint(m), false, false); return fmaxf(__uint_as_float(r2[0]), __uint_as_float(r2[1])); }
__device__ __forceinline__ float fq_sum(float m) {
    auto r = __builtin_amdgcn_permlane16_swap(__float_as_uint(m), __float_as_uint(m), false, false); m = __uint_as_float(r[0]) + __uint_as_float(r[1]);
    auto r2 = __builtin_amdgcn_permlane32_swap(__float_as_uint(m), __float_as_uint(m), false, false); return __uint_as_float(r2[0]) + __uint_as_float(r2[1]); }
__device__ __forceinline__ float row16_max_dpp(float v) { v = grp8_max_dpp(v); return fmaxf(v, DPPF(v, v, 0x140, 0xf, 0xf)); }
__device__ __forceinline__ float wave_scan_dpp(float v) {
    v += DPPF(0.f, v, 0x111, 0xf, 0xf); v += DPPF(0.f, v, 0x112, 0xf, 0xf); v += DPPF(0.f, v, 0x114, 0xf, 0xf); v += DPPF(0.f, v, 0x118, 0xf, 0xf);
    v += DPPF(0.f, v, 0x142, 0xa, 0xf); v += DPPF(0.f, v, 0x143, 0xc, 0xf); return v; }
__device__ __forceinline__ float fexp2(float x) { return __builtin_amdgcn_exp2f(x); }
__device__ __forceinline__ float frcp(float x) { return __builtin_amdgcn_rcpf(x); }
__device__ __forceinline__ float sigmoidf_(float x) { return frcp(1.f + fexp2(-LOG2E * x)); }
__device__ __forceinline__ float siluf_(float x) { return x * sigmoidf_(x); }
__device__ __forceinline__ float gelu_tanh(float x) {
    const float u = x + 0.044715f * x * x * x;
    return x * frcp(1.f + fexp2(-2.f * 0.7978845608028654f * LOG2E * u));
}

namespace pg8 {
constexpr int BM = 256, BK = 64, HALF = 128, HTB = HALF * BK * 2, STAGE_BYTES = 8 * HTB, NXCD = 8, WGM = 8;
__host__ __device__ __forceinline__ int lds_byte(int r, int c) { const int st = (r >> 4) * 2 + (c >> 5), rr = r & 15, cc = c & 31, ob = rr * 64 + cc * 2; return st * 1024 + (ob ^ (((ob >> 9) & 1) << 5)); }
__host__ __device__ __forceinline__ void stage_rc(int b, int& R, int& C) { const int st = b / 1024, sb = b % 1024, swz = sb ^ (((sb >> 9) & 1) << 5); R = (st >> 1) * 16 + swz / 64; C = (st & 1) * 32 + (swz % 64) / 2; }
__host__ __device__ __forceinline__ int perm32(int rho) { const int n = rho >> 4, i = rho & 15; return 8 * (i >> 2) + 4 * n + (i & 3); }

struct Unit { int pm, pn; int a, b, c, e; size_t aoff, boff; };
struct Gemm { const bf16_t* A; const bf16_t* Bt; int lda, ldb, K; const int* idx; };

__device__ __forceinline__ bool static_tile(int i, int G, int c, int nM, int nN, int& pm, int& pn) {
    const int nwg = nM * nN; const long L = (long)i * G + c; if (L >= nwg) return false;
    int wgid = (int)L; { const int q = nwg / NXCD, r = nwg % NXCD, xcd = wgid % NXCD, off = wgid / NXCD; wgid = (xcd < r ? xcd * (q + 1) : r * (q + 1) + (xcd - r) * q) + off; }
    const int nig = WGM * nN, gid = wgid / nig, fm = gid * WGM, gsz = (nM - fm) < WGM ? (nM - fm) : WGM;
    pm = fm + ((wgid % nig) % gsz); pn = (wgid % nig) / gsz; return true;
}

template <class Epi, class Sched, bool GATHER = false, bool FP8 = false>
__device__ __forceinline__ void gemm_phase(LAS unsigned char* lds, const Gemm g, const Sched& S, const Epi& E, const int g_wave) {
    const int tid = TIDX, wid = __builtin_amdgcn_readfirstlane(tid >> 6), lane = tid & 63, wr = wid >> 2, wc = wid & 3, fr = lane & 15, fq = lane >> 4;
    constexpr int NBJ = Epi::NBJ;
    const int K = g.K, nt = K / BK;
    unsigned voffA[2], voffB[2];
#pragma unroll
    for (int i = 0; i < 2; ++i) { int R, C; stage_rc(tid * 16 + i * 8192, R, C); const int Rb = Epi::PERM ? ((R & ~31) + perm32(R & 31)) : R;
        voffA[i] = (unsigned)(R * g.lda + C) * 2u; voffB[i] = (unsigned)(Rb * g.ldb + C) * 2u; }
    const size_t kstep = (size_t)(BK * 2);
    const size_t hstepA = GATHER ? 0 : (size_t)HALF * g.lda * 2, hstepB = (size_t)HALF * g.ldb * 2;
    const unsigned ldsw = (unsigned)wid * 1024u;
    const int aoff = lds_byte(wr * 64 + fr, fq * 8), boff = lds_byte(wc * 32 + fr, fq * 8);
    unsigned vC[2], vN[2];
#define PG8_SA(b, h) (((b) * 2 + (h)) * HTB)
#define PG8_SB(b, h) ((4 + (b) * 2 + (h)) * HTB)
#define PG8_STAGE(bufoff, gbase, voff) do { _Pragma("unroll") for (int _i = 0; _i < 2; ++_i) { unsigned _vo = (voff)[_i]; asm volatile("" : "+v"(_vo)); \
        __builtin_amdgcn_global_load_lds((const unsigned*)((const char*)(gbase) + _vo), (LAS unsigned*)(lds + (bufoff) + ldsw + _i * 8192), 16, 0, 0); } } while (0)
#define PG8_STAGEA(bufoff, p, h, nx) do { if constexpr (GATHER) { const unsigned _pk = (nx) ? vN[h] : vC[h]; unsigned _v[2]; int _R, _C; \
            stage_rc(tid * 16, _R, _C); _v[0] = ((_pk & 0xffffu) * (unsigned)g.lda + (unsigned)_C) * 2u; stage_rc(tid * 16 + 8192, _R, _C); _v[1] = ((_pk >> 16) * (unsigned)g.lda + (unsigned)_C) * 2u; PG8_STAGE(bufoff, p, _v); } \
        else { PG8_STAGE(bufoff, (p) + (h) * hstepA, voffA); } } while (0)
#define PG8_LD8(p) __builtin_shufflevector(*(const LAS i32x4*)(p), *(const LAS i32x4*)((p) + 1024), 0, 1, 2, 3, 4, 5, 6, 7)
#define PG8_LDA(dst, b, h) do { _Pragma("unroll") for (int m = 0; m < 4; ++m) dst[m] = PG8_LD8(lds + PG8_SA(b, h) + aoff + m * 2048); } while (0)
#define PG8_LDB(dst, b, h) do { _Pragma("unroll") for (int n = 0; n < 2; ++n) dst[n] = PG8_LD8(lds + PG8_SB(b, h) + boff + n * 2048); } while (0)
#define PG8_HALF(F, k) __builtin_bit_cast(bf16x8, __builtin_shufflevector(F, F, 4 * (k), 4 * (k) + 1, 4 * (k) + 2, 4 * (k) + 3))
#define PG8_MMA(ai, bj, At, Bt) do { __builtin_amdgcn_s_setprio(1); _Pragma("unroll") for (int m = 0; m < 4; ++m) _Pragma("unroll") for (int n = 0; n < 2; ++n) { \
        if constexpr (FP8) asm("v_mfma_f32_16x16x128_f8f6f4 %0, %1, %2, %0" : "+v"(acc[ai][bj][m][n]) : "v"(Bt[n]), "v"(At[m])); \
        else { acc[ai][bj][m][n] = __builtin_amdgcn_mfma_f32_16x16x32_bf16(PG8_HALF(Bt[n], 0), PG8_HALF(At[m], 0), acc[ai][bj][m][n], 0, 0, 0); \
               acc[ai][bj][m][n] = __builtin_amdgcn_mfma_f32_16x16x32_bf16(PG8_HALF(Bt[n], 1), PG8_HALF(At[m], 1), acc[ai][bj][m][n], 0, 0, 0); } } \
        __builtin_amdgcn_s_setprio(0); } while (0)
#define PG8_WAIT_V(n) asm volatile("s_waitcnt vmcnt(" #n ")" ::: "memory")
#define PG8_WAIT_L(n) asm volatile("s_waitcnt lgkmcnt(" #n ")" ::: "memory")
#define PG8_BAR __builtin_amdgcn_s_barrier()
#define PG8_SCHED __builtin_amdgcn_sched_barrier(0)
#define PG8_GLOAD(dst, U) do { _Pragma("unroll") for (int _h = 0; _h < 2; ++_h) { unsigned _pk = 0u; _Pragma("unroll") for (int _i = 0; _i < 2; ++_i) { int _R, _C; stage_rc(tid * 16 + _i * 8192, _R, _C); \
        const int _r = _h * HALF + _R; int _row = g.idx[(U).c + _r]; _row = (_r < (U).b) ? _row : 0; _pk |= (unsigned)_row << (16 * _i); } dst[_h] = _pk; } } while (0)
    Unit cur, nxt; int ui = 0;
    if (!S.next(0, cur)) return;
    f32x4 acc[2][2][4][2];
#pragma unroll
    for (int a = 0; a < 2; ++a)
#pragma unroll
        for (int b = 0; b < 2; ++b)
#pragma unroll
            for (int m = 0; m < 4; ++m)
#pragma unroll
                for (int n = 0; n < 2; ++n) acc[a][b][m][n] = (f32x4){0.f, 0.f, 0.f, 0.f};
    i32x8 At[4], B0[2], B1[2];
    const char* cA = (const char*)g.A + cur.aoff; const char* cB = (const char*)g.Bt + cur.boff;
    if constexpr (GATHER) { PG8_GLOAD(vC, cur); PG8_GLOAD(vN, cur); }
    PG8_STAGE(PG8_SB(0, 0), cB, voffB); if constexpr (NBJ == 2) PG8_STAGE(PG8_SB(0, 1), cB + hstepB, voffB); PG8_STAGEA(PG8_SA(0, 0), cA, 0, false); PG8_STAGEA(PG8_SA(0, 1), cA, 1, false);
    if (wr == 1) PG8_BAR;
    PG8_WAIT_V(2); PG8_BAR;
    PG8_STAGE(PG8_SB(1, 0), cB + kstep, voffB); PG8_STAGEA(PG8_SA(1, 0), cA + kstep, 0, false); if constexpr (NBJ == 2) PG8_STAGE(PG8_SB(1, 1), cB + hstepB + kstep, voffB);
    if constexpr (NBJ == 2) PG8_WAIT_V(6); else PG8_WAIT_V(4);
    PG8_BAR;
    for (;;) {
        const bool has_next = S.next(ui + 1, nxt);
        const char* nA = has_next ? (const char*)g.A + nxt.aoff : cA; const char* nB = has_next ? (const char*)g.Bt + nxt.boff : cB;
        if constexpr (GATHER) { if (has_next) { PG8_GLOAD(vN, nxt); } else { vN[0] = vC[0]; vN[1] = vC[1]; }
            asm volatile("s_waitcnt vmcnt(0)" : "+v"(vN[0]), "+v"(vN[1]) :: "memory"); }
#pragma unroll 1
        for (int t = 0; t < nt; t += 2) {
            const bool last = (t == nt - 2);
            const char* a1 = cA + (size_t)(t + 1) * kstep;
            const char* a2 = last ? nA : cA + (size_t)(t + 2) * kstep; const char* b2 = last ? nB : cB + (size_t)(t + 2) * kstep;
            const char* a3 = a2 + kstep; const char* b3 = b2 + kstep;
#define PG8_WAIT_K() do { if constexpr (NBJ == 2) PG8_WAIT_V(8); else PG8_WAIT_V(6); } while (0)
            PG8_LDB(B0, 0, 0); if constexpr (NBJ == 2) PG8_LDB(B1, 0, 1); PG8_SCHED; PG8_LDA(At, 0, 0); PG8_STAGEA(PG8_SA(1, 1), a1, 1, false);
            PG8_WAIT_K(); PG8_WAIT_L(0); PG8_BAR; PG8_MMA(0, 0, At, B0); if constexpr (NBJ == 2) PG8_MMA(0, 1, At, B1); PG8_BAR; PG8_SCHED;
            PG8_LDA(At, 0, 1); PG8_STAGE(PG8_SB(0, 0), b2, voffB); if constexpr (NBJ == 2) PG8_STAGE(PG8_SB(0, 1), b2 + hstepB, voffB); PG8_STAGEA(PG8_SA(0, 0), a2, 0, last);
            PG8_WAIT_K(); PG8_WAIT_L(0); PG8_BAR; PG8_MMA(1, 0, At, B0); if constexpr (NBJ == 2) PG8_MMA(1, 1, At, B1); PG8_BAR; PG8_SCHED;
            PG8_LDB(B0, 1, 0); if constexpr (NBJ == 2) PG8_LDB(B1, 1, 1); PG8_SCHED; PG8_LDA(At, 1, 0); PG8_STAGEA(PG8_SA(0, 1), a2, 1, last);
            PG8_WAIT_K(); PG8_WAIT_L(0); PG8_BAR; PG8_MMA(0, 0, At, B0); if constexpr (NBJ == 2) PG8_MMA(0, 1, At, B1); PG8_BAR; PG8_SCHED;
            PG8_LDA(At, 1, 1); PG8_STAGE(PG8_SB(1, 0), b3, voffB); if constexpr (NBJ == 2) PG8_STAGE(PG8_SB(1, 1), b3 + hstepB, voffB); PG8_STAGEA(PG8_SA(1, 0), a3, 0, last);
            PG8_WAIT_K(); PG8_WAIT_L(0); PG8_BAR; PG8_MMA(1, 0, At, B0); if constexpr (NBJ == 2) PG8_MMA(1, 1, At, B1); PG8_BAR; PG8_SCHED;
#undef PG8_WAIT_K
        }
        if (wr == 0) PG8_BAR;
        if constexpr (FP8) asm volatile("s_nop 15\n\ts_nop 15" ::: "memory");
        E(acc, cur, wr, wc, fr, fq);
        if (!has_next) break;
#pragma unroll
        for (int a = 0; a < 2; ++a)
#pragma unroll
            for (int b = 0; b < 2; ++b)
#pragma unroll
                for (int m = 0; m < 4; ++m)
#pragma unroll
                    for (int n = 0; n < 2; ++n) acc[a][b][m][n] = (f32x4){0.f, 0.f, 0.f, 0.f};
        cur = nxt; cA = nA; cB = nB; ++ui;
        if constexpr (GATHER) { vC[0] = vN[0]; vC[1] = vN[1]; }
        if (wr == 1) PG8_BAR;
    }
    PG8_WAIT_V(0);
    PG8_BAR;
#undef PG8_SA
#undef PG8_SB
#undef PG8_STAGE
#undef PG8_STAGEA
#undef PG8_LDA
#undef PG8_LDB
#undef PG8_MMA
#undef PG8_HALF
#undef PG8_LD8
#undef PG8_WAIT_V
#undef PG8_WAIT_L
#undef PG8_BAR
#undef PG8_SCHED
#undef PG8_GLOAD
}
}

#define XB_TMO      128
#define XB_XCNT(j)  (256  + 64 * (j))
#define XB_XSUB(j)  (1280 + 64 * (j))
#define XB_XGEN(j)  (2304 + 64 * (j))
#define XB_TOP      3328
#define XB_TOPGEN   3392
#define XCD_BAR_WORDS 3456
#define XB_SPIN_CAP (1u << 18)
__device__ __forceinline__ unsigned xb_ld(unsigned* p)              { return __hip_atomic_load(p, __ATOMIC_RELAXED, __HIP_MEMORY_SCOPE_AGENT); }
__device__ __forceinline__ unsigned xb_add(unsigned* p, unsigned v) { return __hip_atomic_fetch_add(p, v, __ATOMIC_RELAXED, __HIP_MEMORY_SCOPE_AGENT); }
__device__ __forceinline__ unsigned xb_xcc_id() { return (unsigned)__builtin_amdgcn_s_getreg((3 << 11) | 20) & 0xFu; }
#define XB_SPIN(cond, bar) do { unsigned _sp = 0; while (cond) { __builtin_amdgcn_s_sleep(1); \
    if ((++_sp & 255u) == 0u) { if (xb_ld(&(bar)[XB_TMO])) break; if (_sp > XB_SPIN_CAP) { atomicAdd(&(bar)[XB_TMO], 1u); break; } } } } while (0)
struct XcdBarrier { unsigned* bar; unsigned x; volatile LAS unsigned* st; };
__device__ __forceinline__ XcdBarrier xcd_barrier_post(unsigned* bar, volatile LAS unsigned* st, const int g_wave) {
    XcdBarrier b; b.bar = bar; b.x = xb_xcc_id(); b.st = st;
    if (TIDX == 0) (void)xb_add(&bar[XB_XCNT(b.x)], 1u);
    return b;
}
__device__ __forceinline__ void xcd_barrier_complete(unsigned* bar, unsigned x, unsigned& nloc, unsigned& nx) {
    const unsigned G = gridDim.x * gridDim.y * gridDim.z;
    unsigned sum, cnt, mine, sp = 0u;
    for (;;) {
        sum = 0u; cnt = 0u; mine = 0u;
#pragma unroll
        for (unsigned j = 0; j < 16; ++j) { const unsigned c = xb_ld(&bar[XB_XCNT(j)]); sum += c; cnt += (c > 0u) ? 1u : 0u; mine = (j == x) ? c : mine; }
        if (sum == G) break;
        __builtin_amdgcn_s_sleep(1);
        if ((++sp & 255u) == 0u) { if (xb_ld(&bar[XB_TMO])) break; if (sp > XB_SPIN_CAP) { atomicAdd(&bar[XB_TMO], 1u); break; } }
    }
    nloc = mine > 0u ? mine : 1u; nx = cnt > 0u ? cnt : 1u;
}
__device__ __forceinline__ void xcd_barrier(const XcdBarrier& b, const int g_wave) {
    asm volatile("s_waitcnt vmcnt(0)" ::: "memory");
    __syncthreads();
    if (TIDX == 0) {
        unsigned* bar = b.bar;
        __builtin_amdgcn_s_waitcnt(0);
        unsigned nloc = b.st[0], nx = b.st[1];
        if (nloc == 0u) { xcd_barrier_complete(bar, b.x, nloc, nx); b.st[0] = nloc; b.st[1] = nx; }
        const unsigned old = xb_add(&bar[XB_XSUB(b.x)], 1u);
        const unsigned gen = old / nloc;
        if (old + 1u == (gen + 1u) * nloc) {
            __builtin_amdgcn_fence(__ATOMIC_RELEASE, "agent");
            asm volatile("s_waitcnt vmcnt(0)" ::: "memory");
            const unsigned og = xb_add(&bar[XB_TOP], 1u);
            const unsigned tg = og / nx;
            if (og + 1u == (tg + 1u) * nx) xb_add(&bar[XB_TOPGEN], 1u);
            else XB_SPIN(xb_ld(&bar[XB_TOPGEN]) == tg, bar);
            __builtin_amdgcn_fence(__ATOMIC_ACQUIRE, "agent");
            xb_add(&bar[XB_XGEN(b.x)], 1u);
            asm volatile("s_waitcnt vmcnt(0)" ::: "memory");
        } else {
            XB_SPIN(xb_ld(&bar[XB_XGEN(b.x)]) == gen, bar);
            __builtin_amdgcn_fence(__ATOMIC_ACQUIRE, "agent");
            asm volatile("s_waitcnt vmcnt(0)" ::: "memory");
        }
    }
    __syncthreads();
}

struct Params { const float* in[29]; float* out; unsigned char* ws; int ph_lo, ph_hi; };
extern __shared__ __attribute__((aligned(16))) unsigned char lds_raw[];
__device__ __forceinline__ const float* inptr(int i) { u32x2 v = *(const LAS u32x2*)((LAS unsigned char*)lds_raw + PTRS_OFF + 8 * i); asm volatile("" : "+v"(v));
    GAS const float* gp = (GAS const float*)(((unsigned long long)(unsigned)__builtin_amdgcn_readfirstlane((int)v.y) << 32) | (unsigned long long)(unsigned)__builtin_amdgcn_readfirstlane((int)v.x));
    return (const float*)gp; }
__device__ __forceinline__ unsigned char* wsptr(const Params&) { return (unsigned char*)inptr(29); }
enum { I_X = 0, I_C, I_WIN, I_BF, I_POOLW, I_POOLS, I_SGLG, I_SGLB, I_SGW, I_SGB, I_CONVW, I_CONVB, I_CLG, I_CLB, I_WBR, I_WOUT, I_MNG, I_FNG, I_ADAW, I_ADAB,
       I_RW, I_RB, I_EW1, I_EW3, I_EW2, I_SW1, I_SW3, I_SW2, I_FING };

__device__ __forceinline__ void phase_ada(const Params& P, LAS unsigned char* lds, int bid, int G, const int g_wave) {
    const int tid = TIDX, lane = tid & 63, wave = tid >> 6;
    LAS float* sc = (LAS float*)lds; LAS float* red = (LAS float*)(lds + 8192);
    const float* c = inptr(I_C); float* MOD = (float*)(wsptr(P) + WS_SMALL + SM_MOD);
    for (int i = tid; i < 2048; i += NTHREADS) { const float v = c[i]; sc[i] = v / (1.f + __expf(-v)); }
    __syncthreads();
    for (int ch = bid; ch < 192; ch += G) {
        const int l = ch / 96, n0 = (ch % 96) * 64;
        const float* W = inptr(I_ADAW) + (size_t)l * 1024 * 6144 + n0 + lane;
        float a0 = 0.f, a1 = 0.f;
#pragma unroll 16
        for (int k = 0; k < 128; ++k) { const int kk = wave * 128 + k; const float w = W[(size_t)kk * 6144]; a0 += sc[kk] * w; a1 += sc[1024 + kk] * w; }
        red[(wave * 2 + 0) * 64 + lane] = a0; red[(wave * 2 + 1) * 64 + lane] = a1;
        __syncthreads();
        if (tid < 128) { const int b = tid >> 6; float s = 0.f;
#pragma unroll
            for (int w = 0; w < 8; ++w) s += red[(w * 2 + b) * 64 + lane];
            MOD[(size_t)(l * 2 + b) * 6144 + n0 + lane] = s + inptr(I_ADAB)[l * 6144 + n0 + lane]; }
        __syncthreads();
    }
}

__device__ __forceinline__ float clamp448(float x) { return __builtin_fminf(__builtin_fmaxf(x, -448.f), 448.f); }
__device__ __forceinline__ unsigned pk4_fp8(float a, float b, float c, float d) { a = clamp448(a); b = clamp448(b); c = clamp448(c); d = clamp448(d); int w = __builtin_amdgcn_cvt_pk_fp8_f32(a, b, 0, false); w = __builtin_amdgcn_cvt_pk_fp8_f32(c, d, w, true); return (unsigned)w; }
__device__ __forceinline__ void cvt_item_fp8(const float* __restrict__ src, int ldw, unsigned char* __restrict__ dst, int ldd, float scale, LAS unsigned* T, int lane) {
    const int kp = lane >> 4, ng = lane & 15;
    f32x4 v[16];
#pragma unroll
    for (int j = 0; j < 4; ++j)
#pragma unroll
        for (int h = 0; h < 4; ++h) v[4 * j + h] = __builtin_nontemporal_load((const f32x4*)(src + (size_t)(16 * j + 4 * kp + h) * ldw + 4 * ng));
#pragma unroll
    for (int j = 0; j < 4; ++j)
#pragma unroll
        for (int i = 0; i < 4; ++i) T[(4 * ng + i) * 17 + 4 * j + kp] = pk4_fp8(v[4 * j][i] * scale, v[4 * j + 1][i] * scale, v[4 * j + 2][i] * scale, v[4 * j + 3][i] * scale);
    LDS_WAIT();
#pragma unroll 8
    for (int s = 0; s < 16; ++s) { const int n = 4 * s + (lane >> 4), kd = lane & 15; ((unsigned*)(dst + (size_t)n * ldd))[kd] = T[n * 17 + kd]; }
    LDS_WAIT();
}
__device__ __forceinline__ void cvt_item(const float* __restrict__ src, int ldw, bf16_t* __restrict__ dst, int ldd, LAS unsigned* T, int lane) {
    const int kp = lane >> 4, ng = lane & 15;
    f32x4 v[16];
#pragma unroll
    for (int j = 0; j < 8; ++j)
#pragma unroll
        for (int h = 0; h < 2; ++h) v[2 * j + h] = __builtin_nontemporal_load((const f32x4*)(src + (size_t)(8 * j + 2 * kp + h) * ldw + 4 * ng));
#pragma unroll
    for (int j = 0; j < 8; ++j)
#pragma unroll
        for (int i = 0; i < 4; ++i) T[(4 * ng + i) * 33 + 4 * j + kp] = cvt_pk_bf16(v[2 * j][i], v[2 * j + 1][i]);
    LDS_WAIT();
#pragma unroll 8
    for (int s = 0; s < 32; ++s) { const int n = 2 * s + (lane >> 5), kd = lane & 31; ((unsigned*)(dst + (size_t)n * ldd))[kd] = T[n * 33 + kd]; }
    LDS_WAIT();
}
constexpr int CVT_EARLY = 512 + 1024 + 256 + 256, CVT_ALL = CVT_EARLY + 3 * 65 * 64;
template <bool SMALLS>
__device__ __forceinline__ void phase_convert(const Params& P, LAS unsigned char* lds, int l, int gw, int NGW, const int g_wave, int it0, int it1) {
    const int tid_ = TIDX, lane = tid_ & 63, wave = tid_ >> 6;
    LAS unsigned* T = (LAS unsigned*)(lds + wave * 8448);
    bf16_t* WB = (bf16_t*)(wsptr(P) + WS_WB);
    constexpr int C0 = 512, C1 = 1024, C2 = 256, C3 = 256, C4 = 0, C5 = 65 * 64, C6 = 65 * 64, C7 = 65 * 64;
    constexpr int NITEMS = C0 + C1 + C2 + C3 + C4 + C5 + C6 + C7;
    for (int it = it0 + gw; it < it1; it += NGW) {
        int r = it;
#if FP8_G1
        if (r < C0) { const int nb = r & 31, kb = r >> 5; cvt_item_fp8(inptr(I_WIN) + (size_t)l * 1024 * COLT + (size_t)kb * 64 * COLT + 64 * nb, COLT, (unsigned char*)(WB + WB_WIN) + (size_t)(64 * nb) * 1024 + kb * 64, 1024, 64.f, T, lane); continue; } r -= C0;
        if (r < C1) { const int nb = r & 63, kb = r >> 6; cvt_item_fp8(inptr(I_WIN) + (size_t)l * 1024 * COLT + (size_t)kb * 64 * COLT + 2052 + 64 * nb, COLT, (unsigned char*)(WB + WB_WIN) + (size_t)(2048 + 64 * nb) * 1024 + kb * 64, 1024, 64.f, T, lane); continue; } r -= C1;
#else
        if (r < C0) { const int nb = r & 31, kb = r >> 5; cvt_item(inptr(I_WIN) + (size_t)l * 1024 * COLT + (size_t)kb * 64 * COLT + 64 * nb, COLT, WB + WB_WIN + (size_t)(64 * nb) * 1024 + kb * 64, 1024, T, lane); continue; } r -= C0;
        if (r < C1) { const int nb = r & 63, kb = r >> 6; cvt_item(inptr(I_WIN) + (size_t)l * 1024 * COLT + (size_t)kb * 64 * COLT + 2052 + 64 * nb, COLT, WB + WB_WIN + (size_t)(2048 + 64 * nb) * 1024 + kb * 64, 1024, T, lane); continue; } r -= C1;
#endif
        if (r < C2) { const int nb = r & 15, kb = (r >> 4) & 3, n = r >> 6; cvt_item(inptr(I_WBR) + (size_t)(l * 4 + n) * 256 * 1024 + (size_t)kb * 64 * 1024 + 64 * nb, 1024, WB + WB_WBR + (size_t)(n * 1024 + 64 * nb) * 256 + kb * 64, 256, T, lane); continue; } r -= C2;
        if (r < C3) { const int nb = r & 15, kb = r >> 4; cvt_item(inptr(I_WOUT) + (size_t)l * 1024 * 1024 + (size_t)kb * 64 * 1024 + 64 * nb, 1024, WB + WB_WOUT + (size_t)(64 * nb) * 1024 + kb * 64, 1024, T, lane); continue; } r -= C3;
        if (r < C5 + C6) { const int w3 = r >= C5; if (w3) r -= C5; const int nb = r & 3, kb = (r >> 2) & 15, e = r >> 6;
            const float* src = (e < 64) ? P.in[w3 ? I_EW3 : I_EW1] + ((size_t)(l * 64 + e)) * 1024 * 256 : P.in[w3 ? I_SW3 : I_SW1] + (size_t)l * 1024 * 256;
#if FP8_GA
            cvt_item_fp8(src + (size_t)kb * 64 * 256 + 64 * nb, 256, (unsigned char*)(WB + WB_W13) + ((size_t)e * 512 + (nb >> 1) * 256 + w3 * 128 + (nb & 1) * 64) * 1024 + kb * 64, 1024, 64.f, T, lane); continue; } r -= C5 + C6;
#else
            cvt_item(src + (size_t)kb * 64 * 256 + 64 * nb, 256, WB + WB_W13 + ((size_t)e * 512 + (nb >> 1) * 256 + w3 * 128 + (nb & 1) * 64) * 1024 + kb * 64, 1024, T, lane); continue; } r -= C5 + C6;
#endif
        { const int nb = r & 15, kb = (r >> 4) & 3, e = r >> 6;
            const float* src = (e < 64) ? inptr(I_EW2) + ((size_t)(l * 64 + e)) * 256 * 1024 : inptr(I_SW2) + (size_t)l * 256 * 1024;
#if FP8_GB
            cvt_item_fp8(src + (size_t)kb * 64 * 1024 + 64 * nb, 1024, (unsigned char*)(WB + WB_W2) + ((size_t)e * 1024 + 64 * nb) * 256 + kb * 64, 256, 64.f, T, lane); }
#else
            cvt_item(src + (size_t)kb * 64 * 1024 + 64 * nb, 1024, WB + WB_W2 + ((size_t)e * 1024 + 64 * nb) * 256 + kb * 64, 256, T, lane); }
#endif
    }
    if (SMALLS) {
    { const int gt = gw * 64 + lane, NT = NGW * 64;
      bf16_t* SGWM = (bf16_t*)(wsptr(P) + WS_SMALL + SM_SGWM); const float* sgw = inptr(I_SGW) + (size_t)l * 4 * 128 * 128;
      for (int i = gt; i < 4 * 128 * 128 / 8; i += NT) { const int e0 = i * 8, t = (e0 >> 7) & 127, s0 = e0 & 127; const f32x4 a = *(const f32x4*)(sgw + e0), b = *(const f32x4*)(sgw + e0 + 4);
          u32x4 w; w.x = cvt_pk_bf16(s0 + 0 <= t ? a[0] : 0.f, s0 + 1 <= t ? a[1] : 0.f); w.y = cvt_pk_bf16(s0 + 2 <= t ? a[2] : 0.f, s0 + 3 <= t ? a[3] : 0.f);
          w.z = cvt_pk_bf16(s0 + 4 <= t ? b[0] : 0.f, s0 + 5 <= t ? b[1] : 0.f); w.w = cvt_pk_bf16(s0 + 6 <= t ? b[2] : 0.f, s0 + 7 <= t ? b[3] : 0.f);
          *(u32x4*)(SGWM + e0) = w; }
      bf16_t* PWT = (bf16_t*)(wsptr(P) + WS_SMALL + SM_PWT); const float* pw = inptr(I_POOLW) + (size_t)l * 4 * 64 * 64;
      for (int i = gt; i < 4 * 64 * 64; i += NT) { const int g = i >> 12, d = (i >> 6) & 63, c = i & 63; PWT[i] = f2bf(pw[(g * 64 + c) * 64 + d]); } }
    { const int gt = gw * 64 + lane, NT = NGW * 64; const float* rw = inptr(I_RW) + (size_t)l * 1024 * 64; bf16_t* WRT = WB + WB_WR;
      for (int i = gt; i < 65536; i += NT) { const int k = i >> 6, e = i & 63; const float v = rw[i]; const bf16_t hi = f2bf(v); WRT[e * 1024 + k] = hi; WRT[65536 + e * 1024 + k] = f2bf(v - bf2f(hi)); }
      int* IDXP = (int*)(wsptr(P) + WS_SMALL + SM_IDXP) + 64 * CAP;
      for (int i = gt; i < M; i += NT) IDXP[i] = i; }
    }
}

__device__ __forceinline__ void moe_offsets(const Params& P, LAS unsigned char* lds, int l, const int g_wave) {
    LAS int* eo = (LAS int*)(lds + EOFF_OFF);
    if (TIDX == 0) { const unsigned* CNT = (const unsigned*)(wsptr(P) + WS_CTL) + CW_CNT + l * 64; int off = 0, tp = 0;
#pragma unroll 1
        for (int e = 0; e < 64; ++e) { const int n = (int)__hip_atomic_load(CNT + e, __ATOMIC_RELAXED, __HIP_MEMORY_SCOPE_AGENT); eo[e] = off; eo[64 + e] = tp; eo[128 + e] = n; off += n; tp += (n + 255) >> 8; } }
    __syncthreads();
}
template <int MODE>
__device__ __forceinline__ void phase_norm1(const Params& P, LAS unsigned char* lds, int l, int gw, int NGW, const int g_wave) {
    const int tid = TIDX, lane = tid & 63;
    const float* MOD = (const float*)(wsptr(P) + WS_SMALL + SM_MOD);
    bf16_t* XB = (bf16_t*)(wsptr(P) + WS_X); bf16_t* H = (bf16_t*)(wsptr(P) + WS_H);
    LAS f32x4* wf = (LAS f32x4*)lds;
    if (MODE != 2) {
        const float* win = inptr(I_WIN) + (size_t)l * 1024 * COLT + 2048;
        for (int d = tid; d < 1024; d += NTHREADS) wf[d] = *(const f32x4*)(win + (size_t)d * COLT);
        __syncthreads();
    }
    if (MODE != 0) moe_offsets(P, lds, l - 1, g_wave);
    const int* TE = (const int*)(wsptr(P) + WS_SMALL + SM_TE); const int* TP = (const int*)(wsptr(P) + WS_SMALL + SM_TP); const bf16_t* Y2 = (const bf16_t*)(wsptr(P) + WS_R1);
    LAS const int* eo = (LAS const int*)(lds + EOFF_OFF);
    const float* Y2S = (const float*)(wsptr(P) + WS_R1 + Y2SC_OFF);
    float* LOGF = (float*)(wsptr(P) + WS_SMALL + SM_LOGF);
    for (int b = 0; b < NB; ++b) {
    f32x4 mA[4], mB[4], mG[4];
#pragma unroll
    for (int j = 0; j < 4; ++j) { const int d0 = 256 * j + 4 * lane;
        if (MODE == 2) { mA[j] = *(const f32x4*)(inptr(I_FING) + d0); mB[j] = (f32x4){0.f, 0.f, 0.f, 0.f}; }
        else { const float* md = MOD + (size_t)(l * 2 + b) * 6144; mA[j] = *(const f32x4*)(inptr(I_MNG) + l * D + d0) * (*(const f32x4*)(md + 1024 + d0) + 1.0f); mB[j] = *(const f32x4*)(md + d0); }
        mG[j] = (MODE != 0) ? *(const f32x4*)(MOD + (size_t)((l - 1) * 2 + b) * 6144 + 5 * 1024 + d0) : (f32x4){0.f, 0.f, 0.f, 0.f}; }
    const float bf0 = (MODE != 2) ? inptr(I_BF)[l * 4 + 0] : 0.f, bf1 = (MODE != 2) ? inptr(I_BF)[l * 4 + 1] : 0.f, bf2 = (MODE != 2) ? inptr(I_BF)[l * 4 + 2] : 0.f, bf3 = (MODE != 2) ? inptr(I_BF)[l * 4 + 3] : 0.f;
    for (int row = b * SEQ + ((gw - b * SEQ) % NGW + NGW) % NGW; row < (b + 1) * SEQ; row += NGW) {
        f32x4 v[4];
        if (MODE == 0) {
#pragma unroll
            for (int j = 0; j < 4; ++j) v[j] = *(const f32x4*)(inptr(I_X) + (size_t)row * D + 256 * j + 4 * lane);
        } else {
            f32x4 a[4];
#pragma unroll
            for (int j = 0; j < 4; ++j) { const u32x2 w = *(const u32x2*)(XB + (size_t)row * D + 256 * j + 4 * lane); v[j] = (f32x4){bflo(w.x), bfhi(w.x), bflo(w.y), bfhi(w.y)}; a[j] = (f32x4){0.f, 0.f, 0.f, 0.f}; }
#pragma unroll
            for (int k = 0; k <= TOPK; ++k) { const int slot = (k < TOPK) ? eo[TE[row * TOPK + (k < TOPK ? k : 0)]] + TP[row * TOPK + (k < TOPK ? k : 0)] : NPAIR + row;
#pragma unroll
                for (int j = 0; j < 4; ++j) { const unsigned w = *(const unsigned*)((const unsigned char*)Y2 + (size_t)slot * D + 256 * j + 4 * lane);
                    const float sc = Y2S[(size_t)slot * 32 + 8 * j + (lane >> 3)];
                    a[j][0] += ((float)(w & 255u) - 128.f) * sc; a[j][1] += ((float)((w >> 8) & 255u) - 128.f) * sc;
                    a[j][2] += ((float)((w >> 16) & 255u) - 128.f) * sc; a[j][3] += ((float)(w >> 24) - 128.f) * sc; } }
#pragma unroll
            for (int j = 0; j < 4; ++j) { v[j] = v[j] + mG[j] * a[j];
                if (MODE == 1) { u32x2 w; w.x = cvt_pk_bf16(v[j][0], v[j][1]); w.y = cvt_pk_bf16(v[j][2], v[j][3]); *(u32x2*)(XB + (size_t)row * D + 256 * j + 4 * lane) = w; } }
        }
        float ss = 0.f;
#pragma unroll
        for (int j = 0; j < 4; ++j) ss += (v[j][0] * v[j][0] + v[j][1] * v[j][1]) + (v[j][2] * v[j][2] + v[j][3] * v[j][3]);
        const float rms = 1.0f / sqrtf(wave_sum(ss) * (1.f / D) + EPS);
        if (MODE == 2) {
#pragma unroll
            for (int j = 0; j < 4; ++j) *(f32x4*)(P.out + (size_t)row * D + 256 * j + 4 * lane) = v[j] * rms * mA[j];
        } else {
            float fl[4] = {0.f, 0.f, 0.f, 0.f};
#pragma unroll
            for (int j = 0; j < 4; ++j) { const int d0 = 256 * j + 4 * lane;
                const f32x4 h = v[j] * rms * mA[j] + mB[j];
#if FP8_G1
                *(unsigned*)((unsigned char*)(wsptr(P) + WS_HF8) + (size_t)row * D + d0) = pk4_fp8(h[0], h[1], h[2], h[3]);
#else
                u32x2 w; w.x = cvt_pk_bf16(h[0], h[1]); w.y = cvt_pk_bf16(h[2], h[3]); *(u32x2*)(H + (size_t)row * D + d0) = w;
#endif
#pragma unroll
                for (int i = 0; i < 4; ++i) { const f32x4 wv = wf[d0 + i]; fl[0] += h[i] * wv[0]; fl[1] += h[i] * wv[1]; fl[2] += h[i] * wv[2]; fl[3] += h[i] * wv[3]; } }
#pragma unroll
            for (int hh = 0; hh < 4; ++hh) fl[hh] = wave_sum(fl[hh]);
            if (lane == 0) { f32x4 o;
#pragma unroll
                for (int hh = 0; hh < 4; ++hh) { const float f = fl[hh] + (hh == 0 ? bf0 : hh == 1 ? bf1 : hh == 2 ? bf2 : bf3); o[hh] = fminf(f, 0.f) - log1pf(__expf(-fabsf(f))); }
                *(f32x4*)(LOGF + (size_t)row * 4) = o; }
        }
    }
    }
}
__device__ __forceinline__ void scan_logf(const Params& P, LAS unsigned char* lds, int seq, const int g_wave) {
    const int lane = lane_id(), b = seq >> 2, hh = seq & 3, pos0 = g_wave * 1024;
    const float* LOGF = (const float*)(wsptr(P) + WS_SMALL + SM_LOGF);
    float* CUM = (float*)(wsptr(P) + WS_SMALL + SM_CUM); bf16_t* CB = (bf16_t*)(wsptr(P) + WS_SMALL + SM_CB);
    float v[16]; float tot = 0.f;
#pragma unroll
    for (int it = 0; it < 16; ++it) v[it] = LOGF[(size_t)(b * SEQ + pos0 + it * 64 + lane) * 4 + hh];
#pragma unroll
    for (int it = 0; it < 16; ++it) tot += v[it];
    tot = wave_sum(tot);
    LAS float* sums = (LAS float*)lds;
    if (lane == 0) sums[g_wave] = tot;
    __syncthreads();
    float carry = 0.f;
#pragma unroll
    for (int j = 0; j < 7; ++j) carry += (j < g_wave) ? sums[j] : 0.f;
#pragma unroll
    for (int it = 0; it < 16; ++it) {
        const int pos = pos0 + it * 64 + lane;
        const float sc = wave_scan_dpp(v[it]);
        const float cl = (carry + sc) * LOG2E;
        CUM[(size_t)seq * SEQ + pos] = cl;
        const float kb = -cl;
        const unsigned c1 = cvt_pk_bf16(kb, 0.f) & 0xffffu; const float r1 = kb - __uint_as_float(c1 << 16);
        const unsigned c2 = cvt_pk_bf16(r1, 0.f) & 0xffffu; const float r2 = r1 - __uint_as_float(c2 << 16);
        const unsigned c3 = cvt_pk_bf16(r2, 0.f) & 0xffffu;
        u32x4* cbp = (u32x4*)(CB + ((size_t)seq * SEQ + pos) * 16);
        const unsigned z_ = (unsigned)opaque(0), one_ = 0x3F80u + z_;
        cbp[0] = (u32x4){c1 | (c2 << 16), c3 | (one_ << 16), one_, z_}; cbp[1] = (u32x4){z_, z_, z_, z_};
        carry += __builtin_bit_cast(float, __builtin_amdgcn_readlane(__builtin_bit_cast(int, sc), 63));
    }
}

typedef float f32x16 __attribute__((ext_vector_type(16)));
__device__ __forceinline__ void pool_unit(const Params& P, LAS unsigned char* lds, int l, int tile, const int g_wave) {
    const int tid = TIDX, lane = tid & 63, wave = __builtin_amdgcn_readfirstlane(tid >> 6);
    const bf16_t* PROJ = (const bf16_t*)(wsptr(P) + WS_R1); bf16_t* YS = (bf16_t*)(wsptr(P) + WS_YS);
    LAS bf16_t* zs = (LAS bf16_t*)lds;
    LAS bf16_t* pl = (LAS bf16_t*)(lds + 40960);
    LAS bf16_t* ob = (LAS bf16_t*)(lds + 75776);
    const int t0 = tile * 64, sp0 = t0 & (SEQ - 1);
#pragma unroll
    for (int i_ = 0; i_ < (79 * 32 + NTHREADS - 1) / NTHREADS; ++i_) { const int p = tid + i_ * NTHREADS; if (p >= 79 * 32) break; const int r = p >> 5, ch = p & 31; const int pos = sp0 - 15 + r;
        u32x4 v = (u32x4){0u, 0u, 0u, 0u};
        if (pos >= 0) v = *(const u32x4*)(PROJ + (size_t)(t0 - 15 + r) * 2048 + ch * 8);
        *(LAS u32x4*)(zs + r * 256 + ch * 8) = v; }
    __syncthreads();
    { const int c = tid & 255, half = tid >> 8, g = c >> 6, w = 2 << g;
      float run = 0.f;
      for (int j = 1; j < w; ++j) run += bf2f(zs[(half * 32 + 15 - j) * 256 + c]);
      const float invw = 1.0f / (float)w;
      for (int i = 0; i < 32; ++i) { const int tt = half * 32 + i, pos = sp0 + tt; const float zc = bf2f(zs[(tt + 15) * 256 + c]);
          run += zc;
          const float mean = (pos + 1 < w) ? run / (float)(pos + 1) : run * invw;
          pl[tt * 264 + c] = f2bf(mean - zc);
          run -= bf2f(zs[(tt + 16 - w) * 256 + c]); } }
    __syncthreads();
    { const int g = wave >> 1, tb = wave & 1, r = lane & 31, h = lane >> 5;
      const bf16_t* PWT = (const bf16_t*)(wsptr(P) + WS_SMALL + SM_PWT);
#pragma unroll
      for (int dt = 0; dt < 2; ++dt) { f32x16 acc = {};
#pragma unroll
          for (int ks = 0; ks < 4; ++ks) { const bf16x8 af = *(const LAS bf16x8*)(pl + (32 * tb + r) * 264 + g * 64 + 16 * ks + 8 * h);
              const bf16x8 bf = *(const bf16x8*)(PWT + (size_t)(g * 64 + dt * 32 + r) * 64 + 16 * ks + 8 * h);
              acc = __builtin_amdgcn_mfma_f32_32x32x16_bf16(af, bf, acc, 0, 0, 0); }
          const int col = g * 64 + dt * 32 + r; const float scl = inptr(I_POOLS)[l * 256 + col];
#pragma unroll
          for (int q = 0; q < 16; ++q) { const int t = 32 * tb + (q & 3) + 8 * (q >> 2) + 4 * h; ob[t * 256 + col] = f2bf(acc[q] * scl); } } }
    __syncthreads();
#pragma unroll
    for (int i_ = 0; i_ < 64 * 32 / NTHREADS; ++i_) { const int p = tid + i_ * NTHREADS; const int t = p >> 5, ch = p & 31; *(u32x4*)(YS + (size_t)(t0 + t) * 1024 + ch * 8) = *(const LAS u32x4*)(ob + t * 256 + ch * 8); }
    __syncthreads();
}

__device__ __forceinline__ void sg_unit(const Params& P, LAS unsigned char* lds, int l, int chunk, const int g_wave) {
    const int tid = TIDX, lane = tid & 63, wave = __builtin_amdgcn_readfirstlane(tid >> 6);
    const bf16_t* PROJ = (const bf16_t*)(wsptr(P) + WS_R1); bf16_t* YS = (bf16_t*)(wsptr(P) + WS_YS);
    LAS bf16_t* vn = (LAS bf16_t*)lds;
    LAS bf16_t* ob = (LAS bf16_t*)(lds + 65536);
    const int t0 = chunk * 128;
    {
      const int sidx = wave * 16 + (lane >> 2), pq = lane & 3;
      const bf16_t* src = PROJ + (size_t)(t0 + sidx) * 2048 + 512 + pq * 64;
      u32x4 raw[8];
#pragma unroll
      for (int k = 0; k < 8; ++k) raw[k] = *(const u32x4*)(src + 8 * k);
      float sum = 0.f;
#pragma unroll
      for (int k = 0; k < 8; ++k) sum += ((bflo(raw[k].x) + bfhi(raw[k].x)) + (bflo(raw[k].y) + bfhi(raw[k].y))) + ((bflo(raw[k].z) + bfhi(raw[k].z)) + (bflo(raw[k].w) + bfhi(raw[k].w)));
      sum += DPPF(0.f, sum, 0xB1, 0xf, 0xf); sum += DPPF(0.f, sum, 0x4E, 0xf, 0xf);
      const float mu = sum * (1.f / 256.f); float sq = 0.f;
#pragma unroll
      for (int k = 0; k < 8; ++k) { const float d0 = bflo(raw[k].x) - mu, d1 = bfhi(raw[k].x) - mu, d2 = bflo(raw[k].y) - mu, d3 = bfhi(raw[k].y) - mu, d4 = bflo(raw[k].z) - mu, d5 = bfhi(raw[k].z) - mu, d6 = bflo(raw[k].w) - mu, d7 = bfhi(raw[k].w) - mu;
          sq += ((d0 * d0 + d1 * d1) + (d2 * d2 + d3 * d3)) + ((d4 * d4 + d5 * d5) + (d6 * d6 + d7 * d7)); }
      sq += DPPF(0.f, sq, 0xB1, 0xf, 0xf); sq += DPPF(0.f, sq, 0x4E, 0xf, 0xf);
      const float rstd = 1.0f / sqrtf(sq * (1.f / 256.f) + EPS);
      const float* gp = inptr(I_SGLG) + l * 256 + pq * 64; const float* bp = inptr(I_SGLB) + l * 256 + pq * 64;
#pragma unroll
      for (int k0 = 0; k0 < 8; ++k0) { const int k = (k0 + lane) & 7;
          u32x4 rw = raw[0];
#pragma unroll
          for (int kk = 1; kk < 8; ++kk) rw = (k == kk) ? raw[kk] : rw;
          const f32x4 g0 = *(const f32x4*)(gp + 8 * k), g1 = *(const f32x4*)(gp + 8 * k + 4), b0 = *(const f32x4*)(bp + 8 * k), b1 = *(const f32x4*)(bp + 8 * k + 4);
          u32x4 o; o.x = cvt_pk_bf16((bflo(rw.x) - mu) * rstd * g0[0] + b0[0], (bfhi(rw.x) - mu) * rstd * g0[1] + b0[1]); o.y = cvt_pk_bf16((bflo(rw.y) - mu) * rstd * g0[2] + b0[2], (bfhi(rw.y) - mu) * rstd * g0[3] + b0[3]);
          o.z = cvt_pk_bf16((bflo(rw.z) - mu) * rstd * g1[0] + b1[0], (bfhi(rw.z) - mu) * rstd * g1[1] + b1[1]); o.w = cvt_pk_bf16((bflo(rw.w) - mu) * rstd * g1[2] + b1[2], (bfhi(rw.w) - mu) * rstd * g1[3] + b1[3]);
          *(LAS u32x4*)(vn + sidx * 256 + pq * 64 + 8 * k) = o; } }
    __syncthreads();
    { const int head = wave >> 1, c0 = head * 64 + (wave & 1) * 32, r = lane & 31, h = lane >> 5;
      const bf16_t* SGWM = (const bf16_t*)(wsptr(P) + WS_SMALL + SM_SGWM) + (size_t)head * 128 * 128;
      const float* sgb = inptr(I_SGB) + (l * 4 + head) * 128;
      bf16x8 bfr[8];
#pragma unroll
      for (int ks = 0; ks < 8; ++ks) { unsigned e[8];
#pragma unroll
          for (int j = 0; j < 8; ++j) e[j] = vn[(16 * ks + 8 * h + j) * 256 + c0 + r];
          u32x4 w; w.x = e[0] | (e[1] << 16); w.y = e[2] | (e[3] << 16); w.z = e[4] | (e[5] << 16); w.w = e[6] | (e[7] << 16); bfr[ks] = __builtin_bit_cast(bf16x8, w); }
      bf16x8 wfr[20]; float bias[4];
#pragma unroll
      for (int tb = 0; tb < 4; ++tb) { bias[tb] = sgb[32 * tb + r];
#pragma unroll
          for (int ks = 0; ks < 2 * tb + 2; ++ks) wfr[tb * (tb + 1) + ks] = *(const bf16x8*)(SGWM + (size_t)(32 * tb + r) * 128 + 16 * ks + 8 * h); }
#pragma unroll
      for (int tb = 0; tb < 4; ++tb) { f32x16 acc = {};
#pragma unroll
          for (int ks = 0; ks < 2 * tb + 2; ++ks) acc = __builtin_amdgcn_mfma_f32_32x32x16_bf16(bfr[ks], wfr[tb * (tb + 1) + ks], acc, 0, 0, 0);
          const int t = 32 * tb + r;
#pragma unroll
          for (int g4 = 0; g4 < 4; ++g4) { u32x2 o; o.x = cvt_pk_bf16(acc[4 * g4] + bias[tb], acc[4 * g4 + 1] + bias[tb]); o.y = cvt_pk_bf16(acc[4 * g4 + 2] + bias[tb], acc[4 * g4 + 3] + bias[tb]);
              *(LAS u32x2*)(ob + t * 256 + ((((c0 >> 3) + g4) ^ (t & 31)) << 3) + 4 * h) = o; } } }
    __syncthreads();
#pragma unroll
    for (int i_ = 0; i_ < 128 * 32 / NTHREADS; ++i_) { const int p = tid + i_ * NTHREADS; const int t = p >> 5, ch = p & 31;
        const u32x4 u = *(const u32x4*)(PROJ + (size_t)(t0 + t) * 2048 + 256 + ch * 8), sv = *(const LAS u32x4*)(ob + t * 256 + ((ch ^ (t & 31)) << 3));
        u32x4 o; o.x = cvt_pk_bf16(bflo(u.x) * bflo(sv.x), bfhi(u.x) * bfhi(sv.x)); o.y = cvt_pk_bf16(bflo(u.y) * bflo(sv.y), bfhi(u.y) * bfhi(sv.y));
        o.z = cvt_pk_bf16(bflo(u.z) * bflo(sv.z), bfhi(u.z) * bfhi(sv.z)); o.w = cvt_pk_bf16(bflo(u.w) * bflo(sv.w), bfhi(u.w) * bfhi(sv.w));
        *(u32x4*)(YS + (size_t)(t0 + t) * 1024 + 256 + ch * 8) = o; }
    __syncthreads();
}

__device__ __forceinline__ void conv_unit(const Params& P, LAS unsigned char* lds, int l, int tile, const int g_wave) {
    const int tid = TIDX, lane = tid & 63, wave = tid >> 6;
    const bf16_t* PROJ = (const bf16_t*)(wsptr(P) + WS_R1); bf16_t* YS = (bf16_t*)(wsptr(P) + WS_YS);
    LAS float* ys = (LAS float*)lds;
    const int t0 = tile * 64, sp0 = t0 & (SEQ - 1);
#pragma unroll
    for (int i_ = 0; i_ < (94 * 32 + NTHREADS - 1) / NTHREADS; ++i_) { const int p = tid + i_ * NTHREADS; if (p >= 94 * 32) break; const int r = p >> 5, ch = p & 31; const int pos = sp0 - 30 + r;
        f32x4 o0 = (f32x4){0.f, 0.f, 0.f, 0.f}, o1 = o0;
        if (pos >= 0) { const bf16_t* rp = PROJ + (size_t)(t0 - 30 + r) * 2048 + ch * 8;
            const u32x4 a = *(const u32x4*)(rp + 768), g = *(const u32x4*)(rp + 1024);
            o0 = (f32x4){bflo(a.x) * sigmoidf_(bflo(g.x)), bfhi(a.x) * sigmoidf_(bfhi(g.x)), bflo(a.y) * sigmoidf_(bflo(g.y)), bfhi(a.y) * sigmoidf_(bfhi(g.y))};
            o1 = (f32x4){bflo(a.z) * sigmoidf_(bflo(g.z)), bfhi(a.z) * sigmoidf_(bfhi(g.z)), bflo(a.w) * sigmoidf_(bflo(g.w)), bfhi(a.w) * sigmoidf_(bfhi(g.w))}; }
        *(LAS f32x4*)(ys + r * 256 + ch * 8) = o0; *(LAS f32x4*)(ys + r * 256 + ch * 8 + 4) = o1; }
    __syncthreads();
    f32x2 outv[16];
    { const int cp = tid & 127, qt = tid >> 7;
      f32x2 w[31], yv[46];
#pragma unroll
      for (int j = 0; j < 31; ++j) w[j] = *(const f32x2*)(inptr(I_CONVW) + (size_t)(l * 31 + j) * 256 + 2 * cp);
#pragma unroll
      for (int r = 0; r < 46; ++r) yv[r] = *(const LAS f32x2*)(ys + (qt * 16 + r) * 256 + 2 * cp);
      const f32x2 cb = *(const f32x2*)(inptr(I_CONVB) + l * 256 + 2 * cp);
#pragma unroll
      for (int i = 0; i < 16; ++i) { f32x2 a = cb;
#pragma unroll
          for (int j = 0; j < 31; ++j) a = w[j] * yv[i + j] + a;
          outv[i] = a; } }
    __syncthreads();
    { const int cp = tid & 127, qt = tid >> 7;
#pragma unroll
      for (int i = 0; i < 16; ++i) *(LAS f32x2*)(ys + (qt * 16 + i) * 256 + 2 * cp) = outv[i]; }
    __syncthreads();
    for (int i = 0; i < 8; ++i) { const int tt = wave * 8 + i; f32x4 x = *(const LAS f32x4*)(ys + tt * 256 + 4 * lane);
        const float mu = wave_sum((x[0] + x[1]) + (x[2] + x[3])) * (1.f / 256.f);
        x = x - mu;
        const float var = wave_sum((x[0] * x[0] + x[1] * x[1]) + (x[2] * x[2] + x[3] * x[3])) * (1.f / 256.f);
        const float rstd = 1.0f / sqrtf(var + EPS);
        const f32x4 g4 = *(const f32x4*)(inptr(I_CLG) + l * 256 + 4 * lane), b4 = *(const f32x4*)(inptr(I_CLB) + l * 256 + 4 * lane);
        const f32x4 y = x * rstd * g4 + b4;
        u32x2 o; o.x = cvt_pk_bf16(siluf_(y[0]), siluf_(y[1])); o.y = cvt_pk_bf16(siluf_(y[2]), siluf_(y[3]));
        *(u32x2*)(YS + (size_t)(t0 + tt) * 1024 + 512 + 4 * lane) = o; }
    __syncthreads();
}

namespace fa {
using bf16x8=__attribute__((ext_vector_type(8)))short;
using s16x4=__attribute__((ext_vector_type(4)))short;
using f32x16=__attribute__((ext_vector_type(16)))float;
using u32x4=__attribute__((ext_vector_type(4)))unsigned;
constexpr int PQ=2048, PO=1024;
constexpr int NW=8,QBLK=32,QB=QBLK*NW,KVBLK=64;
__device__ __forceinline__ int crow(int r,int hi){return (r&3)+8*(r>>2)+4*hi;}
#define SBAR() __builtin_amdgcn_sched_barrier(0)
__device__ __forceinline__ void cmask(f32x16&p0,f32x16&p1,int jb,int qrel,int hi){
  const float NEG=-INFINITY; int kb=64*jb+4*hi;
  #pragma unroll
  for(int r=0;r<16;++r){int kv=kb+(r&3)+8*(r>>2); if(kv>qrel)p0[r]=NEG; if(kv+32>qrel)p1[r]=NEG;}
}
constexpr int NSLOT=3, SLOTB=8192;
constexpr int LDS_K=0, LDS_V=NSLOT*SLOTB, LDS_WS=2*NSLOT*SLOTB, LDS_OST=LDS_WS+NW*64*4, LDS_CB=LDS_OST+NW*4096, LDS_BYTES_=LDS_CB+NSLOT*2048;
__device__ __forceinline__ void glds16(const void*gsrc,unsigned lds_dst){unsigned keep;
  asm volatile("s_mov_b32 %0, m0\n\ts_mov_b32 m0, %2\n\ts_nop 0\n\tglobal_load_lds_dwordx4 %1, off\n\ts_mov_b32 m0, %0":"=&s"(keep):"v"(gsrc),"s"(lds_dst):"memory");}
__device__ __forceinline__ float max3f(float a,float b,float c){float r;asm("v_max3_f32 %0, %1, %2, %3":"=v"(r):"v"(a),"v"(b),"v"(c));return r;}
__device__ __forceinline__ float max2f(float a,float b){float r;asm("v_max_f32_e32 %0, %1, %2":"=v"(r):"v"(a),"v"(b));return r;}
__device__ __forceinline__ float fsub_s(float a,float b){float r;asm("v_sub_f32_e32 %0, %1, %2":"=v"(r):"v"(a),"v"(b));return r;}
typedef float f32x2_t __attribute__((ext_vector_type(2))); typedef __bf16 bf16x2_t __attribute__((ext_vector_type(2)));
__device__ __forceinline__ unsigned cvtpk_s(float lo,float hi){f32x2_t v={lo,hi};bf16x2_t b=__builtin_convertvector(v,bf16x2_t);return __builtin_bit_cast(unsigned,b);}
#define WAIT_BAR(N) asm volatile("s_waitcnt vmcnt(" #N ") lgkmcnt(0)\n\ts_barrier":::"memory")
typedef __attribute__((address_space(3))) const char* lds_cptr;
typedef short v4i16_t __attribute__((ext_vector_type(4)));
#define LDSB8(p) (*(const __attribute__((address_space(3))) bf16x8*)(p))
__device__ __forceinline__ void kload8(bf16x8*kf,lds_cptr kp){
  kf[0]=LDSB8(kp);      kf[1]=LDSB8(kp+512);  kf[2]=LDSB8(kp+2048); kf[3]=LDSB8(kp+2560);
  kf[4]=LDSB8(kp+4096); kf[5]=LDSB8(kp+4608); kf[6]=LDSB8(kp+6144); kf[7]=LDSB8(kp+6656);
}
__device__ __forceinline__ void kload2(bf16x8*kf,lds_cptr kp,int j){ kf[2*j]=LDSB8(kp+j*2048); kf[2*j+1]=LDSB8(kp+j*2048+512); }
__device__ __forceinline__ s16x4 vtr(lds_cptr p){ return __builtin_bit_cast(s16x4,__builtin_amdgcn_ds_read_tr16_b64_v4i16((__attribute__((address_space(3))) v4i16_t*)p)); }
__device__ __forceinline__ float rowmax(const f32x16&p0,const f32x16&p1){
  float a=max3f(p0[0],p0[1],p1[0]),b=max3f(p0[2],p0[3],p1[1]);a=max3f(a,p1[2],p1[3]);
  #pragma unroll
  for(int r=4;r<16;r+=4){a=max3f(a,p0[r],p0[r+1]);b=max3f(b,p0[r+2],p0[r+3]);a=max3f(a,p1[r],p1[r+1]);b=max3f(b,p1[r+2],p1[r+3]);}
  const float m=max2f(a,b);
  auto rr=__builtin_amdgcn_permlane32_swap(__float_as_uint(m),__float_as_uint(m),false,false);
  return max2f(__uint_as_float(rr[0]),__uint_as_float(rr[1]));
}
__device__ __forceinline__ void pv(f32x16*o,int vb,bf16x8 pa0,bf16x8 pa1,bf16x8 pa2,bf16x8 pa3){
  #pragma unroll
  for(int d0=0;d0<2;++d0){s16x4 lo[4],hi[4];
    #pragma unroll
    for(int ks=0;ks<4;++ks){
      asm volatile("ds_read_b64_tr_b16 %0,%1 offset:%c2":"=&v"(lo[ks]):"v"(vb),"i"(d0*4096+ks*1024):"memory");
      asm volatile("ds_read_b64_tr_b16 %0,%1 offset:%c2":"=&v"(hi[ks]):"v"(vb),"i"(d0*4096+ks*1024+512):"memory");}
    asm volatile("s_waitcnt lgkmcnt(0)":::"memory");SBAR();
    #define PK(k) (bf16x8){lo[k][0],lo[k][1],lo[k][2],lo[k][3],hi[k][0],hi[k][1],hi[k][2],hi[k][3]}
    o[d0]=__builtin_amdgcn_mfma_f32_32x32x16_bf16(pa0,PK(0),o[d0],0,0,0);
    o[d0]=__builtin_amdgcn_mfma_f32_32x32x16_bf16(pa1,PK(1),o[d0],0,0,0);
    o[d0]=__builtin_amdgcn_mfma_f32_32x32x16_bf16(pa2,PK(2),o[d0],0,0,0);
    o[d0]=__builtin_amdgcn_mfma_f32_32x32x16_bf16(pa3,PK(3),o[d0],0,0,0);
    #undef PK
  }
}
__device__ __forceinline__ float ref_split(float x,unsigned himask,unsigned&q1,unsigned&q2){
  const unsigned b1=cvtpk_s(x,0.f)&0xffffu; const float r1=__uint_as_float(b1<<16);
  const unsigned b2=cvtpk_s(x-r1,0.f)&0xffffu; const float r2=__uint_as_float(b2<<16);
  q1=(0x3F80u|((b1^0x8000u)<<16))&himask; q2=(b2^0x8000u)&himask; return r1+r2;
}
template<int THRL> __device__ __forceinline__ void attn_unit(int b,int h,int qb,int t0,const bf16_t*Q,const bf16_t*__restrict__ K,const bf16_t*__restrict__ V,const bf16_t*__restrict__ CB,bf16_t*O,char*shm,const int g_wave){
  const int tid=TIDX,lane=tid&63,r32=lane&31,hi=lane>>5; const int wid=__builtin_amdgcn_readfirstlane(tid>>6);
  const long rowbase=(long)b*SEQ; const int q0=qb*QB;
  const bf16_t*Qw=Q+(rowbase+q0+wid*QBLK)*PQ+h*64;
  const bf16_t*Kh=K+(rowbase+(long)t0*KVBLK)*PQ+h*64,*Vh=V+(rowbase+(long)t0*KVBLK)*PQ+h*64;
  const bf16_t*CBh=CB+((long)(b*4+h)*SEQ+(long)t0*KVBLK)*16;
  const unsigned lds0=(unsigned)(uintptr_t)shm;
  float*wsf=(float*)(shm+LDS_WS)+wid*64;
  const bf16_t*ksrc=Kh+(long)lane*PQ+wid*8;
  const bf16_t*vsrc=Vh+(long)(16*(wid&3)+(lane>>2))*PQ+(wid>>2)*32+(lane&3)*8;
  const bf16_t*csrc=CBh+(wid*8)*16+lane*8;
  const unsigned kdst=lds0+LDS_K+wid*1024, vdst=lds0+LDS_V+wid*1024, cdst=lds0+LDS_CB+wid*256;
  #define DMA_K(t,slot) do{ glds16(ksrc+(long)(t)*KVBLK*PQ,(unsigned)__builtin_amdgcn_readfirstlane(kdst+(slot))); \
      if(lane<16) glds16(csrc+(long)(t)*KVBLK*16,(unsigned)__builtin_amdgcn_readfirstlane(cdst+((slot)>>2))); }while(0)
  #define DMA_V(t,slot) glds16(vsrc+(long)(t)*KVBLK*PQ,(unsigned)__builtin_amdgcn_readfirstlane(vdst+(slot)))
  const int vb0=(int)(lds0+LDS_V)+((lane>>4)&1)*32+(lane&3)*8+(4*hi+((lane&15)>>2))*64;
  bf16x8 kf[8], kfe[2];
  const lds_cptr shm3=(lds_cptr)shm; const lds_cptr kp0=shm3+LDS_K+hi*1024+r32*16; const lds_cptr vp0=shm3+LDS_V+((lane>>4)&1)*32+(lane&3)*8+(4*hi+((lane&15)>>2))*64;
  const lds_cptr cp0=shm3+LDS_CB+r32*32+hi*16;
  const int NT=(q0+QB)/KVBLK-t0;
  DMA_K(0,0);DMA_V(0,0);DMA_K(1,SLOTB);
  bf16x8 qr[4];
  #pragma unroll
  for(int d0=0;d0<4;++d0)qr[d0]=*reinterpret_cast<const bf16x8*>(&Qw[(long)r32*PQ+d0*16+hi*8]);
  const unsigned himask=hi?0u:0xffffffffu;
  u32x4 qe; qe[0]=0x3F803F80u&himask; qe[3]=0u; float mhat; { unsigned q1_,q2_; mhat=ref_split(0.f,himask,q1_,q2_); qe[1]=q1_; qe[2]=q2_; }
  float l_reg=0.f;f32x16 o[2];o[0]=f32x16{};o[1]=f32x16{};
  const f32x16 Z=f32x16{};
  const int qrel=wid*QBLK+r32;
  #define QE() __builtin_bit_cast(bf16x8,qe)
  #define CMASK(P0,P1,t) do{int jb_=(t)-(NT-4); if(jb_>=0)cmask(P0,P1,jb_,qrel,hi);}while(0)
  bool resc=false;
  #define MOVE_REF(dl,DL_) do{ unsigned q1_,q2_; const float nr_=ref_split(mhat+(dl),himask,q1_,q2_); qe[1]=q1_; qe[2]=q2_; DL_=nr_-mhat; mhat=nr_; asm volatile("":"+v"(qe)); }while(0)
  #define START(P0,P1) do{ const float rm=rowmax(P0,P1); resc=false; \
    { float dl_; MOVE_REF(rm,dl_); \
      _Pragma("unroll") for(int r=0;r<16;++r){P0[r]=fsub_s(P0[r],dl_);P1[r]=fsub_s(P1[r],dl_);} } \
    _Pragma("unroll") for(int r=0;r<16;++r)P0[r]=__builtin_amdgcn_exp2f(P0[r]); }while(0)
  #define RESC() do{ if(resc){ asm volatile("s_waitcnt lgkmcnt(0)":::"memory"); \
      _Pragma("unroll") for(int d_=0;d_<2;++d_) _Pragma("unroll") for(int r=0;r<16;++r)o[d_][r]*=wsf[crow(r,hi)]; } }while(0)
  f32x16 pA0,pA1,pB0,pB1;
  int sl_prev=0,sl_cur=0,sl_next=SLOTB;
  #define ROT() do{sl_prev=sl_cur;sl_cur=sl_next;sl_next=(sl_next==(NSLOT-1)*SLOTB)?0:sl_next+SLOTB;}while(0)
  DMA_K(2,2*SLOTB);
  WAIT_BAR(5);
  { kfe[0]=LDSB8(cp0); kfe[1]=LDSB8(cp0+1024); kload8(kf,kp0);
    pA0=__builtin_amdgcn_mfma_f32_32x32x16_bf16(kfe[0],QE(),Z,0,0,0); pA1=__builtin_amdgcn_mfma_f32_32x32x16_bf16(kfe[1],QE(),Z,0,0,0);
    #pragma unroll
    for(int d0=0;d0<4;++d0){ pA0=__builtin_amdgcn_mfma_f32_32x32x16_bf16(kf[2*d0],qr[d0],pA0,0,0,0); pA1=__builtin_amdgcn_mfma_f32_32x32x16_bf16(kf[2*d0+1],qr[d0],pA1,0,0,0); } }
  asm volatile("s_nop 15\n\ts_nop 7":"+v"(pA0),"+v"(pA1));CMASK(pA0,pA1,0);
  START(pA0,pA1);
  _Pragma("unroll") for(int r=0;r<16;++r)pA1[r]=__builtin_amdgcn_exp2f(pA1[r]);
  WAIT_BAR(0);
  DMA_K(3,0);DMA_V(1,SLOTB);
  ROT();
  kload8(kf,kp0+sl_cur); kfe[0]=LDSB8(cp0+(sl_cur>>2)); kfe[1]=LDSB8(cp0+(sl_cur>>2)+1024);
  WAIT_BAR(3);
  s16x4 vlo[8],vhi[8]; u32x4 pw0,pw1,pw2,pw3;
  #define PKW(P,B) cvtpk_s(P[B],P[B+1])
  #define PAF(k) __builtin_bit_cast(bf16x8,pw##k)
  #define VFR(i) (bf16x8){vlo[i][0],vlo[i][1],vlo[i][2],vlo[i][3],vhi[i][0],vhi[i][1],vhi[i][2],vhi[i][3]}
  #define PIN(x) asm volatile("":"+v"(x))
  #define MX3(a,b,c) __builtin_fmaxf(__builtin_fmaxf((a),(b)),(c))
  #define GAPA(MF,A0,A1,A2,A3,W0,W1,PW) do{ MF; sacc+=A0; sacc+=A1; sacc+=A2; sacc+=A3; PIN(sacc); W0; W1; PIN(PW); SBAR(); }while(0)
  #define EX(v) __builtin_amdgcn_exp2f(v)
  #define GAPB(MF,X,B) do{ MF; X[B]=EX(X[B]); X[B+1]=EX(X[B+1]); X[B+2]=EX(X[B+2]); X[B+3]=EX(X[B+3]); PIN(X); SBAR(); }while(0)
  #define VRD(i) do{ vlo[i]=vtr(vp_+(((i)>>2)*4096+((i)&3)*1024)); vhi[i]=vtr(vp_+(((i)>>2)*4096+((i)&3)*1024+512)); }while(0)
  #define KRD(G,j) do{ if(G){ kload2(kf,kp0+sl_next,j); if((j)==0){ kfe[0]=LDSB8(cp0+(sl_next>>2)); kfe[1]=LDSB8(cp0+(sl_next>>2)+1024); } SBAR(); } }while(0)
  #define STEP(C0,C1,P0,P1,t,GK,GV,GL) do{ SBAR(); \
    const lds_cptr vp_=vp0+sl_prev; \
    C0=__builtin_amdgcn_mfma_f32_32x32x16_bf16(kfe[0],QE(),Z,0,0,0); C1=__builtin_amdgcn_mfma_f32_32x32x16_bf16(kfe[1],QE(),Z,0,0,0); SBAR(); \
    VRD(0); SBAR(); float sacc=(P0[0]+P0[1]); \
    GAPA(C0=__builtin_amdgcn_mfma_f32_32x32x16_bf16(kf[0],qr[0],C0,0,0,0), P0[2],P0[3],P0[4],P0[5],     pw0[0]=PKW(P0,0), pw0[1]=PKW(P0,2), pw0); \
    VRD(4); SBAR(); GAPA(C1=__builtin_amdgcn_mfma_f32_32x32x16_bf16(kf[1],qr[0],C1,0,0,0), P0[6],P0[7],P0[8],P0[9],     pw0[2]=PKW(P0,4), pw0[3]=PKW(P0,6), pw0); \
    VRD(1); SBAR(); GAPA(C0=__builtin_amdgcn_mfma_f32_32x32x16_bf16(kf[2],qr[1],C0,0,0,0),   P0[10],P0[11],P0[12],P0[13], pw1[0]=PKW(P0,8), pw1[1]=PKW(P0,10), pw1); \
    VRD(5); SBAR(); GAPA(C1=__builtin_amdgcn_mfma_f32_32x32x16_bf16(kf[3],qr[1],C1,0,0,0),   P0[14],P0[15],P1[0],P1[1],   pw1[2]=PKW(P0,12),pw1[3]=PKW(P0,14), pw1); \
    VRD(2); SBAR(); GAPA(C0=__builtin_amdgcn_mfma_f32_32x32x16_bf16(kf[4],qr[2],C0,0,0,0),   P1[2],P1[3],P1[4],P1[5],     pw2[0]=PKW(P1,0), pw2[1]=PKW(P1,2), pw2); \
    VRD(6); SBAR(); GAPA(C1=__builtin_amdgcn_mfma_f32_32x32x16_bf16(kf[5],qr[2],C1,0,0,0),   P1[6],P1[7],P1[8],P1[9],     pw2[2]=PKW(P1,4), pw2[3]=PKW(P1,6), pw2); \
    VRD(3); SBAR(); GAPA(C0=__builtin_amdgcn_mfma_f32_32x32x16_bf16(kf[6],qr[3],C0,0,0,0),   P1[10],P1[11],P1[12],P1[13], pw3[0]=PKW(P1,8), pw3[1]=PKW(P1,10), pw3); \
    VRD(7); SBAR(); GAPA(C1=__builtin_amdgcn_mfma_f32_32x32x16_bf16(kf[7],qr[3],C1,0,0,0),   P1[14],P1[15],0.f,0.f,       pw3[2]=PKW(P1,12),pw3[3]=PKW(P1,14), pw3); \
    l_reg+=sacc; \
    if(GK){DMA_K((t)+3,sl_cur);} if(GV){DMA_V((t)+1,sl_next);} \
    CMASK(C0,C1,t); \
    { float a=MX3(C0[0],C0[1],C1[0]),b=MX3(C0[2],C0[3],C1[1]); a=MX3(a,C1[2],C1[3]); \
      _Pragma("unroll") for(int r=4;r<16;r+=4){a=MX3(a,C0[r],C0[r+1]);b=MX3(b,C0[r+2],C0[r+3]);a=MX3(a,C1[r],C1[r+1]);b=MX3(b,C1[r+2],C1[r+3]);} \
      float rm=__builtin_fmaxf(a,b); { auto rr=__builtin_amdgcn_permlane32_swap(__float_as_uint(rm),__float_as_uint(rm),false,false); rm=__builtin_fmaxf(__uint_as_float(rr[0]),__uint_as_float(rr[1])); } \
      resc=false; \
      if(__builtin_expect(__any(rm>(float)THRL),0)){ float dl; MOVE_REF(__builtin_fmaxf(rm,0.f),dl); \
        _Pragma("unroll") for(int r=0;r<16;++r){C0[r]-=dl;C1[r]-=dl;} \
        const float f=__builtin_amdgcn_exp2f(-dl); l_reg*=f; if(hi==0)wsf[r32]=f; resc=true; } } \
    SBAR(); \
    GAPB(o[0]=__builtin_amdgcn_mfma_f32_32x32x16_bf16(PAF(0),VFR(0),o[0],0,0,0), C0,0); \
    GAPB(o[1]=__builtin_amdgcn_mfma_f32_32x32x16_bf16(PAF(0),VFR(4),o[1],0,0,0), C0,4); \
    KRD(GL,0); GAPB(o[0]=__builtin_amdgcn_mfma_f32_32x32x16_bf16(PAF(1),VFR(1),o[0],0,0,0), C0,8); \
    KRD(GL,1); GAPB(o[1]=__builtin_amdgcn_mfma_f32_32x32x16_bf16(PAF(1),VFR(5),o[1],0,0,0), C0,12); \
    KRD(GL,2); GAPB(o[0]=__builtin_amdgcn_mfma_f32_32x32x16_bf16(PAF(2),VFR(2),o[0],0,0,0), C1,0); \
    KRD(GL,3); GAPB(o[1]=__builtin_amdgcn_mfma_f32_32x32x16_bf16(PAF(2),VFR(6),o[1],0,0,0), C1,4); \
    GAPB(o[0]=__builtin_amdgcn_mfma_f32_32x32x16_bf16(PAF(3),VFR(3),o[0],0,0,0), C1,8); \
    GAPB(o[1]=__builtin_amdgcn_mfma_f32_32x32x16_bf16(PAF(3),VFR(7),o[1],0,0,0), C1,12); \
    }while(0)
  int t=1;
  #undef CMASK
  #define CMASK(P0,P1,t) do{}while(0)
  for(;t+5<NT;t+=2){
    STEP(pB0,pB1,pA0,pA1,t,true,true,true);     WAIT_BAR(3); RESC(); ROT();
    STEP(pA0,pA1,pB0,pB1,t+1,true,true,true);   WAIT_BAR(3); RESC(); ROT();
  }
  #undef CMASK
  #define CMASK(P0,P1,t) do{int jb_=(t)-(NT-4); if(jb_>=0)cmask(P0,P1,jb_,qrel,hi);}while(0)
  #define ENDW(tt) do{ if((tt)+3<NT){WAIT_BAR(3);} else if((tt)+2<NT){WAIT_BAR(1);} else {WAIT_BAR(0);} }while(0)
  for(;t+1<NT;t+=2){
    STEP(pB0,pB1,pA0,pA1,t,(t+3<NT),(t+1<NT),(t+1<NT));       ENDW(t);   RESC(); ROT();
    STEP(pA0,pA1,pB0,pB1,t+1,(t+4<NT),(t+2<NT),(t+2<NT));     ENDW(t+1); RESC(); ROT();
  }
  STEP(pB0,pB1,pA0,pA1,NT-1,false,false,false); RESC();
  { float sacc=pB0[0]+pB0[1]; _Pragma("unroll") for(int r=2;r<16;++r)sacc+=pB0[r]; _Pragma("unroll") for(int r=0;r<16;++r)sacc+=pB1[r]; l_reg+=sacc;
    pw0=(u32x4){PKW(pB0,0),PKW(pB0,2),PKW(pB0,4),PKW(pB0,6)};pw1=(u32x4){PKW(pB0,8),PKW(pB0,10),PKW(pB0,12),PKW(pB0,14)};pw2=(u32x4){PKW(pB1,0),PKW(pB1,2),PKW(pB1,4),PKW(pB1,6)};pw3=(u32x4){PKW(pB1,8),PKW(pB1,10),PKW(pB1,12),PKW(pB1,14)};
    SBAR(); pv(o,vb0+sl_cur,PAF(0),PAF(1),PAF(2),PAF(3)); }
  #undef PKW
  #undef PAF
  #undef VFR
  #undef PIN
  #undef MX3
  #undef GAPA
  #undef GAPB
  #undef EX
  #undef VRD
  #undef KRD
  #undef STEP
  #undef ENDW
  {auto rr=__builtin_amdgcn_permlane32_swap(__float_as_uint(l_reg),__float_as_uint(l_reg),false,false);l_reg=__uint_as_float(rr[0])+__uint_as_float(rr[1]);}
  if(hi==0)wsf[32+r32]=l_reg;asm volatile("s_waitcnt lgkmcnt(0)":::"memory");
  float rli[16];
  #pragma unroll
  for(int r=0;r<16;++r)rli[r]=__builtin_amdgcn_rcpf(wsf[32+crow(r,hi)]);
  bf16_t*Ow=O+(rowbase+q0+wid*QBLK)*PO+h*64;
  { bf16_t*stg=(bf16_t*)(shm+LDS_OST)+wid*2048;
    #pragma unroll
    for(int r=0;r<16;++r){const int orow=crow(r,hi);
      #pragma unroll
      for(int d0=0;d0<2;++d0)stg[orow*64+d0*32+r32]=f2bf(o[d0][r]*rli[r]);}
    asm volatile("s_waitcnt lgkmcnt(0)":::"memory");
    #pragma unroll
    for(int i=0;i<4;++i){const int row=i*8+(lane>>3),ch=lane&7; const u32x4 v=*(const u32x4*)(stg+row*64+ch*8); *(u32x4*)(Ow+(long)row*PO+ch*8)=v;} }
  asm volatile("s_waitcnt lgkmcnt(0)\n\ts_barrier":::"memory");
  #undef DMA_K
  #undef DMA_V
  #undef CMASK
  #undef START
  #undef RESC
  #undef ROT
  #undef QE
  #undef MOVE_REF
}
#undef SBAR
#undef WAIT_BAR
#undef LDSB8
}

using pg8::Unit;
struct SchedDense { int nM, nN, G, c, lda, ldb;
    __device__ __forceinline__ bool next(int i, Unit& u) const { int pm, pn; if (!pg8::static_tile(i, G, c, nM, nN, pm, pn)) return false;
        u.pm = pm; u.pn = pn; u.a = 0; u.b = 0; u.c = 0; u.e = 0; u.aoff = (size_t)pm * 256 * lda * 2; u.boff = (size_t)pn * 256 * ldb * 2; return true; } };
struct SchedG2 { int G, c;
    __device__ __forceinline__ bool next(int i, Unit& u) const { int pm, pn; if (!pg8::static_tile(i >> 2, G, c, 64, 8, pm, pn)) return false; const int n = i & 3;
        u.pm = pm; u.pn = pn; u.a = n; u.b = 0; u.c = 0; u.e = 0; u.aoff = ((size_t)pm * 256 * 1024 + n * 256) * 2; u.boff = ((size_t)(n * 1024 + pn * 128) * 256) * 2; return true; } };
template <int NPN, bool DOWN> struct SchedMoe { LAS const i32x4* TL; int u0, u1, per, j;
    __device__ __forceinline__ bool next(int i, Unit& u) const { const int L = u0 + i * per + j; if (L >= u1) return false;
        const int tile = L / NPN, pn = L % NPN; const i32x4 t = TL[tile];
        const int e = __builtin_amdgcn_readfirstlane(t[0]), sb = __builtin_amdgcn_readfirstlane(t[1]), nv = __builtin_amdgcn_readfirstlane(t[2]), ib = __builtin_amdgcn_readfirstlane(t[3]);
        u.pm = tile; u.pn = pn; u.e = e; u.a = sb; u.b = nv; u.c = ib;
        if (DOWN) { u.aoff = (size_t)sb * 256 * (FP8_GB ? 1 : 2); u.boff = WB_W2 * 2 + ((size_t)e * 1024 + pn * 256) * 256 * (FP8_GB ? 1 : 2); }
        else { u.aoff = 0; u.boff = WB_W13 * 2 + ((size_t)e * 512 + pn * 256) * 1024 * (FP8_GA ? 1 : 2); }
        return true; } };

typedef f32x4 Acc[2][2][4][2];
struct Epi1 { static constexpr bool PERM = true; static constexpr int NBJ = 2; static constexpr float ASCALE = FP8_G1 ? 1.f / 64.f : 1.f; bf16_t* PROJ; bf16_t* SG; unsigned* NRM;
    __device__ __forceinline__ void operator()(const Acc& acc, const Unit& u, int wr, int wc, int fr, int fq) const {
        asm volatile("" : "+v"(fr), "+v"(fq));
        const int pn = u.pn; const int mode = (pn >= 8) ? 2 : ((pn == 1 || pn == 2) ? 1 : (pn == 5 ? 3 : 0));
        bf16_t* base = (pn >= 8) ? SG + (pn - 8) * 256 : PROJ + pn * 256; const int ldc = (pn >= 8) ? 4096 : 2048;
        const int row0 = u.pm * 256 + wr * 64 + fr, col0 = wc * 32 + 8 * fq;
#pragma unroll
        for (int ai = 0; ai < 2; ++ai)
#pragma unroll
            for (int m = 0; m < 4; ++m) { bf16_t* rowp = base + (size_t)(row0 + ai * 128 + m * 16) * ldc + col0;
#pragma unroll
                for (int bj = 0; bj < 2; ++bj) { float v[8];
#pragma unroll
                    for (int n = 0; n < 2; ++n)
#pragma unroll
                        for (int q = 0; q < 4; ++q) { float x = acc[ai][bj][m][n][q] * ASCALE;
                            if (mode == 1) x = gelu_tanh(x); else if (mode == 2) x = sigmoidf_(x); else if (mode == 3) x *= QSCALE;
                            v[4 * n + q] = x; }
                    if (mode == 2) { u32x2 w = (u32x2){0u, 0u};
#pragma unroll
                        for (int i = 0; i < 4; ++i) { w.x = __builtin_amdgcn_cvt_pk_u8_f32(v[i] * 255.f, i, w.x); w.y = __builtin_amdgcn_cvt_pk_u8_f32(v[4 + i] * 255.f, i, w.y); }
                        *(u32x2*)((unsigned char*)SG + (size_t)(row0 + ai * 128 + m * 16) * 4096 + (pn - 8) * 256 + col0 + bj * 128) = w; }
                    else { u32x4 w; w.x = cvt_pk_bf16(v[0], v[1]); w.y = cvt_pk_bf16(v[2], v[3]); w.z = cvt_pk_bf16(v[4], v[5]); w.w = cvt_pk_bf16(v[6], v[7]);
                        *(u32x4*)(rowp + bj * 128) = w; } } }
        if (pn == 5 || pn == 6) {
            const float sc = (pn == 5) ? QSCALE : 1.f;
#pragma unroll
            for (int bj = 0; bj < 2; ++bj) { float mx = 0.f;
#pragma unroll
                for (int ai = 0; ai < 2; ++ai)
#pragma unroll
                    for (int m = 0; m < 4; ++m) { float ss = 0.f;
#pragma unroll
                        for (int n = 0; n < 2; ++n)
#pragma unroll
                            for (int q = 0; q < 4; ++q) { const float x = acc[ai][bj][m][n][q] * (sc * ASCALE); ss += x * x; }
                        ss = fq_sum(ss); mx = fmaxf(mx, ss); }
                mx = row16_max_dpp(mx);
                if (fr == 0 && fq == 0) atomicMax(NRM + ((((pn - 5) * 2 + (u.pm >> 5)) * 4 + 2 * bj + (wc >> 1)) * 2 + (wc & 1)), __float_as_uint(mx)); } }
    } };
struct Epi2 { static constexpr bool PERM = true; static constexpr int NBJ = 1; const unsigned char* SG; bf16_t* MRG; mutable f32x4 mrg[2][4][2];
    __device__ __forceinline__ void operator()(const Acc& acc, const Unit& u, int wr, int wc, int fr, int fq) const {
        asm volatile("" : "+v"(fr), "+v"(fq));
        const int n_ = u.a; const int row0 = u.pm * 256 + wr * 64 + fr, col0 = u.pn * 128 + wc * 32 + 8 * fq;
        u32x2 g[2][4];
#pragma unroll
        for (int ai = 0; ai < 2; ++ai)
#pragma unroll
            for (int m = 0; m < 4; ++m) g[ai][m] = *(const u32x2*)(SG + (size_t)(row0 + ai * 128 + m * 16) * 4096 + n_ * 1024 + col0);
#pragma unroll
        for (int ai = 0; ai < 2; ++ai)
#pragma unroll
            for (int m = 0; m < 4; ++m) { const u32x2 gg = g[ai][m]; const f32x4 a0 = acc[ai][0][m][0] * (1.f / 255.f), a1 = acc[ai][0][m][1] * (1.f / 255.f);
                const f32x4 t0 = (f32x4){(float)(gg.x & 255u) * a0[0], (float)((gg.x >> 8) & 255u) * a0[1], (float)((gg.x >> 16) & 255u) * a0[2], (float)(gg.x >> 24) * a0[3]};
                const f32x4 t1 = (f32x4){(float)(gg.y & 255u) * a1[0], (float)((gg.y >> 8) & 255u) * a1[1], (float)((gg.y >> 16) & 255u) * a1[2], (float)(gg.y >> 24) * a1[3]};
                if (n_ == 0) { mrg[ai][m][0] = t0; mrg[ai][m][1] = t1; } else { mrg[ai][m][0] = mrg[ai][m][0] + t0; mrg[ai][m][1] = mrg[ai][m][1] + t1; }
                if (n_ == 3) { const f32x4 r0 = mrg[ai][m][0], r1 = mrg[ai][m][1];
                    u32x4 w; w.x = cvt_pk_bf16(r0[0], r0[1]); w.y = cvt_pk_bf16(r0[2], r0[3]); w.z = cvt_pk_bf16(r1[0], r1[1]); w.w = cvt_pk_bf16(r1[2], r1[3]);
                    *(u32x4*)(MRG + (size_t)(row0 + ai * 128 + m * 16) * 1024 + col0) = w; } }
    } };
struct Epi3 { static constexpr bool PERM = true; static constexpr int NBJ = 2; const float* xin32; bf16_t* X; const float* gate;
    __device__ __forceinline__ void operator()(const Acc& acc, const Unit& u, int wr, int wc, int fr, int fq) const {
        asm volatile("" : "+v"(fr), "+v"(fq));
        const int b = u.pm >> 5; const float* gp = gate + (size_t)b * 6144 + 2 * 1024;
        const int row0 = u.pm * 256 + wr * 64 + fr, col0 = u.pn * 256 + wc * 32 + 8 * fq;
#pragma unroll
        for (int bj = 0; bj < 2; ++bj) { const int col = col0 + bj * 128; const f32x4 g0 = *(const f32x4*)(gp + col), g1 = *(const f32x4*)(gp + col + 4);
#pragma unroll
            for (int ai = 0; ai < 2; ++ai)
#pragma unroll
                for (int m = 0; m < 4; ++m) { const size_t off = (size_t)(row0 + ai * 128 + m * 16) * 1024 + col; f32x4 x0, x1;
                    if (xin32) { x0 = *(const f32x4*)(xin32 + off); x1 = *(const f32x4*)(xin32 + off + 4); }
                    else { const u32x4 w = *(const u32x4*)(X + off); x0 = (f32x4){bflo(w.x), bfhi(w.x), bflo(w.y), bfhi(w.y)}; x1 = (f32x4){bflo(w.z), bfhi(w.z), bflo(w.w), bfhi(w.w)}; }
                    x0 = x0 + g0 * acc[ai][bj][m][0]; x1 = x1 + g1 * acc[ai][bj][m][1];
                    u32x4 o; o.x = cvt_pk_bf16(x0[0], x0[1]); o.y = cvt_pk_bf16(x0[2], x0[3]); o.z = cvt_pk_bf16(x1[0], x1[1]); o.w = cvt_pk_bf16(x1[2], x1[3]);
                    *(u32x4*)(X + off) = o; } }
    } };
struct EpiUp { static constexpr bool PERM = true; static constexpr int NBJ = 2; static constexpr float ASCALE = FP8_GA ? 1.f / 64.f : 1.f; bf16_t* HID; const float* GWP;
    __device__ __forceinline__ void operator()(const Acc& acc, const Unit& u, int wr, int wc, int fr, int fq) const {
        asm volatile("" : "+v"(fr), "+v"(fq));
#pragma unroll
        for (int ai = 0; ai < 2; ++ai)
#pragma unroll
            for (int m = 0; m < 4; ++m) { const int r = ai * 128 + wr * 64 + m * 16 + fr;
                if (r < u.b) { const size_t slot = (size_t)u.a + r; const float gw = (u.e < 64) ? GWP[u.c + r] : 1.f; float v[8];
#pragma unroll
                    for (int n = 0; n < 2; ++n)
#pragma unroll
                        for (int q = 0; q < 4; ++q) v[4 * n + q] = siluf_(acc[ai][0][m][n][q] * ASCALE) * (acc[ai][1][m][n][q] * ASCALE) * gw;
#if FP8_GB
                    u32x2 w; w.x = pk4_fp8(v[0] * 8.f, v[1] * 8.f, v[2] * 8.f, v[3] * 8.f); w.y = pk4_fp8(v[4] * 8.f, v[5] * 8.f, v[6] * 8.f, v[7] * 8.f);
                    *(u32x2*)((unsigned char*)HID + slot * 256 + u.pn * 128 + wc * 32 + 8 * fq) = w; } }
#else
                    u32x4 w; w.x = cvt_pk_bf16(v[0], v[1]); w.y = cvt_pk_bf16(v[2], v[3]); w.z = cvt_pk_bf16(v[4], v[5]); w.w = cvt_pk_bf16(v[6], v[7]);
                    *(u32x4*)(HID + slot * 256 + u.pn * 128 + wc * 32 + 8 * fq) = w; } }
#endif
    } };
struct EpiDown { static constexpr bool PERM = true; static constexpr int NBJ = 2; static constexpr float ASCALE = FP8_GB ? 1.f / 512.f : 1.f; unsigned char* Y2Q; float* Y2S;
    __device__ __forceinline__ void operator()(const Acc& acc, const Unit& u, int wr, int wc, int fr, int fq) const {
        asm volatile("" : "+v"(fr), "+v"(fq));
#pragma unroll
        for (int ai = 0; ai < 2; ++ai)
#pragma unroll
            for (int m = 0; m < 4; ++m) { const int r = ai * 128 + wr * 64 + m * 16 + fr; const size_t slot = (size_t)u.a + r;
#pragma unroll
                for (int bj = 0; bj < 2; ++bj) { const f32x4 a0 = acc[ai][bj][m][0], a1 = acc[ai][bj][m][1];
                    float mx = fmaxf(fmaxf(fmaxf(fabsf(a0[0]), fabsf(a0[1])), fmaxf(fabsf(a0[2]), fabsf(a0[3]))), fmaxf(fmaxf(fabsf(a1[0]), fabsf(a1[1])), fmaxf(fabsf(a1[2]), fabsf(a1[3]))));
                    mx = fq_max(mx);
                    const float sc = mx * (ASCALE / 127.f), inv = mx > 0.f ? 127.f * frcp(mx) : 0.f;
                    unsigned w0 = 0u, w1 = 0u;
#pragma unroll
                    for (int i = 0; i < 4; ++i) { w0 = __builtin_amdgcn_cvt_pk_u8_f32(a0[i] * inv + 128.f, i, w0); w1 = __builtin_amdgcn_cvt_pk_u8_f32(a1[i] * inv + 128.f, i, w1); }
                    if (r < u.b) { *(u32x2*)(Y2Q + slot * 1024 + u.pn * 256 + bj * 128 + wc * 32 + 8 * fq) = (u32x2){w0, w1};
                        if (fq == 0) Y2S[slot * 32 + u.pn * 8 + bj * 4 + wc] = sc; } } }
    } };

__device__ __forceinline__ void phase_token(const Params& P, LAS unsigned char* lds, int l, int bid, int G, const int g_wave, int ctr) {
    const int tid = TIDX, lane = tid & 63, wave = __builtin_amdgcn_readfirstlane(tid >> 6);
    constexpr int AP = 1032;
    LAS bf16_t* Ahi = (LAS bf16_t*)lds; LAS bf16_t* Alo = (LAS bf16_t*)(lds + 16 * AP * 2);
    LAS float* part = (LAS float*)(lds + 2 * 16 * AP * 2);
    LAS int* cntw = (LAS int*)(lds + 2 * 16 * AP * 2 + 8192); LAS int* basew = cntw + 8 * 64;
    const float* MOD = (const float*)(wsptr(P) + WS_SMALL + SM_MOD);
    const bf16_t* X = (const bf16_t*)(wsptr(P) + WS_X); bf16_t* H = (bf16_t*)(wsptr(P) + WS_H);
    int* TE = (int*)(wsptr(P) + WS_SMALL + SM_TE); int* TP = (int*)(wsptr(P) + WS_SMALL + SM_TP);
    int* IDXP = (int*)(wsptr(P) + WS_SMALL + SM_IDXP); float* GWP = (float*)(wsptr(P) + WS_SMALL + SM_GWP);
    unsigned* CNT = (unsigned*)(wsptr(P) + WS_CTL) + CW_CNT + ctr * 64;
    const int nt = wave & 3, kh = wave >> 2, kq = lane >> 4;
    bf16x8 bhi[16], blo[16];
    { const bf16_t* WRT = (const bf16_t*)(wsptr(P) + WS_WB) + WB_WR + (size_t)(16 * nt + (lane & 15)) * 1024 + kh * 512 + 8 * kq;
#pragma unroll
      for (int ks = 0; ks < 16; ++ks) { bhi[ks] = *(const bf16x8*)(WRT + 32 * ks); blo[ks] = *(const bf16x8*)(WRT + 65536 + 32 * ks); } }
    const float rb = inptr(I_RB)[l * 64 + lane];
    for (int grp = bid; grp < M / 64; grp += G) {
        int selk[8]; float selw[8]; int cnt = 0;
        f32x4 mA[4], mB[4];
        { const float* md = MOD + (size_t)(l * 2 + ((grp * 64) >> 13)) * 6144;
#pragma unroll
          for (int j = 0; j < 4; ++j) { const int d0 = 256 * j + 4 * lane; mA[j] = *(const f32x4*)(inptr(I_FNG) + l * D + d0) * (*(const f32x4*)(md + 4 * 1024 + d0) + 1.0f); mB[j] = *(const f32x4*)(md + 3 * 1024 + d0); } }
        u32x2 vx[2][4];
#pragma unroll
        for (int i2 = 0; i2 < 2; ++i2)
#pragma unroll
            for (int j = 0; j < 4; ++j) vx[i2][j] = *(const u32x2*)(X + (size_t)(grp * 64 + 2 * wave + i2) * D + 256 * j + 4 * lane);
#pragma unroll
        for (int sub = 0; sub < 4; ++sub) {
#pragma unroll
            for (int i2 = 0; i2 < 2; ++i2) { const int tl = 2 * wave + i2, row = grp * 64 + sub * 16 + tl;
                f32x4 v[4]; float ss = 0.f;
#pragma unroll
                for (int j = 0; j < 4; ++j) { const u32x2 w_ = vx[i2][j]; v[j] = (f32x4){bflo(w_.x), bfhi(w_.x), bflo(w_.y), bfhi(w_.y)}; ss += (v[j][0] * v[j][0] + v[j][1] * v[j][1]) + (v[j][2] * v[j][2] + v[j][3] * v[j][3]); }
                if (sub < 3) {
#pragma unroll
                    for (int j = 0; j < 4; ++j) vx[i2][j] = *(const u32x2*)(X + (size_t)(row + 16) * D + 256 * j + 4 * lane); }
                const float rms = 1.0f / sqrtf(wave_sum(ss) * (1.f / D) + EPS);
#pragma unroll
                for (int j = 0; j < 4; ++j) { const int d0 = 256 * j + 4 * lane;
                    const f32x4 h = v[j] * rms * mA[j] + mB[j];
                    u32x2 w; w.x = cvt_pk_bf16(h[0], h[1]); w.y = cvt_pk_bf16(h[2], h[3]);
#if FP8_GA
                    *(unsigned*)((unsigned char*)(wsptr(P) + WS_HF8) + (size_t)row * D + d0) = pk4_fp8(h[0], h[1], h[2], h[3]);
#else
                    *(u32x2*)(H + (size_t)row * D + d0) = w;
#endif
                    *(LAS u32x2*)(Ahi + tl * AP + d0) = w;
                    u32x2 wl; wl.x = cvt_pk_bf16(h[0] - bflo(w.x), h[1] - bfhi(w.x)); wl.y = cvt_pk_bf16(h[2] - bflo(w.y), h[3] - bfhi(w.y)); *(LAS u32x2*)(Alo + tl * AP + d0) = wl; } }
            __syncthreads();
            { f32x4 a0 = (f32x4){0.f, 0.f, 0.f, 0.f}, a1 = a0, a2 = a0; const int ao = (lane & 15) * AP + kh * 512 + 8 * kq;
#pragma unroll
              for (int ks = 0; ks < 16; ++ks) { const bf16x8 ahi = *(const LAS bf16x8*)(Ahi + ao + 32 * ks), alo = *(const LAS bf16x8*)(Alo + ao + 32 * ks);
                  a0 = __builtin_amdgcn_mfma_f32_16x16x32_bf16(ahi, bhi[ks], a0, 0, 0, 0); a1 = __builtin_amdgcn_mfma_f32_16x16x32_bf16(alo, bhi[ks], a1, 0, 0, 0);
                  a2 = __builtin_amdgcn_mfma_f32_16x16x32_bf16(ahi, blo[ks], a2, 0, 0, 0); }
              const f32x4 acc = a0 + (a1 + a2);
#pragma unroll
              for (int j = 0; j < 4; ++j) part[(kh * 16 + 4 * kq + j) * 64 + 16 * nt + (lane & 15)] = acc[j]; }
            __syncthreads();
            {
                float score[2], sel[2], m1[2], m2[2], gs[2], cand[2]; int i1[2], grank[2], myrank[2];
#pragma unroll
                for (int i2 = 0; i2 < 2; ++i2) { const int tl = 2 * wave + i2; score[i2] = sigmoidf_(part[tl * 64 + lane] + part[(16 + tl) * 64 + lane]); sel[i2] = score[i2] + rb; m1[i2] = grp8_max_dpp(sel[i2]); }
#pragma unroll
                for (int i2 = 0; i2 < 2; ++i2) i1[i2] = grp8_min_dpp((sel[i2] == m1[i2]) ? lane : 64);
#pragma unroll
                for (int i2 = 0; i2 < 2; ++i2) m2[i2] = grp8_max_dpp((lane == i1[i2]) ? -INFINITY : sel[i2]);
                const int grp_id = lane >> 3;
#pragma unroll
                for (int i2 = 0; i2 < 2; ++i2) { gs[i2] = m1[i2] + m2[i2]; grank[i2] = 0; }
#pragma unroll
                for (int j = 0; j < 8; ++j)
#pragma unroll
                    for (int i2 = 0; i2 < 2; ++i2) { const float o = __builtin_bit_cast(float, __builtin_amdgcn_readlane(__builtin_bit_cast(int, gs[i2]), 8 * j)); grank[i2] += (o > gs[i2] || (o == gs[i2] && j < grp_id)) ? 1 : 0; }
#pragma unroll
                for (int i2 = 0; i2 < 2; ++i2) { cand[i2] = (grank[i2] < 4) ? sel[i2] : -INFINITY; myrank[i2] = -1; }
#pragma unroll
                for (int k = 0; k < TOPK; ++k) {
#pragma unroll
                    for (int i2 = 0; i2 < 2; ++i2) { const float mx = wave_max_dpp(cand[i2]); const int first = __ffsll((unsigned long long)__ballot(cand[i2] == mx)) - 1; if (lane == first) { myrank[i2] = k; cand[i2] = -INFINITY; } } }
#pragma unroll
                for (int i2 = 0; i2 < 2; ++i2) { const bool chosen = myrank[i2] >= 0; const float den = wave_sum_dpp(chosen ? score[i2] : 0.f);
                    selk[sub * 2 + i2] = myrank[i2]; selw[sub * 2 + i2] = score[i2] / den * 2.5f; cnt += chosen ? 1 : 0; } }
            __syncthreads();
        }
        cntw[wave * 64 + lane] = cnt;
        __syncthreads();
        if (tid < 64) { int tot = 0; int pre[8];
#pragma unroll
            for (int w = 0; w < 8; ++w) { pre[w] = tot; tot += cntw[w * 64 + tid]; }
            int base = 0; if (tot > 0) base = (int)__hip_atomic_fetch_add(CNT + tid, (unsigned)tot, __ATOMIC_RELAXED, __HIP_MEMORY_SCOPE_AGENT);
#pragma unroll
            for (int w = 0; w < 8; ++w) basew[w * 64 + tid] = base + pre[w]; }
        __syncthreads();
        int run = basew[wave * 64 + lane];
#pragma unroll
        for (int i = 0; i < 8; ++i) { const int t = grp * 64 + (i >> 1) * 16 + 2 * wave + (i & 1);
            if (selk[i] >= 0) { const int o = t * TOPK + selk[i]; TE[o] = lane; TP[o] = run; IDXP[lane * CAP + run] = t; GWP[lane * CAP + run] = selw[i]; ++run; } }
        __syncthreads();
    }
}
__device__ __forceinline__ int moe_tile_list(const Params& P, LAS unsigned char* lds, int l, const int g_wave) {
    moe_offsets(P, lds, l, g_wave);
    LAS const int* eo = (LAS const int*)(lds + EOFF_OFF); LAS i32x4* TL = (LAS i32x4*)(lds + TL_OFF);
    const int tid = TIDX; const int nrt = eo[64 + 63] + ((eo[128 + 63] + 255) >> 8);
    LAS int* TLi = (LAS int*)(lds + TL_OFF);
    if (tid < 64) { const int e = tid, n = eo[128 + e], t0 = eo[64 + e];
#pragma unroll 1
        for (int j = 0; j * 256 < n; ++j) { LAS int* q = TLi + 4 * (t0 + 8 * (e >> 3) + j); q[0] = e; q[1] = eo[e] + j * 256; q[2] = (n - j * 256 < 256) ? n - j * 256 : 256; q[3] = e * CAP + j * 256; } }
    else if (tid < 128) { const int s_ = tid - 64, g_ = s_ >> 3; LAS int* q = TLi + 4 * ((g_ < 7 ? eo[64 + 8 * (g_ + 1)] : nrt) + s_); q[0] = opaque(64); q[1] = NPAIR + s_ * 256; q[2] = opaque(256); q[3] = 64 * CAP + s_ * 256; }
    __syncthreads();
    return nrt + 64;
}

constexpr int PH_PER_LAYER = 8, N_PHASES = 1 + NL * PH_PER_LAYER + 1;
__global__ void __launch_bounds__(NTHREADS, 2) fwd_kernel(Params P) {
    LAS unsigned char* lds = (LAS unsigned char*)lds_raw;
    const int wave = __builtin_amdgcn_readfirstlane((int)threadIdx.x >> 6);
    int bid = blockIdx.x, G = gridDim.x;
    const int g_wave = wave; const int tid = TIDX;
    int gw = bid * NWAVES + wave, NGW = G * NWAVES;
    if (tid < 64) ((LAS unsigned*)(lds + LDSCTL_OFF))[tid] = 0u;
    if (tid == 0) {
#pragma unroll
        for (int i = 0; i < 29; ++i) *(LAS unsigned long long*)(lds + PTRS_OFF + 8 * i) = (unsigned long long)P.in[i];
        *(LAS unsigned long long*)(lds + PTRS_OFF + 8 * 29) = (unsigned long long)P.ws; }
    __syncthreads();
    unsigned* ctl = (unsigned*)(wsptr(P) + WS_CTL);
#if MK_ONE_LAUNCH
    XcdBarrier bar = xcd_barrier_post(ctl + CW_BAR, (volatile LAS unsigned*)(lds + MISC_OFF) + 8, wave);
#define SEAM() xcd_barrier(bar, wave)
#else
#define SEAM() do {} while (0)
#endif
    const int lo = P.ph_lo, hi = P.ph_hi;
#ifndef KMASK
#define KMASK 0xffff
#endif
#define IN(k) (lo <= (k) && (k) < hi)
#define KIND(j) ((KMASK >> (j)) & 1)
#define BOTH(k) (IN(k) && IN((k) + 1))
#define WB ((bf16_t*)(wsptr(P) + WS_WB))
#define X ((float*)(wsptr(P) + WS_X))
#define H ((bf16_t*)(wsptr(P) + WS_H))
#define YS ((bf16_t*)(wsptr(P) + WS_YS))
#define MRG ((bf16_t*)(wsptr(P) + WS_MRG))
#define HID ((bf16_t*)(wsptr(P) + WS_HID))
#define PROJ ((bf16_t*)(wsptr(P) + WS_R1))
#define SG (PROJ + (size_t)M * 2048)
#define Y2 ((bf16_t*)(wsptr(P) + WS_R1))
#define MOD ((const float*)(wsptr(P) + WS_SMALL + SM_MOD))
#define SOPQ(v) asm volatile("" : "+s"(v))
#ifndef DUPK
#define DUPK -1
#endif
#define REP(k) for (int rep_ = 0; rep_ < ((DUPK == (k)) ? 2 : 1); ++rep_, ((DUPK == (k)) && rep_ == 1 ? (SEAM(), 0) : 0))
    if (KIND(0) && IN(0)) { REP(0) phase_ada(P, lds, bid, G, wave); if (BOTH(0)) SEAM(); }

    for (int l = 0; l < NL; ++l) {
        const int pb = 1 + l * PH_PER_LAYER;
        if (KIND(1) && IN(pb + 0)) { SOPQ(bid); SOPQ(G); SOPQ(gw); SOPQ(NGW);
            REP(1) phase_convert<true>(P, lds, l, gw, NGW, wave, 0, CVT_EARLY);
            __syncthreads();
            if (l == 0) { for (int rep_ = 0; rep_ < ((DUPK == 12) ? 2 : 1); ++rep_) phase_norm1<0>(P, lds, l, gw, NGW, wave); } else phase_norm1<1>(P, lds, l, gw, NGW, wave);
            if (BOTH(pb + 0)) SEAM();
        }
        if (KIND(2) && IN(pb + 1)) { SOPQ(bid); SOPQ(G); SOPQ(gw); SOPQ(NGW);
            if (bid < 8) { scan_logf(P, lds, bid, wave); VM_WAIT(); __syncthreads(); }
#if FP8_G1
            pg8::Gemm g{(const bf16_t*)(wsptr(P) + WS_HF8), WB + WB_WIN, 512, 512, 512, nullptr}; SchedDense S{64, 24, G, bid, 512, 512}; Epi1 E{PROJ, SG, ctl + CW_NRM + 64 * l};
            REP(2) pg8::gemm_phase<Epi1, SchedDense, false, true>(lds, g, S, E, wave);
#else
            pg8::Gemm g{H, WB + WB_WIN, 1024, 1024, 1024, nullptr}; SchedDense S{64, 24, G, bid, 1024, 1024}; Epi1 E{PROJ, SG, ctl + CW_NRM + 64 * l};
            REP(2) pg8::gemm_phase<Epi1, SchedDense, false>(lds, g, S, E, wave);
#endif
            if (BOTH(pb + 1)) SEAM();
        }
        if (KIND(3) && IN(pb + 2)) { SOPQ(bid); SOPQ(G); SOPQ(gw); SOPQ(NGW);
            REP(3) {
            unsigned* qheads = ctl + CW_QS + ((l * 2 + rep_) * 8) * 64; LAS int* qitem = (LAS int*)(lds + MISC_OFF) + 16;
            const bf16_t* CBp = (const bf16_t*)(wsptr(P) + WS_SMALL + SM_CB);
            constexpr int NCV = (CVT_ALL - CVT_EARLY + 7) / 8, NI = 896 + NCV;
            int sh = bid & 7, dry = 0;
            for (;;) {
                if (TIDX == 0) *qitem = (int)__hip_atomic_fetch_add(qheads + 64 * sh, 1u, __ATOMIC_RELAXED, __HIP_MEMORY_SCOPE_AGENT);
                __syncthreads();
                const int it = __builtin_amdgcn_readfirstlane(*qitem) * 8 + sh;
                __syncthreads();
                if (it >= NI) { if (++dry >= 8) break; sh = (sh + 1) & 7; continue; }
                if (it >= 256 && it < 256 + NCV) { phase_convert<false>(P, lds, l, wave, 8, wave, CVT_EARLY + (it - 256) * 8, min(CVT_EARLY + (it - 256) * 8 + 8, CVT_ALL)); continue; }
                if (it < 256) {
                    const int qb = 31 - (it >> 3), bh = (it + (it >> 3)) & 7;
                    int t0 = 0;
                    { const unsigned* nq = ctl + CW_NRM + 64 * l + bh * 2; const unsigned* nk = nq + 16;
                      const float qn2 = __uint_as_float(__hip_atomic_load(nq, __ATOMIC_RELAXED, __HIP_MEMORY_SCOPE_AGENT)) + __uint_as_float(__hip_atomic_load(nq + 1, __ATOMIC_RELAXED, __HIP_MEMORY_SCOPE_AGENT));
                      const float kn2 = __uint_as_float(__hip_atomic_load(nk, __ATOMIC_RELAXED, __HIP_MEMORY_SCOPE_AGENT)) + __uint_as_float(__hip_atomic_load(nk + 1, __ATOMIC_RELAXED, __HIP_MEMORY_SCOPE_AGENT));
                      const float thr = 2.f * 1.02f * sqrtf(qn2 * kn2) + 160.f;
                      const float* cum = (const float*)(wsptr(P) + WS_SMALL + SM_CUM) + (size_t)bh * SEQ; const float ci = cum[qb * 256];
                      const int ln = lane_id(); int cnt = 0;
#pragma unroll
                      for (int k2 = 0; k2 < 2; ++k2) { const int J = ln + 64 * k2; const bool sk = (J < 4 * qb) && (cum[(J < 128 ? J : 127) * 64 + 63] - ci > thr); cnt += __popcll(__ballot(sk)); }
                      t0 = __builtin_amdgcn_readfirstlane(cnt) & ~1; }
                    fa::attn_unit<8>(bh >> 2, bh & 3, qb, t0, PROJ + 1280, PROJ + 1536, PROJ + 1792, CBp, YS + 768, (char*)lds_raw, wave);
                }
                else if (it < NCV + 384) sg_unit(P, lds, l, it - NCV - 256, wave);
                else if (it < NCV + 640) conv_unit(P, lds, l, it - NCV - 384, wave);
                else pool_unit(P, lds, l, it - NCV - 640, wave);
            }
            }
            if (BOTH(pb + 2)) SEAM();
        }
        if (KIND(4) && IN(pb + 3)) { SOPQ(bid); SOPQ(G); SOPQ(gw); SOPQ(NGW);
            pg8::Gemm g{YS, WB + WB_WBR, 1024, 256, 256, nullptr}; SchedG2 S{G, bid}; Epi2 E{(const unsigned char*)SG, MRG, {}};
            REP(4) pg8::gemm_phase<Epi2, SchedG2, false>(lds, g, S, E, wave);
            if (BOTH(pb + 3)) SEAM();
        }
        if (KIND(5) && IN(pb + 4)) { SOPQ(bid); SOPQ(G); SOPQ(gw); SOPQ(NGW);
            pg8::Gemm g{MRG, WB + WB_WOUT, 1024, 1024, 1024, nullptr}; SchedDense S{64, 4, G, bid, 1024, 1024}; Epi3 E{l == 0 ? inptr(I_X) : (const float*)nullptr, (bf16_t*)X, MOD + (size_t)l * 2 * 6144};
            for (int rep_ = 0; rep_ < ((DUPK == 5 && l == 0) ? 2 : 1); ++rep_) pg8::gemm_phase<Epi3, SchedDense, false>(lds, g, S, E, wave);
            if (BOTH(pb + 4)) SEAM();
        }
        if (KIND(6) && IN(pb + 5)) { SOPQ(bid); SOPQ(G); SOPQ(gw); SOPQ(NGW); if (DUPK == 6) { phase_token(P, lds, l, bid, G, wave, 2 + l); SEAM(); } phase_token(P, lds, l, bid, G, wave, l); if (BOTH(pb + 5)) SEAM(); }
        if (KIND(10) && IN(pb + 6)) { SOPQ(bid); SOPQ(G); SOPQ(gw); SOPQ(NGW);
            const int x = bid & 7, j = bid >> 3, per = (G - x + 7) >> 3;
            const int nt = moe_tile_list(P, lds, l, wave); const int U = nt * 2;
#if FP8_GA
            pg8::Gemm g{(const bf16_t*)(wsptr(P) + WS_HF8), WB, 512, 512, 512, (const int*)(wsptr(P) + WS_SMALL + SM_IDXP)};
#else
            pg8::Gemm g{H, WB, 1024, 1024, 1024, (const int*)(wsptr(P) + WS_SMALL + SM_IDXP)};
#endif
            SchedMoe<2, false> S{(LAS const i32x4*)(lds + TL_OFF), (int)((long)U * x / 8), (int)((long)U * (x + 1) / 8), per, j};
            EpiUp E{HID, (const float*)(wsptr(P) + WS_SMALL + SM_GWP)};
            REP(10) pg8::gemm_phase<EpiUp, SchedMoe<2, false>, true, FP8_GA != 0>(lds, g, S, E, wave);
            if (BOTH(pb + 6)) SEAM();
        }
        if (KIND(11) && IN(pb + 7)) { SOPQ(bid); SOPQ(G); SOPQ(gw); SOPQ(NGW);
            const int x = bid & 7, j = bid >> 3, per = (G - x + 7) >> 3;
            const int nt = moe_tile_list(P, lds, l, wave); const int U = nt * 4;
#if FP8_GB
            pg8::Gemm g{HID, WB, 128, 128, 128, nullptr};
#else
            pg8::Gemm g{HID, WB, 256, 256, 256, nullptr};
#endif
            SchedMoe<4, true> S{(LAS const i32x4*)(lds + TL_OFF), (int)((long)U * x / 8), (int)((long)U * (x + 1) / 8), per, j};
            EpiDown E{(unsigned char*)Y2, (float*)(wsptr(P) + WS_R1 + Y2SC_OFF)};
            REP(11) pg8::gemm_phase<EpiDown, SchedMoe<4, true>, false, FP8_GB != 0>(lds, g, S, E, wave);
            if (BOTH(pb + 7)) SEAM();
        }
    }
    if (KIND(12) && IN(N_PHASES - 1)) { REP(13) phase_norm1<2>(P, lds, NL, gw, NGW, wave); }
#undef IN
#undef BOTH
#undef SEAM
#undef WB
#undef X
#undef H
#undef YS
#undef MRG
#undef HID
#undef PROJ
#undef SG
#undef Y2
#undef MOD
}

extern "C" void kernel_launch(void* const* d_in, const int* in_sizes, int n_in, void* d_out, int out_size, void* d_ws, size_t ws_size, hipStream_t stream) {
    static int grid = 0;
    if (grid == 0) {
        if (n_in != 29 || out_size != M * D || ws_size < WS_END) { fprintf(stderr, "kernel_launch: unexpected shapes (n_in %d, out %d, ws %zu)\n", n_in, out_size, ws_size); grid = -1; return; }
        int dev = 0, cus = 0;
        if (hipGetDevice(&dev) != hipSuccess || hipDeviceGetAttribute(&cus, hipDeviceAttributeMultiprocessorCount, dev) != hipSuccess) { grid = -1; return; }
        if (hipFuncSetAttribute((const void*)fwd_kernel, hipFuncAttributeMaxDynamicSharedMemorySize, LDS_BYTES) != hipSuccess) { fprintf(stderr, "kernel_launch: hipFuncSetAttribute failed\n"); grid = -1; return; }
        int per_cu = 0;
        if (hipOccupancyMaxActiveBlocksPerMultiprocessor(&per_cu, (const void*)fwd_kernel, NTHREADS, LDS_BYTES) != hipSuccess || per_cu < 1) { fprintf(stderr, "kernel_launch: occupancy query says %d\n", per_cu); }
        (void)hipGetLastError();
        grid = cus;
    }
    if (grid < 0) return;
    (void)hipMemsetAsync((char*)d_ws + WS_CTL, 0, CTL_ZERO_BYTES, stream);
    Params p; memset(&p, 0, sizeof(p));
    for (int i = 0; i < 29; ++i) p.in[i] = (const float*)d_in[i];
    p.out = (float*)d_out; p.ws = (unsigned char*)d_ws;
#if MK_ONE_LAUNCH
    p.ph_lo = 0; p.ph_hi = N_PHASES;
    hipLaunchKernelGGL(fwd_kernel, dim3(grid), dim3(NTHREADS), LDS_BYTES, stream, p);
#else
    for (int k = 0; k < N_PHASES; ++k) { p.ph_lo = k; p.ph_hi = k + 1; hipLaunchKernelGGL(fwd_kernel, dim3(grid), dim3(NTHREADS), LDS_BYTES, stream, p); }
#endif
}
```

```cpp
#include <hip/hip_runtime.h>
#include <cstdio>
#include <cstdint>
#include <cstring>

#ifndef MK_ONE_LAUNCH
#define MK_ONE_LAUNCH 1
#endif

#ifndef FP8_G1
#define FP8_G1 1
#endif
#ifndef FP8_GB
#define FP8_GB 1
#endif
#ifndef FP8_GA
#define FP8_GA 1
#endif
#ifndef FP8_G2
#define FP8_G2 1
#endif
#ifndef FP8_G3
#define FP8_G3 1
#endif
#define LAS __attribute__((address_space(3)))
#define TIDX (g_wave * 64 + lane_id())
#define GAS __attribute__((address_space(1)))
typedef unsigned short bf16_t;
typedef short bf16x8 __attribute__((ext_vector_type(8)));
typedef float f32x4 __attribute__((ext_vector_type(4)));
typedef float f32x2 __attribute__((ext_vector_type(2)));
typedef unsigned u32x4 __attribute__((ext_vector_type(4)));
typedef unsigned u32x2 __attribute__((ext_vector_type(2)));
typedef int i32x4 __attribute__((ext_vector_type(4)));
typedef int i32x8 __attribute__((ext_vector_type(8)));

constexpr int NB = 2, SEQ = 8192, M = NB * SEQ, D = 1024, NL = 2;
constexpr int COLT = 6148;
constexpr int NE = 64, TOPK = 6, EFF = 256;
constexpr int NPAIR = M * TOPK;
constexpr float EPS = 1e-6f;
constexpr float LOG2E = 1.4426950408889634f;
constexpr float QSCALE = 0.125f * LOG2E;
constexpr int NWAVES = 8, NTHREADS = 512;

constexpr size_t MiB = 1u << 20;
constexpr size_t WS_CTL = 0;
constexpr size_t CTL_ZERO_BYTES = 1 * MiB;
constexpr size_t WS_SMALL = 1 * MiB;
constexpr size_t WS_WB = 24 * MiB;
constexpr size_t WS_X = 138 * MiB;
constexpr size_t WS_H = 202 * MiB;
constexpr size_t WS_YS = 234 * MiB;
constexpr size_t WS_MRG = 266 * MiB;
constexpr size_t WS_HID = 298 * MiB;
constexpr size_t WS_R1 = 354 * MiB;
constexpr size_t Y2SC_OFF = 112 * MiB;
constexpr size_t WS_HF8 = 546 * MiB;
constexpr size_t WS_END = 562 * MiB;
constexpr size_t WB_WIN = 0;
constexpr size_t WB_WBR = WB_WIN + (size_t)6144 * 1024;
constexpr size_t WB_WOUT = WB_WBR + (size_t)4 * 1024 * 256;
constexpr size_t WB_WR = WB_WOUT + (size_t)1024 * 1024;
constexpr size_t WB_W13 = WB_WR + (size_t)256 * 1024;
constexpr size_t WB_W2 = WB_W13 + (size_t)65 * 512 * 1024;
constexpr size_t WB_ELEMS = WB_W2 + (size_t)65 * 1024 * 256;
static_assert(WB_ELEMS * 2 <= 114 * MiB, "weights region");
constexpr size_t SM_MOD = 0;
constexpr size_t SM_LOGF = 128 * 1024;
constexpr size_t SM_CUM = SM_LOGF + (size_t)M * 16;
constexpr size_t SM_CB = SM_CUM + (size_t)8 * SEQ * 4;
constexpr int CAP = 16384;
constexpr size_t SM_TE = SM_CB + (size_t)8 * SEQ * 32;
constexpr size_t SM_TP = SM_TE + (size_t)NPAIR * 4;
constexpr size_t SM_IDXP = SM_TP + (size_t)NPAIR * 4;
constexpr size_t SM_GWP = SM_IDXP + (size_t)65 * CAP * 4;
constexpr size_t SM_SGWM = SM_GWP + (size_t)64 * CAP * 4;
constexpr size_t SM_PWT = SM_SGWM + (size_t)4 * 128 * 128 * 2;
constexpr size_t SM_END = SM_PWT + (size_t)4 * 64 * 64 * 2;
static_assert(SM_END <= 23 * MiB, "small region");
constexpr int CW_BAR = 4096;
constexpr int CW_CNT = 16384;
constexpr int CW_Q = 16384 + 256;
constexpr int CW_QS = 16384 + 4096;
constexpr int CW_TD = 32768;
constexpr int CW_NRM = 16384 + 512;

constexpr int RING_BYTES = 131072;
constexpr int LDSCTL_OFF = RING_BYTES;
constexpr int MISC_OFF = LDSCTL_OFF;
constexpr int TL_OFF = LDSCTL_OFF + 256;
constexpr int TLN_OFF = TL_OFF + 512 * 16;
constexpr int EOFF_OFF = TLN_OFF + 16;
constexpr int PTRS_OFF = EOFF_OFF + 3 * 64 * 4;
constexpr int LDS_BYTES = 147456;
static_assert(PTRS_OFF + 32 * 8 <= LDS_BYTES, "LDS map");

__device__ __forceinline__ int lane_id() { int r; asm volatile("v_mbcnt_lo_u32_b32 %0, -1, 0\n\tv_mbcnt_hi_u32_b32 %0, -1, %0" : "=v"(r)); return r; }
__device__ __forceinline__ int opaque(int v) { asm volatile("" : "+v"(v)); return v; }
#define LDS_WAIT() asm volatile("s_waitcnt lgkmcnt(0)" ::: "memory")
#define VM_WAIT() asm volatile("s_waitcnt vmcnt(0)" ::: "memory")
__device__ __forceinline__ unsigned cvt_pk_bf16(float lo, float hi) { unsigned r; asm volatile("v_cvt_pk_bf16_f32 %0, %1, %2" : "=v"(r) : "v"(lo), "v"(hi)); return r; }
__device__ __forceinline__ float bflo(unsigned w) { return __uint_as_float(w << 16); }
__device__ __forceinline__ float bfhi(unsigned w) { return __uint_as_float(w & 0xffff0000u); }
__device__ __forceinline__ float bf2f(bf16_t h) { return __uint_as_float((unsigned)h << 16); }
__device__ __forceinline__ bf16_t f2bf(float f) { return (bf16_t)(cvt_pk_bf16(f, 0.f) & 0xffffu); }
#define DPPI(old, src, ctrl, rm, bm) __builtin_amdgcn_update_dpp((int)(old), (int)(src), ctrl, rm, bm, false)
#define DPPF(old, src, ctrl, rm, bm) __builtin_bit_cast(float, __builtin_amdgcn_update_dpp(__builtin_bit_cast(int, (float)(old)), __builtin_bit_cast(int, (float)(src)), ctrl, rm, bm, false))
#define DPP_MAX(v, CTRL) asm("s_nop 1\n\tv_max_f32_dpp %0, %0, %0 " CTRL : "+v"(v))
__device__ __forceinline__ float wave_max_dpp(float v) {
    DPP_MAX(v, "row_shr:1 row_mask:0xf bank_mask:0xf"); DPP_MAX(v, "row_shr:2 row_mask:0xf bank_mask:0xf"); DPP_MAX(v, "row_shr:4 row_mask:0xf bank_mask:0xf"); DPP_MAX(v, "row_shr:8 row_mask:0xf bank_mask:0xf");
    DPP_MAX(v, "row_bcast:15 row_mask:0xa bank_mask:0xf"); DPP_MAX(v, "row_bcast:31 row_mask:0xc bank_mask:0xf");
    return __builtin_bit_cast(float, __builtin_amdgcn_readlane(__builtin_bit_cast(int, v), 63));
}
__device__ __forceinline__ float wave_sum_dpp(float v) {
    v += DPPF(0.f, v, 0x111, 0xf, 0xf); v += DPPF(0.f, v, 0x112, 0xf, 0xf); v += DPPF(0.f, v, 0x114, 0xf, 0xf); v += DPPF(0.f, v, 0x118, 0xf, 0xf);
    v += DPPF(0.f, v, 0x142, 0xa, 0xf); v += DPPF(0.f, v, 0x143, 0xc, 0xf);
    return __builtin_bit_cast(float, __builtin_amdgcn_readlane(__builtin_bit_cast(int, v), 63));
}
__device__ __forceinline__ float grp8_max_dpp(float v) { DPP_MAX(v, "quad_perm:[1,0,3,2] row_mask:0xf bank_mask:0xf"); DPP_MAX(v, "quad_perm:[2,3,0,1] row_mask:0xf bank_mask:0xf"); DPP_MAX(v, "row_half_mirror row_mask:0xf bank_mask:0xf"); return v; }
__device__ __forceinline__ int grp8_min_dpp(int v) { v = min(v, DPPI(v, v, 0xB1, 0xf, 0xf)); v = min(v, DPPI(v, v, 0x4E, 0xf, 0xf)); v = min(v, DPPI(v, v, 0x141, 0xf, 0xf)); return v; }
__device__ __forceinline__ float wave_sum(float v) { return wave_sum_dpp(v); }
__device__ __forceinline__ float fq_max(float m) {
    auto r = __builtin_amdgcn_permlane16_swap(__float_as_uint(m), __float_as_uint(m), false, false); m = fmaxf(__uint_as_float(r[0]), __uint_as_float(r[1]));
    auto r2 = __builtin_amdgcn_permlane32_swap(__float_as_uint(m), __float_as_uint(m), false, false); return fmaxf(__uint_as_float(r2[0]), __uint_as_float(r2[1])); }
__device__ __forceinline__ float fq_sum(float m) {
    auto r = __builtin_amdgcn_permlane16_swap(__float_as_uint(m), __float_as_uint(m), false, false); m = __uint_as_float(r[0]) + __uint_as_float(r[1]);
    auto r2 = __builtin_amdgcn_permlane32_swap(__float_as_uint(m), __float_as_uint(m), false, false); return __uint_as_float(r2[0]) + __uint_as_float(r2[1]); }
__device__ __forceinline__ float row16_max_dpp(float v) { v = grp8_max_dpp(v); DPP_MAX(v, "row_mirror row_mask:0xf bank_mask:0xf"); return v; }
__device__ __forceinline__ float wave_scan_dpp(float v) {
    v += DPPF(0.f, v, 0x111, 0xf, 0xf); v += DPPF(0.f, v, 0x112, 0xf, 0xf); v += DPPF(0.f, v, 0x114, 0xf, 0xf); v += DPPF(0.f, v, 0x118, 0xf, 0xf);
    v += DPPF(0.f, v, 0x142, 0xa, 0xf); v += DPPF(0.f, v, 0x143, 0xc, 0xf); return v; }
__device__ __forceinline__ float fexp2(float x) { return __builtin_amdgcn_exp2f(x); }
__device__ __forceinline__ float frcp(float x) { return __builtin_amdgcn_rcpf(x); }
__device__ __forceinline__ float sigmoidf_(float x) { return frcp(1.f + fexp2(-LOG2E * x)); }
__device__ __forceinline__ float siluf_(float x) { return x * sigmoidf_(x); }
__device__ __forceinline__ float gelu_tanh(float x) {
    const float u = x + 0.044715f * x * x * x;
    return x * frcp(1.f + fexp2(-2.f * 0.7978845608028654f * LOG2E * u));
}

namespace pg8 {
constexpr int BM = 256, BK = 64, HALF = 128, HTB = HALF * BK * 2, STAGE_BYTES = 8 * HTB, NXCD = 8, WGM = 8;
__host__ __device__ __forceinline__ int lds_byte(int r, int c) { const int st = (r >> 4) * 2 + (c >> 5), rr = r & 15, cc = c & 31, ob = rr * 64 + cc * 2; return st * 1024 + (ob ^ (((ob >> 9) & 1) << 5)); }
__host__ __device__ __forceinline__ void stage_rc(int b, int& R, int& C) { const int st = b / 1024, sb = b % 1024, swz = sb ^ (((sb >> 9) & 1) << 5); R = (st >> 1) * 16 + swz / 64; C = (st & 1) * 32 + (swz % 64) / 2; }
__host__ __device__ __forceinline__ int perm32(int rho) { const int n = rho >> 4, i = rho & 15; return 8 * (i >> 2) + 4 * n + (i & 3); }

struct Unit { int pm, pn; int a, b, c, e; size_t aoff, boff; };
struct Gemm { const bf16_t* A; const bf16_t* Bt; int lda, ldb, K; const int* idx; };

__device__ __forceinline__ bool static_tile(int i, int G, int c, int nM, int nN, int& pm, int& pn) {
    const int nwg = nM * nN; const long L = (long)i * G + c; if (L >= nwg) return false;
    int wgid = (int)L; { const int q = nwg / NXCD, r = nwg % NXCD, xcd = wgid % NXCD, off = wgid / NXCD; wgid = (xcd < r ? xcd * (q + 1) : r * (q + 1) + (xcd - r) * q) + off; }
    const int nig = WGM * nN, gid = wgid / nig, fm = gid * WGM, gsz = (nM - fm) < WGM ? (nM - fm) : WGM;
    pm = fm + ((wgid % nig) % gsz); pn = (wgid % nig) / gsz; return true;
}

template <class Epi, class Sched, bool GATHER = false, bool FP8 = false>
__device__ __forceinline__ void gemm_phase(LAS unsigned char* lds, const Gemm g, const Sched& S, const Epi& E, const int g_wave) {
    const int tid = TIDX, wid = __builtin_amdgcn_readfirstlane(tid >> 6), lane = tid & 63, wr = wid >> 2, wc = wid & 3, fr = lane & 15, fq = lane >> 4;
    constexpr int NBJ = Epi::NBJ;
    const int K = g.K, nt = K / BK;
    unsigned voffA[2], voffB[2];
#pragma unroll
    for (int i = 0; i < 2; ++i) { int R, C; stage_rc(tid * 16 + i * 8192, R, C); const int Rb = Epi::PERM ? ((R & ~31) + perm32(R & 31)) : R;
        voffA[i] = (unsigned)(R * g.lda + C) * 2u; voffB[i] = (unsigned)(Rb * g.ldb + C) * 2u; }
    const size_t kstep = (size_t)(BK * 2);
    const size_t hstepA = GATHER ? 0 : (size_t)HALF * g.lda * 2, hstepB = (size_t)HALF * g.ldb * 2;
    const unsigned ldsw = (unsigned)wid * 1024u;
    const int aoff = lds_byte(wr * 64 + fr, fq * 8), boff = lds_byte(wc * 32 + fr, fq * 8);
    unsigned vC[2], vN[2];
#define PG8_SA(b, h) (((b) * 2 + (h)) * HTB)
#define PG8_SB(b, h) ((4 + (b) * 2 + (h)) * HTB)
#define PG8_STAGE(bufoff, gbase, voff) do { _Pragma("unroll") for (int _i = 0; _i < 2; ++_i) { unsigned _vo = (voff)[_i]; asm volatile("" : "+v"(_vo)); \
        __builtin_amdgcn_global_load_lds((const unsigned*)((const char*)(gbase) + _vo), (LAS unsigned*)(lds + (bufoff) + ldsw + _i * 8192), 16, 0, 0); } } while (0)
#define PG8_STAGEA(bufoff, p, h, nx) do { if constexpr (GATHER) { const unsigned _pk = (nx) ? vN[h] : vC[h]; unsigned _v[2]; int _R, _C; \
            stage_rc(tid * 16, _R, _C); _v[0] = ((_pk & 0xffffu) * (unsigned)g.lda + (unsigned)_C) * 2u; stage_rc(tid * 16 + 8192, _R, _C); _v[1] = ((_pk >> 16) * (unsigned)g.lda + (unsigned)_C) * 2u; PG8_STAGE(bufoff, p, _v); } \
        else { PG8_STAGE(bufoff, (p) + (h) * hstepA, voffA); } } while (0)
#define PG8_LD8(p) __builtin_shufflevector(*(const LAS i32x4*)(p), *(const LAS i32x4*)((p) + 1024), 0, 1, 2, 3, 4, 5, 6, 7)
#define PG8_LDA(dst, b, h) do { _Pragma("unroll") for (int m = 0; m < 4; ++m) dst[m] = PG8_LD8(lds + PG8_SA(b, h) + aoff + m * 2048); } while (0)
#define PG8_LDB(dst, b, h) do { _Pragma("unroll") for (int n = 0; n < 2; ++n) dst[n] = PG8_LD8(lds + PG8_SB(b, h) + boff + n * 2048); } while (0)
#define PG8_HALF(F, k) __builtin_bit_cast(bf16x8, __builtin_shufflevector(F, F, 4 * (k), 4 * (k) + 1, 4 * (k) + 2, 4 * (k) + 3))
#define PG8_MMA(ai, bj, At, Bt) do { __builtin_amdgcn_s_setprio(1); _Pragma("unroll") for (int m = 0; m < 4; ++m) _Pragma("unroll") for (int n = 0; n < 2; ++n) { \
        if constexpr (FP8) asm("v_mfma_f32_16x16x128_f8f6f4 %0, %1, %2, %0" : "+v"(acc[ai][bj][m][n]) : "v"(Bt[n]), "v"(At[m])); \
        else { acc[ai][bj][m][n] = __builtin_amdgcn_mfma_f32_16x16x32_bf16(PG8_HALF(Bt[n], 0), PG8_HALF(At[m], 0), acc[ai][bj][m][n], 0, 0, 0); \
               acc[ai][bj][m][n] = __builtin_amdgcn_mfma_f32_16x16x32_bf16(PG8_HALF(Bt[n], 1), PG8_HALF(At[m], 1), acc[ai][bj][m][n], 0, 0, 0); } } \
        __builtin_amdgcn_s_setprio(0); } while (0)
#define PG8_WAIT_V(n) asm volatile("s_waitcnt vmcnt(" #n ")" ::: "memory")
#define PG8_WAIT_L(n) asm volatile("s_waitcnt lgkmcnt(" #n ")" ::: "memory")
#define PG8_BAR __builtin_amdgcn_s_barrier()
#define PG8_SCHED __builtin_amdgcn_sched_barrier(0)
#define PG8_GLOAD(dst, U) do { _Pragma("unroll") for (int _h = 0; _h < 2; ++_h) { unsigned _pk = 0u; _Pragma("unroll") for (int _i = 0; _i < 2; ++_i) { int _R, _C; stage_rc(tid * 16 + _i * 8192, _R, _C); \
        const int _r = _h * HALF + _R; int _row = g.idx[(U).c + _r]; _row = (_r < (U).b) ? _row : 0; _pk |= (unsigned)_row << (16 * _i); } dst[_h] = _pk; } } while (0)
    Unit cur, nxt; int ui = 0;
    if (!S.next(0, cur)) return;
    f32x4 acc[2][2][4][2];
#pragma unroll
    for (int a = 0; a < 2; ++a)
#pragma unroll
        for (int b = 0; b < 2; ++b)
#pragma unroll
            for (int m = 0; m < 4; ++m)
#pragma unroll
                for (int n = 0; n < 2; ++n) acc[a][b][m][n] = (f32x4){0.f, 0.f, 0.f, 0.f};
    i32x8 At[4], B0[2], B1[2];
    const char* cA = (const char*)g.A + cur.aoff; const char* cB = (const char*)g.Bt + cur.boff;
    if constexpr (GATHER) { PG8_GLOAD(vC, cur); PG8_GLOAD(vN, cur); }
    PG8_STAGE(PG8_SB(0, 0), cB, voffB); if constexpr (NBJ == 2) PG8_STAGE(PG8_SB(0, 1), cB + hstepB, voffB); PG8_STAGEA(PG8_SA(0, 0), cA, 0, false); PG8_STAGEA(PG8_SA(0, 1), cA, 1, false);
    if (wr == 1) PG8_BAR;
    PG8_WAIT_V(2); PG8_BAR;
    PG8_STAGE(PG8_SB(1, 0), cB + kstep, voffB); PG8_STAGEA(PG8_SA(1, 0), cA + kstep, 0, false); if constexpr (NBJ == 2) PG8_STAGE(PG8_SB(1, 1), cB + hstepB + kstep, voffB);
    if constexpr (NBJ == 2) PG8_WAIT_V(6); else PG8_WAIT_V(4);
    PG8_BAR;
    for (;;) {
        const bool has_next = S.next(ui + 1, nxt);
        const char* nA = has_next ? (const char*)g.A + nxt.aoff : cA; const char* nB = has_next ? (const char*)g.Bt + nxt.boff : cB;
        if constexpr (GATHER) { if (has_next) { PG8_GLOAD(vN, nxt); } else { vN[0] = vC[0]; vN[1] = vC[1]; }
            asm volatile("s_waitcnt vmcnt(0)" : "+v"(vN[0]), "+v"(vN[1]) :: "memory"); }
#pragma unroll 1
        for (int t = 0; t < nt; t += 2) {
            const bool last = (t == nt - 2);
            const char* a1 = cA + (size_t)(t + 1) * kstep;
            const char* a2 = last ? nA : cA + (size_t)(t + 2) * kstep; const char* b2 = last ? nB : cB + (size_t)(t + 2) * kstep;
            const char* a3 = a2 + kstep; const char* b3 = b2 + kstep;
#define PG8_WAIT_K() do { if constexpr (NBJ == 2) PG8_WAIT_V(8); else PG8_WAIT_V(6); } while (0)
            PG8_LDB(B0, 0, 0); if constexpr (NBJ == 2) PG8_LDB(B1, 0, 1); PG8_SCHED; PG8_LDA(At, 0, 0); PG8_STAGEA(PG8_SA(1, 1), a1, 1, false);
            PG8_WAIT_K(); PG8_WAIT_L(0); PG8_BAR; PG8_MMA(0, 0, At, B0); if constexpr (NBJ == 2) PG8_MMA(0, 1, At, B1); PG8_BAR; PG8_SCHED;
            PG8_LDA(At, 0, 1); PG8_STAGE(PG8_SB(0, 0), b2, voffB); if constexpr (NBJ == 2) PG8_STAGE(PG8_SB(0, 1), b2 + hstepB, voffB); PG8_STAGEA(PG8_SA(0, 0), a2, 0, last);
            PG8_WAIT_K(); PG8_WAIT_L(0); PG8_BAR; PG8_MMA(1, 0, At, B0); if constexpr (NBJ == 2) PG8_MMA(1, 1, At, B1); PG8_BAR; PG8_SCHED;
            PG8_LDB(B0, 1, 0); if constexpr (NBJ == 2) PG8_LDB(B1, 1, 1); PG8_SCHED; PG8_LDA(At, 1, 0); PG8_STAGEA(PG8_SA(0, 1), a2, 1, last);
            PG8_WAIT_K(); PG8_WAIT_L(0); PG8_BAR; PG8_MMA(0, 0, At, B0); if constexpr (NBJ == 2) PG8_MMA(0, 1, At, B1); PG8_BAR; PG8_SCHED;
            PG8_LDA(At, 1, 1); PG8_STAGE(PG8_SB(1, 0), b3, voffB); if constexpr (NBJ == 2) PG8_STAGE(PG8_SB(1, 1), b3 + hstepB, voffB); PG8_STAGEA(PG8_SA(1, 0), a3, 0, last);
            PG8_WAIT_K(); PG8_WAIT_L(0); PG8_BAR; PG8_MMA(1, 0, At, B0); if constexpr (NBJ == 2) PG8_MMA(1, 1, At, B1); PG8_BAR; PG8_SCHED;
#undef PG8_WAIT_K
        }
        if (wr == 0) PG8_BAR;
        if constexpr (FP8) asm volatile("s_nop 15\n\ts_nop 15" ::: "memory");
        E(acc, cur, wr, wc, fr, fq);
        if (!has_next) break;
#pragma unroll
        for (int a = 0; a < 2; ++a)
#pragma unroll
            for (int b = 0; b < 2; ++b)
#pragma unroll
                for (int m = 0; m < 4; ++m)
#pragma unroll
                    for (int n = 0; n < 2; ++n) acc[a][b][m][n] = (f32x4){0.f, 0.f, 0.f, 0.f};
        cur = nxt; cA = nA; cB = nB; ++ui;
        if constexpr (GATHER) { vC[0] = vN[0]; vC[1] = vN[1]; }
        if (wr == 1) PG8_BAR;
    }
    PG8_WAIT_V(0);
    PG8_BAR;
#undef PG8_SA
#undef PG8_SB
#undef PG8_STAGE
#undef PG8_STAGEA
#undef PG8_LDA
#undef PG8_LDB
#undef PG8_MMA
#undef PG8_HALF
#undef PG8_LD8
#undef PG8_WAIT_V
#undef PG8_WAIT_L
#undef PG8_BAR
#undef PG8_SCHED
#undef PG8_GLOAD
}
}

#define XB_TMO      128
#define XB_XCNT(j)  (256  + 64 * (j))
#define XB_XSUB(j)  (1280 + 64 * (j))
#define XB_XGEN(j)  (2304 + 64 * (j))
#define XB_TOP      3328
#define XB_TOPGEN   3392
#define XCD_BAR_WORDS 3456
#define XB_SPIN_CAP (1u << 18)
__device__ __forceinline__ unsigned xb_ld(unsigned* p)              { return __hip_atomic_load(p, __ATOMIC_RELAXED, __HIP_MEMORY_SCOPE_AGENT); }
__device__ __forceinline__ unsigned xb_add(unsigned* p, unsigned v) { return __hip_atomic_fetch_add(p, v, __ATOMIC_RELAXED, __HIP_MEMORY_SCOPE_AGENT); }
__device__ __forceinline__ unsigned xb_xcc_id() { return (unsigned)__builtin_amdgcn_s_getreg((3 << 11) | 20) & 0xFu; }
#define XB_SPIN(cond, bar) do { unsigned _sp = 0; while (cond) { __builtin_amdgcn_s_sleep(1); \
    if ((++_sp & 255u) == 0u) { if (xb_ld(&(bar)[XB_TMO])) break; if (_sp > XB_SPIN_CAP) { atomicAdd(&(bar)[XB_TMO], 1u); break; } } } } while (0)
struct XcdBarrier { unsigned* bar; unsigned x; volatile LAS unsigned* st; };
__device__ __forceinline__ XcdBarrier xcd_barrier_post(unsigned* bar, volatile LAS unsigned* st, const int g_wave) {
    XcdBarrier b; b.bar = bar; b.x = xb_xcc_id(); b.st = st;
    if (TIDX == 0) st[4] = xb_add(&bar[XB_XCNT(b.x)], 1u);
    return b;
}
__device__ __forceinline__ void xcd_barrier_complete(unsigned* bar, unsigned x, unsigned& nloc, unsigned& nx, unsigned& uni) {
    const unsigned G = gridDim.x * gridDim.y * gridDim.z;
    unsigned sum, cnt, mine, sp = 0u;
    for (;;) {
        sum = 0u; cnt = 0u; mine = 0u; uni = 0u;
#pragma unroll
        for (unsigned j = 0; j < 16; ++j) { const unsigned c = xb_ld(&bar[XB_XCNT(j)]); sum += c; cnt += (c > 0u) ? 1u : 0u; mine = (j == x) ? c : mine; uni += (j < 8u ? c == 32u : c == 0u) ? 1u : 0u; }
        if (sum == G) break;
        __builtin_amdgcn_s_sleep(1);
        if ((++sp & 255u) == 0u) { if (xb_ld(&bar[XB_TMO])) break; if (sp > XB_SPIN_CAP) { atomicAdd(&bar[XB_TMO], 1u); break; } }
    }
    nloc = mine > 0u ? mine : 1u; nx = cnt > 0u ? cnt : 1u;
}
__device__ __forceinline__ void xcd_barrier(const XcdBarrier& b, const int g_wave) {
    asm volatile("s_waitcnt vmcnt(0)" ::: "memory");
    __syncthreads();
    if (TIDX == 0) {
        unsigned* bar = b.bar;
        __builtin_amdgcn_s_waitcnt(0);
        unsigned nloc = b.st[0], nx = b.st[1];
        if (nloc == 0u) { unsigned uni; xcd_barrier_complete(bar, b.x, nloc, nx, uni); b.st[0] = nloc; b.st[1] = nx; b.st[3] = (uni == 16u) ? 1u : 0u; }
        const unsigned old = xb_add(&bar[XB_XSUB(b.x)], 1u);
        const unsigned gen = old / nloc;
        if (old + 1u == (gen + 1u) * nloc) {
            __builtin_amdgcn_fence(__ATOMIC_RELEASE, "agent");
            asm volatile("s_waitcnt vmcnt(0)" ::: "memory");
            const unsigned og = xb_add(&bar[XB_TOP], 1u);
            const unsigned tg = og / nx;
            if (og + 1u == (tg + 1u) * nx) xb_add(&bar[XB_TOPGEN], 1u);
            else XB_SPIN(xb_ld(&bar[XB_TOPGEN]) == tg, bar);
            __builtin_amdgcn_fence(__ATOMIC_ACQUIRE, "agent");
            xb_add(&bar[XB_XGEN(b.x)], 1u);
            asm volatile("s_waitcnt vmcnt(0)" ::: "memory");
        } else {
            XB_SPIN(xb_ld(&bar[XB_XGEN(b.x)]) == gen, bar);
            __builtin_amdgcn_fence(__ATOMIC_ACQUIRE, "agent");
            asm volatile("s_waitcnt vmcnt(0)" ::: "memory");
        }
    }
    __syncthreads();
}

struct Params { const float* in[29]; float* out; unsigned char* ws; int ph_lo, ph_hi; };
extern __shared__ __attribute__((aligned(16))) unsigned char lds_raw[];
__device__ __forceinline__ const float* inptr(int i) { u32x2 v = *(const LAS u32x2*)((LAS unsigned char*)lds_raw + PTRS_OFF + 8 * i); asm volatile("" : "+v"(v));
    GAS const float* gp = (GAS const float*)(((unsigned long long)(unsigned)__builtin_amdgcn_readfirstlane((int)v.y) << 32) | (unsigned long long)(unsigned)__builtin_amdgcn_readfirstlane((int)v.x));
    return (const float*)gp; }
__device__ __forceinline__ unsigned char* wsptr(const Params&) { return (unsigned char*)inptr(29); }
enum { I_X = 0, I_C, I_WIN, I_BF, I_POOLW, I_POOLS, I_SGLG, I_SGLB, I_SGW, I_SGB, I_CONVW, I_CONVB, I_CLG, I_CLB, I_WBR, I_WOUT, I_MNG, I_FNG, I_ADAW, I_ADAB,
       I_RW, I_RB, I_EW1, I_EW3, I_EW2, I_SW1, I_SW3, I_SW2, I_FING };

__device__ __forceinline__ void phase_ada(const Params& P, LAS unsigned char* lds, int bid, int G, const int g_wave) {
    const int tid = TIDX, lane = tid & 63, wave = tid >> 6, kq = lane >> 4, cq = lane & 15;
    LAS float* sc = (LAS float*)lds; LAS float* red = (LAS float*)(lds + 8192);
    const float* c = inptr(I_C); float* MOD = (float*)(wsptr(P) + WS_SMALL + SM_MOD);
    for (int i = tid; i < 2048; i += NTHREADS) { const float v = c[i]; sc[i] = v / (1.f + __expf(-v)); }
    __syncthreads();
    for (int ch = bid; ch < 192; ch += G) {
        const int l = ch / 96, n0 = (ch % 96) * 64;
        const float* W = inptr(I_ADAW) + (size_t)l * 1024 * 6144 + n0 + 4 * cq;
        f32x4 a0 = (f32x4){0.f, 0.f, 0.f, 0.f}, a1 = (f32x4){0.f, 0.f, 0.f, 0.f};
#pragma unroll
        for (int hf = 0; hf < 2; ++hf) {
            f32x4 w[16];
#pragma unroll
            for (int j = 0; j < 16; ++j) w[j] = __builtin_nontemporal_load((const f32x4*)(W + (size_t)(wave * 128 + (hf * 16 + j) * 4 + kq) * 6144));
#pragma unroll
            for (int j = 0; j < 16; ++j) { const int kk = wave * 128 + (hf * 16 + j) * 4 + kq; a0 += sc[kk] * w[j]; a1 += sc[1024 + kk] * w[j]; }
        }
#pragma unroll
        for (int i = 0; i < 4; ++i) { a0[i] = fq_sum(a0[i]); a1[i] = fq_sum(a1[i]); }
        if (kq == 0) { *(LAS f32x4*)(red + (wave * 2 + 0) * 64 + 4 * cq) = a0; *(LAS f32x4*)(red + (wave * 2 + 1) * 64 + 4 * cq) = a1; }
        __syncthreads();
        if (tid < 128) { const int b = tid >> 6; float s = 0.f;
#pragma unroll
            for (int w = 0; w < 8; ++w) s += red[(w * 2 + b) * 64 + lane];
            MOD[(size_t)(l * 2 + b) * 6144 + n0 + lane] = s + inptr(I_ADAB)[l * 6144 + n0 + lane]; }
        __syncthreads();
    }
}

__device__ __forceinline__ float clamp448(float x) { return __builtin_amdgcn_fmed3f(x, -448.f, 448.f); }
__device__ __forceinline__ unsigned pk4_fp8(float a, float b, float c, float d) { a = clamp448(a); b = clamp448(b); c = clamp448(c); d = clamp448(d); int w = __builtin_amdgcn_cvt_pk_fp8_f32(a, b, 0, false); w = __builtin_amdgcn_cvt_pk_fp8_f32(c, d, w, true); return (unsigned)w; }
constexpr float YSC = 8.f;
__device__ __forceinline__ u32x2 bf8_to_fp8(u32x4 v, float sc) { u32x2 w; w.x = pk4_fp8(bflo(v.x) * sc, bfhi(v.x) * sc, bflo(v.y) * sc, bfhi(v.y) * sc); w.y = pk4_fp8(bflo(v.z) * sc, bfhi(v.z) * sc, bflo(v.w) * sc, bfhi(v.w) * sc); return w; }
__device__ __forceinline__ void st16_wt(void* p, u32x4 v) { asm volatile("global_store_dwordx4 %0, %1, off sc1\n\ts_nop 1" :: "v"(p), "v"(v) : "memory"); }
__device__ __forceinline__ void tr4x4(unsigned& r0, unsigned& r1, unsigned& r2, unsigned& r3) {
    auto a = __builtin_amdgcn_permlane32_swap(r0, r2, false, false); r0 = a[0]; r2 = a[1];
    auto b = __builtin_amdgcn_permlane32_swap(r1, r3, false, false); r1 = b[0]; r3 = b[1];
    auto c = __builtin_amdgcn_permlane16_swap(r0, r1, false, false); r0 = c[0]; r1 = c[1];
    auto d = __builtin_amdgcn_permlane16_swap(r2, r3, false, false); r2 = d[0]; r3 = d[1];
}
__device__ __forceinline__ void cvt_item_fp8(const float* __restrict__ src, int ldw, unsigned char* __restrict__ dst, int ldd, float scale, LAS unsigned* T, int lane) {
    const int kp = lane >> 4, ng = lane & 15;
    f32x4 v[16];
#pragma unroll
    for (int j = 0; j < 4; ++j)
#pragma unroll
        for (int h = 0; h < 4; ++h) v[4 * j + h] = __builtin_nontemporal_load((const f32x4*)(src + (size_t)(16 * j + 4 * kp + h) * ldw + 4 * ng));
#pragma unroll
    for (int i = 0; i < 4; ++i) { unsigned r[4];
#pragma unroll
        for (int j = 0; j < 4; ++j) r[j] = pk4_fp8(v[4 * j][i] * scale, v[4 * j + 1][i] * scale, v[4 * j + 2][i] * scale, v[4 * j + 3][i] * scale);
        tr4x4(r[0], r[1], r[2], r[3]);
        st16_wt(dst + (size_t)(4 * ng + i) * ldd + 16 * kp, (u32x4){r[0], r[1], r[2], r[3]}); }
}
__device__ __forceinline__ void cvt_item(const float* __restrict__ src, int ldw, bf16_t* __restrict__ dst, int ldd, LAS unsigned* T, int lane) {
    const int kp = lane >> 4, ng = lane & 15;
    f32x4 v[16];
#pragma unroll
    for (int j = 0; j < 8; ++j)
#pragma unroll
        for (int h = 0; h < 2; ++h) v[2 * j + h] = __builtin_nontemporal_load((const f32x4*)(src + (size_t)(8 * j + 2 * kp + h) * ldw + 4 * ng));
#pragma unroll
    for (int j = 0; j < 8; ++j)
#pragma unroll
        for (int i = 0; i < 4; ++i) T[(4 * ng + i) * 33 + 4 * j + kp] = cvt_pk_bf16(v[2 * j][i], v[2 * j + 1][i]);
    LDS_WAIT();
#pragma unroll 8
    for (int s = 0; s < 32; ++s) { const int n = 2 * s + (lane >> 5), kd = lane & 31; ((unsigned*)(dst + (size_t)n * ldd))[kd] = T[n * 33 + kd]; }
    LDS_WAIT();
}
constexpr int CVT_EARLY = 512 + 1024 + 256 + 256, CVT_ALL = CVT_EARLY + 3 * 65 * 64;
template <bool SMALLS>
__device__ __forceinline__ void phase_convert(const Params& P, LAS unsigned char* lds, int l, int gw, int NGW, const int g_wave, int it0, int it1) {
    const int tid_ = TIDX, lane = tid_ & 63, wave = tid_ >> 6;
    LAS unsigned* T = (LAS unsigned*)(lds + wave * 8448);
    bf16_t* WB = (bf16_t*)(wsptr(P) + WS_WB);
    constexpr int C0 = 512, C1 = 1024, C2 = 256, C3 = 256, C4 = 0, C5 = 65 * 64, C6 = 65 * 64, C7 = 65 * 64;
    constexpr int NITEMS = C0 + C1 + C2 + C3 + C4 + C5 + C6 + C7;
    for (int it = it0 + gw; it < it1; it += NGW) {
        int r = it;
#if FP8_G1
        if (r < C0) { const int nb = r & 31, kb = r >> 5; cvt_item_fp8(inptr(I_WIN) + (size_t)l * 1024 * COLT + (size_t)kb * 64 * COLT + 64 * nb, COLT, (unsigned char*)(WB + WB_WIN) + (size_t)(64 * nb) * 1024 + kb * 64, 1024, 64.f, T, lane); continue; } r -= C0;
        if (r < C1) { const int nb = r & 63, kb = r >> 6; cvt_item_fp8(inptr(I_WIN) + (size_t)l * 1024 * COLT + (size_t)kb * 64 * COLT + 2052 + 64 * nb, COLT, (unsigned char*)(WB + WB_WIN) + (size_t)(2048 + 64 * nb) * 1024 + kb * 64, 1024, 64.f, T, lane); continue; } r -= C1;
#else
        if (r < C0) { const int nb = r & 31, kb = r >> 5; cvt_item(inptr(I_WIN) + (size_t)l * 1024 * COLT + (size_t)kb * 64 * COLT + 64 * nb, COLT, WB + WB_WIN + (size_t)(64 * nb) * 1024 + kb * 64, 1024, T, lane); continue; } r -= C0;
        if (r < C1) { const int nb = r & 63, kb = r >> 6; cvt_item(inptr(I_WIN) + (size_t)l * 1024 * COLT + (size_t)kb * 64 * COLT + 2052 + 64 * nb, COLT, WB + WB_WIN + (size_t)(2048 + 64 * nb) * 1024 + kb * 64, 1024, T, lane); continue; } r -= C1;
#endif
#if FP8_G2
        if (r < C2) { const int nb = r & 15, kb = (r >> 4) & 3, n = r >> 6; cvt_item_fp8(inptr(I_WBR) + (size_t)(l * 4 + n) * 256 * 1024 + (size_t)kb * 64 * 1024 + 64 * nb, 1024, (unsigned char*)(WB + WB_WBR) + (size_t)(n * 1024 + 64 * nb) * 256 + kb * 64, 256, 64.f, T, lane); continue; } r -= C2;
#else
        if (r < C2) { const int nb = r & 15, kb = (r >> 4) & 3, n = r >> 6; cvt_item(inptr(I_WBR) + (size_t)(l * 4 + n) * 256 * 1024 + (size_t)kb * 64 * 1024 + 64 * nb, 1024, WB + WB_WBR + (size_t)(n * 1024 + 64 * nb) * 256 + kb * 64, 256, T, lane); continue; } r -= C2;
#endif
#if FP8_G3
        if (r < C3) { const int nb = r & 15, kb = r >> 4; cvt_item_fp8(inptr(I_WOUT) + (size_t)l * 1024 * 1024 + (size_t)kb * 64 * 1024 + 64 * nb, 1024, (unsigned char*)(WB + WB_WOUT) + (size_t)(64 * nb) * 1024 + kb * 64, 1024, 64.f, T, lane); continue; } r -= C3;
#else
        if (r < C3) { const int nb = r & 15, kb = r >> 4; cvt_item(inptr(I_WOUT) + (size_t)l * 1024 * 1024 + (size_t)kb * 64 * 1024 + 64 * nb, 1024, WB + WB_WOUT + (size_t)(64 * nb) * 1024 + kb * 64, 1024, T, lane); continue; } r -= C3;
#endif
        if (r < C5 + C6) { const int w3 = r >= C5; if (w3) r -= C5; const int nb = r & 3, kb = (r >> 2) & 15, e = r >> 6;
            const float* src = (e < 64) ? P.in[w3 ? I_EW3 : I_EW1] + ((size_t)(l * 64 + e)) * 1024 * 256 : P.in[w3 ? I_SW3 : I_SW1] + (size_t)l * 1024 * 256;
#if FP8_GA
            cvt_item_fp8(src + (size_t)kb * 64 * 256 + 64 * nb, 256, (unsigned char*)(WB + WB_W13) + ((size_t)e * 512 + (nb >> 1) * 256 + w3 * 128 + (nb & 1) * 64) * 1024 + kb * 64, 1024, 64.f, T, lane); continue; } r -= C5 + C6;
#else
            cvt_item(src + (size_t)kb * 64 * 256 + 64 * nb, 256, WB + WB_W13 + ((size_t)e * 512 + (nb >> 1) * 256 + w3 * 128 + (nb & 1) * 64) * 1024 + kb * 64, 1024, T, lane); continue; } r -= C5 + C6;
#endif
        { const int nb = r & 15, kb = (r >> 4) & 3, e = r >> 6;
            const float* src = (e < 64) ? inptr(I_EW2) + ((size_t)(l * 64 + e)) * 256 * 1024 : inptr(I_SW2) + (size_t)l * 256 * 1024;
#if FP8_GB
            cvt_item_fp8(src + (size_t)kb * 64 * 1024 + 64 * nb, 1024, (unsigned char*)(WB + WB_W2) + ((size_t)e * 1024 + 64 * nb) * 256 + kb * 64, 256, 64.f, T, lane); }
#else
            cvt_item(src + (size_t)kb * 64 * 1024 + 64 * nb, 1024, WB + WB_W2 + ((size_t)e * 1024 + 64 * nb) * 256 + kb * 64, 256, T, lane); }
#endif
    }
    if (SMALLS) {
    for (int gt = gw * 64 + lane; gt < 8192 + 16384 + 65536 + 16384; gt += NGW * 64) {
    if (gt < 8192) { const int i = gt;
      bf16_t* SGWM = (bf16_t*)(wsptr(P) + WS_SMALL + SM_SGWM); const float* sgw = inptr(I_SGW) + (size_t)l * 4 * 128 * 128;
      { const int e0 = i * 8, t = (e0 >> 7) & 127, s0 = e0 & 127; const f32x4 a = *(const f32x4*)(sgw + e0), b = *(const f32x4*)(sgw + e0 + 4);
          u32x4 w; w.x = cvt_pk_bf16(s0 + 0 <= t ? a[0] : 0.f, s0 + 1 <= t ? a[1] : 0.f); w.y = cvt_pk_bf16(s0 + 2 <= t ? a[2] : 0.f, s0 + 3 <= t ? a[3] : 0.f);
          w.z = cvt_pk_bf16(s0 + 4 <= t ? b[0] : 0.f, s0 + 5 <= t ? b[1] : 0.f); w.w = cvt_pk_bf16(s0 + 6 <= t ? b[2] : 0.f, s0 + 7 <= t ? b[3] : 0.f);
          *(u32x4*)(SGWM + e0) = w; } }
    else if (gt < 8192 + 16384) { const int i = gt - 8192;
      bf16_t* PWT = (bf16_t*)(wsptr(P) + WS_SMALL + SM_PWT); const float* pw = inptr(I_POOLW) + (size_t)l * 4 * 64 * 64;
      { const int g = i >> 12, d = (i >> 6) & 63, c = i & 63; PWT[i] = f2bf(pw[(g * 64 + c) * 64 + d]); } }
    else if (gt < 8192 + 16384 + 65536) { const int i = gt - (8192 + 16384); const float* rw = inptr(I_RW) + (size_t)l * 1024 * 64; bf16_t* WRT = WB + WB_WR;
      { const int k = i >> 6, e = i & 63; const float v = rw[i]; const bf16_t hi = f2bf(v); WRT[e * 1024 + k] = hi; WRT[65536 + e * 1024 + k] = f2bf(v - bf2f(hi)); } }
    else { const int i = gt - (8192 + 16384 + 65536);
      int* IDXP = (int*)(wsptr(P) + WS_SMALL + SM_IDXP) + 64 * CAP; IDXP[i] = i; }
    }
    }
}

__device__ __forceinline__ void moe_offsets(const Params& P, LAS unsigned char* lds, int l, const int g_wave) {
    LAS int* eo = (LAS int*)(lds + EOFF_OFF);
    if (g_wave == 0) { const int e = lane_id(); const unsigned* CNT = (const unsigned*)(wsptr(P) + WS_CTL) + CW_CNT + l * 64;
        const int n = (int)__hip_atomic_load(CNT + e, __ATOMIC_RELAXED, __HIP_MEMORY_SCOPE_AGENT), nt = (n + 255) >> 8;
        const float so = wave_scan_dpp((float)n), st = wave_scan_dpp((float)nt);
        eo[e] = (int)so - n; eo[64 + e] = (int)st - nt; eo[128 + e] = n; }
    __syncthreads();
}
template <int MODE>
__device__ __forceinline__ void phase_norm1(const Params& P, LAS unsigned char* lds, int l, int gw, int NGW, const int g_wave, const f32x4 wfr0 = (f32x4){0.f, 0.f, 0.f, 0.f}, const f32x4 wfr1 = (f32x4){0.f, 0.f, 0.f, 0.f}) {
    const int tid = TIDX, lane = tid & 63;
    const float* MOD = (const float*)(wsptr(P) + WS_SMALL + SM_MOD);
    bf16_t* XB = (bf16_t*)(wsptr(P) + WS_X); bf16_t* H = (bf16_t*)(wsptr(P) + WS_H);
    LAS f32x4* wf = (LAS f32x4*)lds;
    if (MODE != 2) {
        wf[tid] = wfr0; wf[tid + NTHREADS] = wfr1;
        __syncthreads();
    }
    if (MODE != 0) moe_offsets(P, lds, l - 1, g_wave);
    const int* TE = (const int*)(wsptr(P) + WS_SMALL + SM_TE); const int* TP = (const int*)(wsptr(P) + WS_SMALL + SM_TP); const bf16_t* Y2 = (const bf16_t*)(wsptr(P) + WS_R1);
    LAS const int* eo = (LAS const int*)(lds + EOFF_OFF);
    const float* Y2S = (const float*)(wsptr(P) + WS_R1 + Y2SC_OFF);
    float* LOGF = (float*)(wsptr(P) + WS_SMALL + SM_LOGF);
    for (int b = 0; b < NB; ++b) {
    f32x4 mA[4], mB[4], mG[4];
#pragma unroll
    for (int j = 0; j < 4; ++j) { const int d0 = 256 * j + 4 * lane;
        if (MODE == 2) { mA[j] = *(const f32x4*)(inptr(I_FING) + d0); mB[j] = (f32x4){0.f, 0.f, 0.f, 0.f}; }
        else { const float* md = MOD + (size_t)(l * 2 + b) * 6144; mA[j] = *(const f32x4*)(inptr(I_MNG) + l * D + d0) * (*(const f32x4*)(md + 1024 + d0) + 1.0f); mB[j] = *(const f32x4*)(md + d0); }
        mG[j] = (MODE != 0) ? *(const f32x4*)(MOD + (size_t)((l - 1) * 2 + b) * 6144 + 5 * 1024 + d0) : (f32x4){0.f, 0.f, 0.f, 0.f}; }
    const float bf0 = (MODE != 2) ? inptr(I_BF)[l * 4 + 0] : 0.f, bf1 = (MODE != 2) ? inptr(I_BF)[l * 4 + 1] : 0.f, bf2 = (MODE != 2) ? inptr(I_BF)[l * 4 + 2] : 0.f, bf3 = (MODE != 2) ? inptr(I_BF)[l * 4 + 3] : 0.f;
    for (int row = b * SEQ + ((gw - b * SEQ) % NGW + NGW) % NGW; row < (b + 1) * SEQ; row += NGW) {
        f32x4 v[4];
        if (MODE == 0) {
#pragma unroll
            for (int j = 0; j < 4; ++j) v[j] = __builtin_nontemporal_load((const f32x4*)(inptr(I_X) + (size_t)row * D + 256 * j + 4 * lane));
        } else {
            f32x4 a[4];
#pragma unroll
            for (int j = 0; j < 4; ++j) { const u32x2 w = *(const u32x2*)(XB + (size_t)row * D + 256 * j + 4 * lane); v[j] = (f32x4){bflo(w.x), bfhi(w.x), bflo(w.y), bfhi(w.y)}; a[j] = (f32x4){0.f, 0.f, 0.f, 0.f}; }
#pragma unroll
            for (int k = 0; k <= TOPK; ++k) { const int slot = (k < TOPK) ? eo[TE[row * TOPK + (k < TOPK ? k : 0)]] + TP[row * TOPK + (k < TOPK ? k : 0)] : NPAIR + row;
#pragma unroll
                for (int j = 0; j < 4; ++j) { const unsigned w = *(const unsigned*)((const unsigned char*)Y2 + (size_t)slot * D + 256 * j + 4 * lane);
                    const float sc = Y2S[(size_t)slot * 32 + 8 * j + (lane >> 3)];
                    a[j][0] += ((float)(w & 255u) - 128.f) * sc; a[j][1] += ((float)((w >> 8) & 255u) - 128.f) * sc;
                    a[j][2] += ((float)((w >> 16) & 255u) - 128.f) * sc; a[j][3] += ((float)(w >> 24) - 128.f) * sc; } }
#pragma unroll
            for (int j = 0; j < 4; ++j) { v[j] = v[j] + mG[j] * a[j];
                if (MODE == 1) { u32x2 w; w.x = cvt_pk_bf16(v[j][0], v[j][1]); w.y = cvt_pk_bf16(v[j][2], v[j][3]); *(u32x2*)(XB + (size_t)row * D + 256 * j + 4 * lane) = w; } }
        }
        float ss = 0.f;
#pragma unroll
        for (int j = 0; j < 4; ++j) ss += (v[j][0] * v[j][0] + v[j][1] * v[j][1]) + (v[j][2] * v[j][2] + v[j][3] * v[j][3]);
        const float rms = 1.0f / sqrtf(wave_sum(ss) * (1.f / D) + EPS);
        if (MODE == 2) {
#pragma unroll
            for (int j = 0; j < 4; ++j) __builtin_nontemporal_store(v[j] * rms * mA[j], (f32x4*)(P.out + (size_t)row * D + 256 * j + 4 * lane));
        } else {
            float fl[4] = {0.f, 0.f, 0.f, 0.f};
#pragma unroll
            for (int j = 0; j < 4; ++j) { const int d0 = 256 * j + 4 * lane;
                const f32x4 h = v[j] * rms * mA[j] + mB[j];
#if FP8_G1
                *(unsigned*)((unsigned char*)(wsptr(P) + WS_HF8) + (size_t)row * D + d0) = pk4_fp8(h[0], h[1], h[2], h[3]);
#else
                u32x2 w; w.x = cvt_pk_bf16(h[0], h[1]); w.y = cvt_pk_bf16(h[2], h[3]); *(u32x2*)(H + (size_t)row * D + d0) = w;
#endif
#pragma unroll
                for (int i = 0; i < 4; ++i) { const f32x4 wv = wf[d0 + i]; fl[0] += h[i] * wv[0]; fl[1] += h[i] * wv[1]; fl[2] += h[i] * wv[2]; fl[3] += h[i] * wv[3]; } }
#pragma unroll
            for (int hh = 0; hh < 4; ++hh) fl[hh] = wave_sum(fl[hh]);
            if (lane == 0) { f32x4 o;
#pragma unroll
                for (int hh = 0; hh < 4; ++hh) { const float f = fl[hh] + (hh == 0 ? bf0 : hh == 1 ? bf1 : hh == 2 ? bf2 : bf3); o[hh] = fminf(f, 0.f) - log1pf(__expf(-fabsf(f))); }
                *(f32x4*)(LOGF + (size_t)row * 4) = o; }
        }
    }
    }
}
__device__ __forceinline__ void scan_logf(const Params& P, LAS unsigned char* lds, int vb, const int g_wave) {
    const int lane = lane_id(), seq = vb >> 5, seg = vb & 31, b = seq >> 2, hh = seq & 3;
    const float* LG = (const float*)(wsptr(P) + WS_SMALL + SM_LOGF) + (size_t)b * SEQ * 4 + hh;
    float* CUM = (float*)(wsptr(P) + WS_SMALL + SM_CUM); bf16_t* CB = (bf16_t*)(wsptr(P) + WS_SMALL + SM_CB);
    float acc = 0.f;
#pragma unroll 4
    for (int i = g_wave * 64 + lane; i < seg * 256; i += NTHREADS) acc += LG[(size_t)i * 4];
    const int pos = seg * 256 + (g_wave & 3) * 64 + lane;
    const float v = (g_wave < 4) ? LG[(size_t)pos * 4] : 0.f;
    const float sc = wave_scan_dpp(v);
    acc = wave_sum(acc);
    const float wt = __builtin_bit_cast(float, __builtin_amdgcn_readlane(__builtin_bit_cast(int, sc), 63));
    LAS float* sums = (LAS float*)lds;
    if (lane == 0) { sums[g_wave] = acc; sums[8 + g_wave] = wt; }
    __syncthreads();
    float carry = 0.f;
#pragma unroll
    for (int j = 0; j < 8; ++j) carry += sums[j];
#pragma unroll
    for (int j = 0; j < 3; ++j) carry += (j < g_wave) ? sums[8 + j] : 0.f;
    if (g_wave < 4) {
        const float cl = (carry + sc) * LOG2E;
        CUM[(size_t)seq * SEQ + pos] = cl;
        const float kb = -cl;
        const unsigned c1 = cvt_pk_bf16(kb, 0.f) & 0xffffu; const float r1 = kb - __uint_as_float(c1 << 16);
        const unsigned c2 = cvt_pk_bf16(r1, 0.f) & 0xffffu; const float r2 = r1 - __uint_as_float(c2 << 16);
        const unsigned c3 = cvt_pk_bf16(r2, 0.f) & 0xffffu;
        u32x4* cbp = (u32x4*)(CB + ((size_t)seq * SEQ + pos) * 16);
        const unsigned z_ = (unsigned)opaque(0), one_ = 0x3F80u + z_;
        cbp[0] = (u32x4){c1 | (c2 << 16), c3 | (one_ << 16), one_, z_}; cbp[1] = (u32x4){z_, z_, z_, z_};
    }
    __syncthreads();
}

typedef float f32x16 __attribute__((ext_vector_type(16)));
__device__ __forceinline__ void pool_unit(const Params& P, LAS unsigned char* lds, int l, int tile, const int g_wave) {
    const int tid = TIDX, lane = tid & 63, wave = __builtin_amdgcn_readfirstlane(tid >> 6);
    const bf16_t* PROJ = (const bf16_t*)(wsptr(P) + WS_R1); bf16_t* YS = (bf16_t*)(wsptr(P) + WS_YS);
    LAS bf16_t* zs = (LAS bf16_t*)lds;
    LAS bf16_t* pl = (LAS bf16_t*)(lds + 40960);
    LAS bf16_t* ob = (LAS bf16_t*)(lds + 75776);
    const int t0 = tile * 64, sp0 = t0 & (SEQ - 1);
#pragma unroll
    for (int i_ = 0; i_ < (79 * 32 + NTHREADS - 1) / NTHREADS; ++i_) { const int p = tid + i_ * NTHREADS; if (p >= 79 * 32) break; const int r = p >> 5, ch = p & 31; const int pos = sp0 - 15 + r;
        u32x4 v = (u32x4){0u, 0u, 0u, 0u};
        if (pos >= 0) v = *(const u32x4*)(PROJ + (size_t)(t0 - 15 + r) * 2048 + ch * 8);
        *(LAS u32x4*)(zs + r * 256 + ch * 8) = v; }
    __syncthreads();
    { const int c = tid & 255, half = tid >> 8, g = c >> 6, w = 2 << g;
      float run = 0.f;
      for (int j = 1; j < w; ++j) run += bf2f(zs[(half * 32 + 15 - j) * 256 + c]);
      const float invw = 1.0f / (float)w;
      if (sp0 == 0) {
      for (int i = 0; i < 32; ++i) { const int tt = half * 32 + i, pos = sp0 + tt; const float zc = bf2f(zs[(tt + 15) * 256 + c]);
          run += zc;
          const float mean = (pos + 1 < w) ? run / (float)(pos + 1) : run * invw;
          pl[tt * 264 + c] = f2bf(mean - zc);
          run -= bf2f(zs[(tt + 16 - w) * 256 + c]); }
      } else {
      for (int i = 0; i < 32; ++i) { const int tt = half * 32 + i; const float zc = bf2f(zs[(tt + 15) * 256 + c]);
          run += zc;
          pl[tt * 264 + c] = f2bf(run * invw - zc);
          run -= bf2f(zs[(tt + 16 - w) * 256 + c]); } } }
    __syncthreads();
    { const int g = wave >> 1, tb = wave & 1, r = lane & 31, h = lane >> 5;
      const bf16_t* PWT = (const bf16_t*)(wsptr(P) + WS_SMALL + SM_PWT);
#pragma unroll
      for (int dt = 0; dt < 2; ++dt) { f32x16 acc = {};
#pragma unroll
          for (int ks = 0; ks < 4; ++ks) { const bf16x8 af = *(const LAS bf16x8*)(pl + (32 * tb + r) * 264 + g * 64 + 16 * ks + 8 * h);
              const bf16x8 bf = *(const bf16x8*)(PWT + (size_t)(g * 64 + dt * 32 + r) * 64 + 16 * ks + 8 * h);
              acc = __builtin_amdgcn_mfma_f32_32x32x16_bf16(af, bf, acc, 0, 0, 0); }
          const int col = g * 64 + dt * 32 + r; const float scl = inptr(I_POOLS)[l * 256 + col];
#pragma unroll
          for (int q = 0; q < 16; ++q) { const int t = 32 * tb + (q & 3) + 8 * (q >> 2) + 4 * h; ob[t * 256 + col] = f2bf(acc[q] * scl); } } }
    __syncthreads();
#pragma unroll
    for (int i_ = 0; i_ < 64 * 32 / NTHREADS; ++i_) { const int p = tid + i_ * NTHREADS; const int t = p >> 5, ch = p & 31;
#if FP8_G2
        *(u32x2*)((unsigned char*)YS + (size_t)(t0 + t) * 1024 + ch * 8) = bf8_to_fp8(*(const LAS u32x4*)(ob + t * 256 + ch * 8), YSC); }
#else
        *(u32x4*)(YS + (size_t)(t0 + t) * 1024 + ch * 8) = *(const LAS u32x4*)(ob + t * 256 + ch * 8); }
#endif
    __syncthreads();
}

__device__ __forceinline__ void sg_unit(const Params& P, LAS unsigned char* lds, int l, int chunk, const int g_wave) {
    const int tid = TIDX, lane = tid & 63, wave = __builtin_amdgcn_readfirstlane(tid >> 6);
    const bf16_t* PROJ = (const bf16_t*)(wsptr(P) + WS_R1); bf16_t* YS = (bf16_t*)(wsptr(P) + WS_YS);
    LAS bf16_t* vn = (LAS bf16_t*)lds;
    LAS bf16_t* ob = (LAS bf16_t*)(lds + 65536);
    const int t0 = chunk * 128;
    {
      const int sidx = wave * 16 + (lane >> 2), pq = lane & 3;
      const bf16_t* src = PROJ + (size_t)(t0 + sidx) * 2048 + 512 + pq * 64;
      u32x4 raw[8];
#pragma unroll
      for (int k = 0; k < 8; ++k) raw[k] = *(const u32x4*)(src + 8 * k);
      float sum = 0.f;
#pragma unroll
      for (int k = 0; k < 8; ++k) sum += ((bflo(raw[k].x) + bfhi(raw[k].x)) + (bflo(raw[k].y) + bfhi(raw[k].y))) + ((bflo(raw[k].z) + bfhi(raw[k].z)) + (bflo(raw[k].w) + bfhi(raw[k].w)));
      sum += DPPF(0.f, sum, 0xB1, 0xf, 0xf); sum += DPPF(0.f, sum, 0x4E, 0xf, 0xf);
      const float mu = sum * (1.f / 256.f); float sq = 0.f;
#pragma unroll
      for (int k = 0; k < 8; ++k) { const float d0 = bflo(raw[k].x) - mu, d1 = bfhi(raw[k].x) - mu, d2 = bflo(raw[k].y) - mu, d3 = bfhi(raw[k].y) - mu, d4 = bflo(raw[k].z) - mu, d5 = bfhi(raw[k].z) - mu, d6 = bflo(raw[k].w) - mu, d7 = bfhi(raw[k].w) - mu;
          sq += ((d0 * d0 + d1 * d1) + (d2 * d2 + d3 * d3)) + ((d4 * d4 + d5 * d5) + (d6 * d6 + d7 * d7)); }
      sq += DPPF(0.f, sq, 0xB1, 0xf, 0xf); sq += DPPF(0.f, sq, 0x4E, 0xf, 0xf);
      const float rstd = 1.0f / sqrtf(sq * (1.f / 256.f) + EPS);
      const float* gp = inptr(I_SGLG) + l * 256 + pq * 64; const float* bp = inptr(I_SGLB) + l * 256 + pq * 64;
#pragma unroll
      for (int k0 = 0; k0 < 8; ++k0) { const int k = (k0 + lane) & 7;
          u32x4 rw = raw[0];
#pragma unroll
          for (int kk = 1; kk < 8; ++kk) rw = (k == kk) ? raw[kk] : rw;
          const f32x4 g0 = *(const f32x4*)(gp + 8 * k), g1 = *(const f32x4*)(gp + 8 * k + 4), b0 = *(const f32x4*)(bp + 8 * k), b1 = *(const f32x4*)(bp + 8 * k + 4);
          u32x4 o; o.x = cvt_pk_bf16((bflo(rw.x) - mu) * rstd * g0[0] + b0[0], (bfhi(rw.x) - mu) * rstd * g0[1] + b0[1]); o.y = cvt_pk_bf16((bflo(rw.y) - mu) * rstd * g0[2] + b0[2], (bfhi(rw.y) - mu) * rstd * g0[3] + b0[3]);
          o.z = cvt_pk_bf16((bflo(rw.z) - mu) * rstd * g1[0] + b1[0], (bfhi(rw.z) - mu) * rstd * g1[1] + b1[1]); o.w = cvt_pk_bf16((bflo(rw.w) - mu) * rstd * g1[2] + b1[2], (bfhi(rw.w) - mu) * rstd * g1[3] + b1[3]);
          *(LAS u32x4*)(vn + sidx * 256 + pq * 64 + 8 * k) = o; } }
    __syncthreads();
    { const int head = wave >> 1, c0 = head * 64 + (wave & 1) * 32, r = lane & 31, h = lane >> 5;
      const bf16_t* SGWM = (const bf16_t*)(wsptr(P) + WS_SMALL + SM_SGWM) + (size_t)head * 128 * 128;
      const float* sgb = inptr(I_SGB) + (l * 4 + head) * 128;
      bf16x8 bfr[8];
#pragma unroll
      for (int ks = 0; ks < 8; ++ks) { unsigned e[8];
#pragma unroll
          for (int j = 0; j < 8; ++j) e[j] = vn[(16 * ks + 8 * h + j) * 256 + c0 + r];
          u32x4 w; w.x = e[0] | (e[1] << 16); w.y = e[2] | (e[3] << 16); w.z = e[4] | (e[5] << 16); w.w = e[6] | (e[7] << 16); bfr[ks] = __builtin_bit_cast(bf16x8, w); }
      bf16x8 wfr[20]; float bias[4];
#pragma unroll
      for (int tb = 0; tb < 4; ++tb) { bias[tb] = sgb[32 * tb + r];
#pragma unroll
          for (int ks = 0; ks < 2 * tb + 2; ++ks) wfr[tb * (tb + 1) + ks] = *(const bf16x8*)(SGWM + (size_t)(32 * tb + r) * 128 + 16 * ks + 8 * h); }
#pragma unroll
      for (int tb = 0; tb < 4; ++tb) { f32x16 acc = {};
#pragma unroll
          for (int ks = 0; ks < 2 * tb + 2; ++ks) acc = __builtin_amdgcn_mfma_f32_32x32x16_bf16(bfr[ks], wfr[tb * (tb + 1) + ks], acc, 0, 0, 0);
          const int t = 32 * tb + r;
#pragma unroll
          for (int g4 = 0; g4 < 4; ++g4) { u32x2 o; o.x = cvt_pk_bf16(acc[4 * g4] + bias[tb], acc[4 * g4 + 1] + bias[tb]); o.y = cvt_pk_bf16(acc[4 * g4 + 2] + bias[tb], acc[4 * g4 + 3] + bias[tb]);
              *(LAS u32x2*)(ob + t * 256 + ((((c0 >> 3) + g4) ^ (t & 31)) << 3) + 4 * h) = o; } } }
    __syncthreads();
#pragma unroll
    for (int i_ = 0; i_ < 128 * 32 / NTHREADS; ++i_) { const int p = tid + i_ * NTHREADS; const int t = p >> 5, ch = p & 31;
        const u32x4 u = *(const u32x4*)(PROJ + (size_t)(t0 + t) * 2048 + 256 + ch * 8), sv = *(const LAS u32x4*)(ob + t * 256 + ((ch ^ (t & 31)) << 3));
#if FP8_G2
        u32x2 o; o.x = pk4_fp8(bflo(u.x) * bflo(sv.x) * YSC, bfhi(u.x) * bfhi(sv.x) * YSC, bflo(u.y) * bflo(sv.y) * YSC, bfhi(u.y) * bfhi(sv.y) * YSC);
        o.y = pk4_fp8(bflo(u.z) * bflo(sv.z) * YSC, bfhi(u.z) * bfhi(sv.z) * YSC, bflo(u.w) * bflo(sv.w) * YSC, bfhi(u.w) * bfhi(sv.w) * YSC);
        *(u32x2*)((unsigned char*)YS + (size_t)(t0 + t) * 1024 + 256 + ch * 8) = o; }
#else
        u32x4 o; o.x = cvt_pk_bf16(bflo(u.x) * bflo(sv.x), bfhi(u.x) * bfhi(sv.x)); o.y = cvt_pk_bf16(bflo(u.y) * bflo(sv.y), bfhi(u.y) * bfhi(sv.y));
        o.z = cvt_pk_bf16(bflo(u.z) * bflo(sv.z), bfhi(u.z) * bfhi(sv.z)); o.w = cvt_pk_bf16(bflo(u.w) * bflo(sv.w), bfhi(u.w) * bfhi(sv.w));
        *(u32x4*)(YS + (size_t)(t0 + t) * 1024 + 256 + ch * 8) = o; }
#endif
    __syncthreads();
}

__device__ __forceinline__ void conv_unit(const Params& P, LAS unsigned char* lds, int l, int tile, const int g_wave) {
    const int tid = TIDX, lane = tid & 63, wave = tid >> 6;
    const bf16_t* PROJ = (const bf16_t*)(wsptr(P) + WS_R1); bf16_t* YS = (bf16_t*)(wsptr(P) + WS_YS);
    LAS float* ys = (LAS float*)lds;
    const int t0 = tile * 64, sp0 = t0 & (SEQ - 1);
#pragma unroll
    for (int i_ = 0; i_ < (94 * 32 + NTHREADS - 1) / NTHREADS; ++i_) { const int p = tid + i_ * NTHREADS; if (p >= 94 * 32) break; const int r = p >> 5, ch = p & 31; const int pos = sp0 - 30 + r;
        f32x4 o0 = (f32x4){0.f, 0.f, 0.f, 0.f}, o1 = o0;
        if (pos >= 0) { const bf16_t* rp = PROJ + (size_t)(t0 - 30 + r) * 2048 + ch * 8;
            const u32x4 a = *(const u32x4*)(rp + 768), g = *(const u32x4*)(rp + 1024);
            o0 = (f32x4){bflo(a.x) * sigmoidf_(bflo(g.x)), bfhi(a.x) * sigmoidf_(bfhi(g.x)), bflo(a.y) * sigmoidf_(bflo(g.y)), bfhi(a.y) * sigmoidf_(bfhi(g.y))};
            o1 = (f32x4){bflo(a.z) * sigmoidf_(bflo(g.z)), bfhi(a.z) * sigmoidf_(bfhi(g.z)), bflo(a.w) * sigmoidf_(bflo(g.w)), bfhi(a.w) * sigmoidf_(bfhi(g.w))}; }
        *(LAS f32x4*)(ys + r * 256 + ch * 8) = o0; *(LAS f32x4*)(ys + r * 256 + ch * 8 + 4) = o1; }
    __syncthreads();
    f32x2 outv[16];
    { const int cp = tid & 127, qt = tid >> 7;
      f32x2 w[31], yv[46];
#pragma unroll
      for (int j = 0; j < 31; ++j) w[j] = *(const f32x2*)(inptr(I_CONVW) + (size_t)(l * 31 + j) * 256 + 2 * cp);
#pragma unroll
      for (int r = 0; r < 46; ++r) yv[r] = *(const LAS f32x2*)(ys + (qt * 16 + r) * 256 + 2 * cp);
      const f32x2 cb = *(const f32x2*)(inptr(I_CONVB) + l * 256 + 2 * cp);
#pragma unroll
      for (int i = 0; i < 16; ++i) { f32x2 a = cb;
#pragma unroll
          for (int j = 0; j < 31; ++j) a = w[j] * yv[i + j] + a;
          outv[i] = a; } }
    __syncthreads();
    { const int cp = tid & 127, qt = tid >> 7;
#pragma unroll
      for (int i = 0; i < 16; ++i) *(LAS f32x2*)(ys + (qt * 16 + i) * 256 + 2 * cp) = outv[i]; }
    __syncthreads();
    for (int i = 0; i < 8; ++i) { const int tt = wave * 8 + i; f32x4 x = *(const LAS f32x4*)(ys + tt * 256 + 4 * lane);
        const float mu = wave_sum((x[0] + x[1]) + (x[2] + x[3])) * (1.f / 256.f);
        x = x - mu;
        const float var = wave_sum((x[0] * x[0] + x[1] * x[1]) + (x[2] * x[2] + x[3] * x[3])) * (1.f / 256.f);
        const float rstd = 1.0f / sqrtf(var + EPS);
        const f32x4 g4 = *(const f32x4*)(inptr(I_CLG) + l * 256 + 4 * lane), b4 = *(const f32x4*)(inptr(I_CLB) + l * 256 + 4 * lane);
        const f32x4 y = x * rstd * g4 + b4;
#if FP8_G2
        *(unsigned*)((unsigned char*)YS + (size_t)(t0 + tt) * 1024 + 512 + 4 * lane) = pk4_fp8(siluf_(y[0]) * YSC, siluf_(y[1]) * YSC, siluf_(y[2]) * YSC, siluf_(y[3]) * YSC); }
#else
        u32x2 o; o.x = cvt_pk_bf16(siluf_(y[0]), siluf_(y[1])); o.y = cvt_pk_bf16(siluf_(y[2]), siluf_(y[3]));
        *(u32x2*)(YS + (size_t)(t0 + tt) * 1024 + 512 + 4 * lane) = o; }
#endif
    __syncthreads();
}

namespace fa {
using bf16x8=__attribute__((ext_vector_type(8)))short;
using s16x4=__attribute__((ext_vector_type(4)))short;
using f32x16=__attribute__((ext_vector_type(16)))float;
using u32x4=__attribute__((ext_vector_type(4)))unsigned;
constexpr int PQ=2048, PO=1024;
constexpr int NW=8,QBLK=32,QB=QBLK*NW,KVBLK=64;
__device__ __forceinline__ int crow(int r,int hi){return (r&3)+8*(r>>2)+4*hi;}
#define SBAR() __builtin_amdgcn_sched_barrier(0)
__device__ __forceinline__ void cmask(f32x16&p0,f32x16&p1,int jb,int qrel,int hi){
  const float NEG=-INFINITY; int kb=64*jb+4*hi;
  #pragma unroll
  for(int r=0;r<16;++r){int kv=kb+(r&3)+8*(r>>2); if(kv>qrel)p0[r]=NEG; if(kv+32>qrel)p1[r]=NEG;}
}
constexpr int NSLOT=3, SLOTB=8192;
constexpr int LDS_K=0, LDS_V=NSLOT*SLOTB, LDS_WS=2*NSLOT*SLOTB, LDS_OST=LDS_WS+NW*64*4, LDS_CB=LDS_OST+NW*4096, LDS_BYTES_=LDS_CB+NSLOT*2048;
__device__ __forceinline__ void glds16(const void*gsrc,unsigned lds_dst){unsigned keep;
  asm volatile("s_mov_b32 %0, m0\n\ts_mov_b32 m0, %2\n\ts_nop 0\n\tglobal_load_lds_dwordx4 %1, off\n\ts_mov_b32 m0, %0":"=&s"(keep):"v"(gsrc),"s"(lds_dst):"memory");}
__device__ __forceinline__ float max3f(float a,float b,float c){float r;asm("v_max3_f32 %0, %1, %2, %3":"=v"(r):"v"(a),"v"(b),"v"(c));return r;}
__device__ __forceinline__ float max2f(float a,float b){float r;asm("v_max_f32_e32 %0, %1, %2":"=v"(r):"v"(a),"v"(b));return r;}
__device__ __forceinline__ float fsub_s(float a,float b){float r;asm("v_sub_f32_e32 %0, %1, %2":"=v"(r):"v"(a),"v"(b));return r;}
typedef float f32x2_t __attribute__((ext_vector_type(2))); typedef __bf16 bf16x2_t __attribute__((ext_vector_type(2)));
__device__ __forceinline__ unsigned cvtpk_s(float lo,float hi){f32x2_t v={lo,hi};bf16x2_t b=__builtin_convertvector(v,bf16x2_t);return __builtin_bit_cast(unsigned,b);}
#define WAIT_BAR(N) asm volatile("s_waitcnt vmcnt(" #N ") lgkmcnt(0)\n\ts_barrier":::"memory")
typedef __attribute__((address_space(3))) const char* lds_cptr;
typedef short v4i16_t __attribute__((ext_vector_type(4)));
#define LDSB8(p) (*(const __attribute__((address_space(3))) bf16x8*)(p))
__device__ __forceinline__ void kload8(bf16x8*kf,lds_cptr kp){
  kf[0]=LDSB8(kp);      kf[1]=LDSB8(kp+512);  kf[2]=LDSB8(kp+2048); kf[3]=LDSB8(kp+2560);
  kf[4]=LDSB8(kp+4096); kf[5]=LDSB8(kp+4608); kf[6]=LDSB8(kp+6144); kf[7]=LDSB8(kp+6656);
}
__device__ __forceinline__ void kload2(bf16x8*kf,lds_cptr kp,int j){ kf[2*j]=LDSB8(kp+j*2048); kf[2*j+1]=LDSB8(kp+j*2048+512); }
__device__ __forceinline__ s16x4 vtr(lds_cptr p){ return __builtin_bit_cast(s16x4,__builtin_amdgcn_ds_read_tr16_b64_v4i16((__attribute__((address_space(3))) v4i16_t*)p)); }
__device__ __forceinline__ float rowmax(const f32x16&p0,const f32x16&p1){
  float a=max3f(p0[0],p0[1],p1[0]),b=max3f(p0[2],p0[3],p1[1]);a=max3f(a,p1[2],p1[3]);
  #pragma unroll
  for(int r=4;r<16;r+=4){a=max3f(a,p0[r],p0[r+1]);b=max3f(b,p0[r+2],p0[r+3]);a=max3f(a,p1[r],p1[r+1]);b=max3f(b,p1[r+2],p1[r+3]);}
  const float m=max2f(a,b);
  auto rr=__builtin_amdgcn_permlane32_swap(__float_as_uint(m),__float_as_uint(m),false,false);
  return max2f(__uint_as_float(rr[0]),__uint_as_float(rr[1]));
}
__device__ __forceinline__ void pv(f32x16*o,int vb,bf16x8 pa0,bf16x8 pa1,bf16x8 pa2,bf16x8 pa3){
  #pragma unroll
  for(int d0=0;d0<2;++d0){s16x4 lo[4],hi[4];
    #pragma unroll
    for(int ks=0;ks<4;++ks){
      asm volatile("ds_read_b64_tr_b16 %0,%1 offset:%c2":"=&v"(lo[ks]):"v"(vb),"i"(d0*4096+ks*1024):"memory");
      asm volatile("ds_read_b64_tr_b16 %0,%1 offset:%c2":"=&v"(hi[ks]):"v"(vb),"i"(d0*4096+ks*1024+512):"memory");}
    asm volatile("s_waitcnt lgkmcnt(0)":::"memory");SBAR();
    #define PK(k) (bf16x8){lo[k][0],lo[k][1],lo[k][2],lo[k][3],hi[k][0],hi[k][1],hi[k][2],hi[k][3]}
    o[d0]=__builtin_amdgcn_mfma_f32_32x32x16_bf16(pa0,PK(0),o[d0],0,0,0);
    o[d0]=__builtin_amdgcn_mfma_f32_32x32x16_bf16(pa1,PK(1),o[d0],0,0,0);
    o[d0]=__builtin_amdgcn_mfma_f32_32x32x16_bf16(pa2,PK(2),o[d0],0,0,0);
    o[d0]=__builtin_amdgcn_mfma_f32_32x32x16_bf16(pa3,PK(3),o[d0],0,0,0);
    #undef PK
  }
}
__device__ __forceinline__ float ref_split(float x,unsigned himask,unsigned&q1,unsigned&q2){
  const unsigned b1=cvtpk_s(x,0.f)&0xffffu; const float r1=__uint_as_float(b1<<16);
  const unsigned b2=cvtpk_s(x-r1,0.f)&0xffffu; const float r2=__uint_as_float(b2<<16);
  q1=(0x3F80u|((b1^0x8000u)<<16))&himask; q2=(b2^0x8000u)&himask; return r1+r2;
}
template<int THRL> __device__ __forceinline__ void attn_unit(int b,int h,int qb,int t0,const bf16_t*Q,const bf16_t*__restrict__ K,const bf16_t*__restrict__ V,const bf16_t*__restrict__ CB,bf16_t*O,char*shm,const int g_wave){
  const int tid=TIDX,lane=tid&63,r32=lane&31,hi=lane>>5; const int wid=__builtin_amdgcn_readfirstlane(tid>>6);
  const long rowbase=(long)b*SEQ; const int q0=qb*QB;
  const bf16_t*Qw=Q+(rowbase+q0+wid*QBLK)*PQ+h*64;
  const bf16_t*Kh=K+(rowbase+(long)t0*KVBLK)*PQ+h*64,*Vh=V+(rowbase+(long)t0*KVBLK)*PQ+h*64;
  const bf16_t*CBh=CB+((long)(b*4+h)*SEQ+(long)t0*KVBLK)*16;
  const unsigned lds0=(unsigned)(uintptr_t)shm;
  float*wsf=(float*)(shm+LDS_WS)+wid*64;
  const bf16_t*ksrc=Kh+(long)lane*PQ+wid*8;
  const bf16_t*vsrc=Vh+(long)(16*(wid&3)+(lane>>2))*PQ+(wid>>2)*32+(lane&3)*8;
  const bf16_t*csrc=CBh+(wid*8)*16+lane*8;
  const unsigned kdst=lds0+LDS_K+wid*1024, vdst=lds0+LDS_V+wid*1024, cdst=lds0+LDS_CB+wid*256;
  #define DMA_K(t,slot) do{ glds16(ksrc+(long)(t)*KVBLK*PQ,(unsigned)__builtin_amdgcn_readfirstlane(kdst+(slot))); \
      if(lane<16) glds16(csrc+(long)(t)*KVBLK*16,(unsigned)__builtin_amdgcn_readfirstlane(cdst+((slot)>>2))); }while(0)
  #define DMA_V(t,slot) glds16(vsrc+(long)(t)*KVBLK*PQ,(unsigned)__builtin_amdgcn_readfirstlane(vdst+(slot)))
  const int vb0=(int)(lds0+LDS_V)+((lane>>4)&1)*32+(lane&3)*8+(4*hi+((lane&15)>>2))*64;
  bf16x8 kf[8], kfe[2];
  const lds_cptr shm3=(lds_cptr)shm; const lds_cptr kp0=shm3+LDS_K+hi*1024+r32*16; const lds_cptr vp0=shm3+LDS_V+((lane>>4)&1)*32+(lane&3)*8+(4*hi+((lane&15)>>2))*64;
  const lds_cptr cp0=shm3+LDS_CB+r32*32+hi*16;
  const int NT=(q0+QB)/KVBLK-t0;
  DMA_K(0,0);DMA_V(0,0);DMA_K(1,SLOTB);
  bf16x8 qr[4];
  #pragma unroll
  for(int d0=0;d0<4;++d0)qr[d0]=*reinterpret_cast<const bf16x8*>(&Qw[(long)r32*PQ+d0*16+hi*8]);
  const unsigned himask=hi?0u:0xffffffffu;
  u32x4 qe; qe[0]=0x3F803F80u&himask; qe[3]=0u; float mhat; { unsigned q1_,q2_; mhat=ref_split(0.f,himask,q1_,q2_); qe[1]=q1_; qe[2]=q2_; }
  float l_reg=0.f;f32x16 o[2];o[0]=f32x16{};o[1]=f32x16{};
  const f32x16 Z=f32x16{};
  const int qrel=wid*QBLK+r32;
  #define QE() __builtin_bit_cast(bf16x8,qe)
  #define CMASK(P0,P1,t) do{int jb_=(t)-(NT-4); if(jb_>=0)cmask(P0,P1,jb_,qrel,hi);}while(0)
  bool resc=false;
  #define MOVE_REF(dl,DL_) do{ unsigned q1_,q2_; const float nr_=ref_split(mhat+(dl),himask,q1_,q2_); qe[1]=q1_; qe[2]=q2_; DL_=nr_-mhat; mhat=nr_; asm volatile("":"+v"(qe)); }while(0)
  #define START(P0,P1) do{ const float rm=rowmax(P0,P1); resc=false; \
    { float dl_; MOVE_REF(rm,dl_); \
      _Pragma("unroll") for(int r=0;r<16;++r){P0[r]=fsub_s(P0[r],dl_);P1[r]=fsub_s(P1[r],dl_);} } \
    _Pragma("unroll") for(int r=0;r<16;++r)P0[r]=__builtin_amdgcn_exp2f(P0[r]); }while(0)
  #define RESC() do{ if(resc){ asm volatile("s_waitcnt lgkmcnt(0)":::"memory"); \
      _Pragma("unroll") for(int d_=0;d_<2;++d_) _Pragma("unroll") for(int r=0;r<16;++r)o[d_][r]*=wsf[crow(r,hi)]; } }while(0)
  f32x16 pA0,pA1,pB0,pB1;
  int sl_prev=0,sl_cur=0,sl_next=SLOTB;
  #define ROT() do{sl_prev=sl_cur;sl_cur=sl_next;sl_next=(sl_next==(NSLOT-1)*SLOTB)?0:sl_next+SLOTB;}while(0)
  DMA_K(2,2*SLOTB);
  WAIT_BAR(5);
  { kfe[0]=LDSB8(cp0); kfe[1]=LDSB8(cp0+1024); kload8(kf,kp0);
    pA0=__builtin_amdgcn_mfma_f32_32x32x16_bf16(kfe[0],QE(),Z,0,0,0); pA1=__builtin_amdgcn_mfma_f32_32x32x16_bf16(kfe[1],QE(),Z,0,0,0);
    #pragma unroll
    for(int d0=0;d0<4;++d0){ pA0=__builtin_amdgcn_mfma_f32_32x32x16_bf16(kf[2*d0],qr[d0],pA0,0,0,0); pA1=__builtin_amdgcn_mfma_f32_32x32x16_bf16(kf[2*d0+1],qr[d0],pA1,0,0,0); } }
  asm volatile("s_nop 15\n\ts_nop 7":"+v"(pA0),"+v"(pA1));CMASK(pA0,pA1,0);
  START(pA0,pA1);
  _Pragma("unroll") for(int r=0;r<16;++r)pA1[r]=__builtin_amdgcn_exp2f(pA1[r]);
  WAIT_BAR(0);
  DMA_K(3,0);DMA_V(1,SLOTB);
  ROT();
  kload8(kf,kp0+sl_cur); kfe[0]=LDSB8(cp0+(sl_cur>>2)); kfe[1]=LDSB8(cp0+(sl_cur>>2)+1024);
  WAIT_BAR(3);
  s16x4 vlo[8],vhi[8]; u32x4 pw0,pw1,pw2,pw3;
  #define PKW(P,B) cvtpk_s(P[B],P[B+1])
  #define PAF(k) __builtin_bit_cast(bf16x8,pw##k)
  #define VFR(i) (bf16x8){vlo[i][0],vlo[i][1],vlo[i][2],vlo[i][3],vhi[i][0],vhi[i][1],vhi[i][2],vhi[i][3]}
  #define PIN(x) asm volatile("":"+v"(x))
  #define MX3(a,b,c) __builtin_fmaxf(__builtin_fmaxf((a),(b)),(c))
  #define GAPA(MF,A0,A1,A2,A3,W0,W1,PW) do{ MF; sacc+=A0; sacc+=A1; sacc+=A2; sacc+=A3; PIN(sacc); W0; W1; PIN(PW); SBAR(); }while(0)
  #define EX(v) __builtin_amdgcn_exp2f(v)
  #define GAPB(MF,X,B) do{ MF; X[B]=EX(X[B]); X[B+1]=EX(X[B+1]); X[B+2]=EX(X[B+2]); X[B+3]=EX(X[B+3]); PIN(X); SBAR(); }while(0)
  #define VRD(i) do{ vlo[i]=vtr(vp_+(((i)>>2)*4096+((i)&3)*1024)); vhi[i]=vtr(vp_+(((i)>>2)*4096+((i)&3)*1024+512)); }while(0)
  #define KRD(G,j) do{ if(G){ kload2(kf,kp0+sl_next,j); if((j)==0){ kfe[0]=LDSB8(cp0+(sl_next>>2)); kfe[1]=LDSB8(cp0+(sl_next>>2)+1024); } SBAR(); } }while(0)
  #define STEP(C0,C1,P0,P1,t,GK,GV,GL) do{ SBAR(); \
    const lds_cptr vp_=vp0+sl_prev; \
    C0=__builtin_amdgcn_mfma_f32_32x32x16_bf16(kfe[0],QE(),Z,0,0,0); C1=__builtin_amdgcn_mfma_f32_32x32x16_bf16(kfe[1],QE(),Z,0,0,0); SBAR(); \
    VRD(0); SBAR(); float sacc=(P0[0]+P0[1]); \
    GAPA(C0=__builtin_amdgcn_mfma_f32_32x32x16_bf16(kf[0],qr[0],C0,0,0,0), P0[2],P0[3],P0[4],P0[5],     pw0[0]=PKW(P0,0), pw0[1]=PKW(P0,2), pw0); \
    VRD(4); SBAR(); GAPA(C1=__builtin_amdgcn_mfma_f32_32x32x16_bf16(kf[1],qr[0],C1,0,0,0), P0[6],P0[7],P0[8],P0[9],     pw0[2]=PKW(P0,4), pw0[3]=PKW(P0,6), pw0); \
    VRD(1); SBAR(); GAPA(C0=__builtin_amdgcn_mfma_f32_32x32x16_bf16(kf[2],qr[1],C0,0,0,0),   P0[10],P0[11],P0[12],P0[13], pw1[0]=PKW(P0,8), pw1[1]=PKW(P0,10), pw1); \
    VRD(5); SBAR(); GAPA(C1=__builtin_amdgcn_mfma_f32_32x32x16_bf16(kf[3],qr[1],C1,0,0,0),   P0[14],P0[15],P1[0],P1[1],   pw1[2]=PKW(P0,12),pw1[3]=PKW(P0,14), pw1); \
    VRD(2); SBAR(); GAPA(C0=__builtin_amdgcn_mfma_f32_32x32x16_bf16(kf[4],qr[2],C0,0,0,0),   P1[2],P1[3],P1[4],P1[5],     pw2[0]=PKW(P1,0), pw2[1]=PKW(P1,2), pw2); \
    VRD(6); SBAR(); GAPA(C1=__builtin_amdgcn_mfma_f32_32x32x16_bf16(kf[5],qr[2],C1,0,0,0),   P1[6],P1[7],P1[8],P1[9],     pw2[2]=PKW(P1,4), pw2[3]=PKW(P1,6), pw2); \
    VRD(3); SBAR(); GAPA(C0=__builtin_amdgcn_mfma_f32_32x32x16_bf16(kf[6],qr[3],C0,0,0,0),   P1[10],P1[11],P1[12],P1[13], pw3[0]=PKW(P1,8), pw3[1]=PKW(P1,10), pw3); \
    VRD(7); SBAR(); GAPA(C1=__builtin_amdgcn_mfma_f32_32x32x16_bf16(kf[7],qr[3],C1,0,0,0),   P1[14],P1[15],0.f,0.f,       pw3[2]=PKW(P1,12),pw3[3]=PKW(P1,14), pw3); \
    l_reg+=sacc; \
    if(GK){DMA_K((t)+3,sl_cur);} if(GV){DMA_V((t)+1,sl_next);} \
    CMASK(C0,C1,t); \
    { float a=MX3(C0[0],C0[1],C1[0]),b=MX3(C0[2],C0[3],C1[1]); a=MX3(a,C1[2],C1[3]); \
      _Pragma("unroll") for(int r=4;r<16;r+=4){a=MX3(a,C0[r],C0[r+1]);b=MX3(b,C0[r+2],C0[r+3]);a=MX3(a,C1[r],C1[r+1]);b=MX3(b,C1[r+2],C1[r+3]);} \
      float rm=__builtin_fmaxf(a,b); { auto rr=__builtin_amdgcn_permlane32_swap(__float_as_uint(rm),__float_as_uint(rm),false,false); rm=__builtin_fmaxf(__uint_as_float(rr[0]),__uint_as_float(rr[1])); } \
      resc=false; \
      if(__builtin_expect(__any(rm>(float)THRL),0)){ float dl; MOVE_REF(__builtin_fmaxf(rm,0.f),dl); \
        _Pragma("unroll") for(int r=0;r<16;++r){C0[r]-=dl;C1[r]-=dl;} \
        const float f=__builtin_amdgcn_exp2f(-dl); l_reg*=f; if(hi==0)wsf[r32]=f; resc=true; } } \
    SBAR(); \
    GAPB(o[0]=__builtin_amdgcn_mfma_f32_32x32x16_bf16(PAF(0),VFR(0),o[0],0,0,0), C0,0); \
    GAPB(o[1]=__builtin_amdgcn_mfma_f32_32x32x16_bf16(PAF(0),VFR(4),o[1],0,0,0), C0,4); \
    KRD(GL,0); GAPB(o[0]=__builtin_amdgcn_mfma_f32_32x32x16_bf16(PAF(1),VFR(1),o[0],0,0,0), C0,8); \
    KRD(GL,1); GAPB(o[1]=__builtin_amdgcn_mfma_f32_32x32x16_bf16(PAF(1),VFR(5),o[1],0,0,0), C0,12); \
    KRD(GL,2); GAPB(o[0]=__builtin_amdgcn_mfma_f32_32x32x16_bf16(PAF(2),VFR(2),o[0],0,0,0), C1,0); \
    KRD(GL,3); GAPB(o[1]=__builtin_amdgcn_mfma_f32_32x32x16_bf16(PAF(2),VFR(6),o[1],0,0,0), C1,4); \
    GAPB(o[0]=__builtin_amdgcn_mfma_f32_32x32x16_bf16(PAF(3),VFR(3),o[0],0,0,0), C1,8); \
    GAPB(o[1]=__builtin_amdgcn_mfma_f32_32x32x16_bf16(PAF(3),VFR(7),o[1],0,0,0), C1,12); \
    }while(0)
  int t=1;
  #undef CMASK
  #define CMASK(P0,P1,t) do{}while(0)
  for(;t+5<NT;t+=2){
    STEP(pB0,pB1,pA0,pA1,t,true,true,true);     WAIT_BAR(3); RESC(); ROT();
    STEP(pA0,pA1,pB0,pB1,t+1,true,true,true);   WAIT_BAR(3); RESC(); ROT();
  }
  #undef CMASK
  #define CMASK(P0,P1,t) do{int jb_=(t)-(NT-4); if(jb_>=0)cmask(P0,P1,jb_,qrel,hi);}while(0)
  #define ENDW(tt) do{ if((tt)+3<NT){WAIT_BAR(3);} else if((tt)+2<NT){WAIT_BAR(1);} else {WAIT_BAR(0);} }while(0)
  for(;t+1<NT;t+=2){
    STEP(pB0,pB1,pA0,pA1,t,(t+3<NT),(t+1<NT),(t+1<NT));       ENDW(t);   RESC(); ROT();
    STEP(pA0,pA1,pB0,pB1,t+1,(t+4<NT),(t+2<NT),(t+2<NT));     ENDW(t+1); RESC(); ROT();
  }
  STEP(pB0,pB1,pA0,pA1,NT-1,false,false,false); RESC();
  { float sacc=pB0[0]+pB0[1]; _Pragma("unroll") for(int r=2;r<16;++r)sacc+=pB0[r]; _Pragma("unroll") for(int r=0;r<16;++r)sacc+=pB1[r]; l_reg+=sacc;
    pw0=(u32x4){PKW(pB0,0),PKW(pB0,2),PKW(pB0,4),PKW(pB0,6)};pw1=(u32x4){PKW(pB0,8),PKW(pB0,10),PKW(pB0,12),PKW(pB0,14)};pw2=(u32x4){PKW(pB1,0),PKW(pB1,2),PKW(pB1,4),PKW(pB1,6)};pw3=(u32x4){PKW(pB1,8),PKW(pB1,10),PKW(pB1,12),PKW(pB1,14)};
    SBAR(); pv(o,vb0+sl_cur,PAF(0),PAF(1),PAF(2),PAF(3)); }
  #undef PKW
  #undef PAF
  #undef VFR
  #undef PIN
  #undef MX3
  #undef GAPA
  #undef GAPB
  #undef EX
  #undef VRD
  #undef KRD
  #undef STEP
  #undef ENDW
  {auto rr=__builtin_amdgcn_permlane32_swap(__float_as_uint(l_reg),__float_as_uint(l_reg),false,false);l_reg=__uint_as_float(rr[0])+__uint_as_float(rr[1]);}
  if(hi==0)wsf[32+r32]=l_reg;asm volatile("s_waitcnt lgkmcnt(0)":::"memory");
  float rli[16];
  #pragma unroll
  for(int r=0;r<16;++r)rli[r]=__builtin_amdgcn_rcpf(wsf[32+crow(r,hi)]);
  bf16_t*Ow=O+(rowbase+q0+wid*QBLK)*PO+h*64;
  { bf16_t*stg=(bf16_t*)(shm+LDS_OST)+wid*2048;
    #pragma unroll
    for(int r=0;r<16;++r){const int orow=crow(r,hi);
      #pragma unroll
      for(int d0=0;d0<2;++d0)stg[orow*64+d0*32+r32]=f2bf(o[d0][r]*rli[r]);}
    asm volatile("s_waitcnt lgkmcnt(0)":::"memory");
    #pragma unroll
    for(int i=0;i<4;++i){const int row=i*8+(lane>>3),ch=lane&7; const u32x4 v=*(const u32x4*)(stg+row*64+ch*8);
#if FP8_G2
      *(u32x2*)((unsigned char*)(O-768)+((Ow+(long)row*PO+ch*8)-(O-768)))=bf8_to_fp8(v,YSC);} }
#else
      *(u32x4*)(Ow+(long)row*PO+ch*8)=v;} }
#endif
  asm volatile("s_waitcnt lgkmcnt(0)\n\ts_barrier":::"memory");
  #undef DMA_K
  #undef DMA_V
  #undef CMASK
  #undef START
  #undef RESC
  #undef ROT
  #undef QE
  #undef MOVE_REF
}
#undef SBAR
#undef WAIT_BAR
#undef LDSB8
}

using pg8::Unit;
struct SchedDense { int nM, nN, G, c, lda, ldb;
    __device__ __forceinline__ bool next(int i, Unit& u) const { int pm, pn; if (!pg8::static_tile(i, G, c, nM, nN, pm, pn)) return false;
        u.pm = pm; u.pn = pn; u.a = 0; u.b = 0; u.c = 0; u.e = 0; u.aoff = (size_t)pm * 256 * lda * 2; u.boff = (size_t)pn * 256 * ldb * 2; return true; } };
struct SchedG2 { int G, c;
    __device__ __forceinline__ bool next(int i, Unit& u) const { int pm, pn; if (!pg8::static_tile(i >> 2, G, c, 64, 8, pm, pn)) return false; const int n = i & 3;
        u.pm = pm; u.pn = pn; u.a = n; u.b = 0; u.c = 0; u.e = 0; u.aoff = ((size_t)pm * 256 * 1024 + n * 256) * (FP8_G2 ? 1 : 2); u.boff = ((size_t)(n * 1024 + pn * 128) * 256) * (FP8_G2 ? 1 : 2); return true; } };
template <int NPN, bool DOWN> struct SchedMoe { LAS const i32x4* TL; int u0, u1, per, j; int m; const unsigned* TD;
    __device__ __forceinline__ bool next(int i, Unit& u) const { int L = u0 + i * per + j;
        if (DOWN && TD) L = u0 + ((j >= m) ? (i == 0 ? (j - m) : i == 1 ? (j - m) + (per - m) : 2 * (per - m) + j + (i - 2) * per) : 2 * (per - m) + j + i * per);
        if (L >= u1) return false;
        const int tile = L / NPN, pn = L % NPN; const i32x4 t = TL[tile];
        if (DOWN && TD) { unsigned sp = 0u; while (__hip_atomic_load(TD + tile, __ATOMIC_RELAXED, __HIP_MEMORY_SCOPE_AGENT) < 16u) { __builtin_amdgcn_s_sleep(1); if (++sp > (1u << 20)) break; } }
        const int e = __builtin_amdgcn_readfirstlane(t[0]), sb = __builtin_amdgcn_readfirstlane(t[1]), nv = __builtin_amdgcn_readfirstlane(t[2]), ib = __builtin_amdgcn_readfirstlane(t[3]);
        u.pm = tile; u.pn = pn; u.e = e; u.a = sb; u.b = nv; u.c = ib;
        if (DOWN) { u.aoff = (size_t)sb * 256 * (FP8_GB ? 1 : 2); u.boff = WB_W2 * 2 + ((size_t)e * 1024 + pn * 256) * 256 * (FP8_GB ? 1 : 2); }
        else { u.aoff = 0; u.boff = WB_W13 * 2 + ((size_t)e * 512 + pn * 256) * 1024 * (FP8_GA ? 1 : 2); }
        return true; } };

typedef f32x4 Acc[2][2][4][2];
struct Epi1 { static constexpr bool PERM = true; static constexpr int NBJ = 2; static constexpr float ASCALE = FP8_G1 ? 1.f / 64.f : 1.f; bf16_t* PROJ; bf16_t* SG; unsigned* NRM;
    __device__ __forceinline__ void operator()(const Acc& acc, const Unit& u, int wr, int wc, int fr, int fq) const {
        asm volatile("" : "+v"(fr), "+v"(fq));
        const int pn = u.pn;
        const int row0 = u.pm * 256 + wr * 64 + fr, col0 = wc * 32 + 8 * fq;
        if (pn >= 8) {
            unsigned char* gb = (unsigned char*)SG + (size_t)row0 * 4096 + (pn - 8) * 256 + col0;
#pragma unroll
            for (int ai = 0; ai < 2; ++ai)
#pragma unroll
                for (int m = 0; m < 4; ++m)
#pragma unroll
                    for (int bj = 0; bj < 2; ++bj) { u32x2 w = (u32x2){0u, 0u};
#pragma unroll
                        for (int q = 0; q < 4; ++q) {
                            w.x = __builtin_amdgcn_cvt_pk_u8_f32(frcp(fmaf(fexp2(acc[ai][bj][m][0][q] * (-LOG2E * ASCALE)), 1.f / 255.f, 1.f / 255.f)), q, w.x);
                            w.y = __builtin_amdgcn_cvt_pk_u8_f32(frcp(fmaf(fexp2(acc[ai][bj][m][1][q] * (-LOG2E * ASCALE)), 1.f / 255.f, 1.f / 255.f)), q, w.y); }
                        *(u32x2*)(gb + (size_t)(ai * 128 + m * 16) * 4096 + bj * 128) = w; }
        } else if (pn == 1 || pn == 2) {
            bf16_t* pb_ = PROJ + (size_t)row0 * 2048 + pn * 256 + col0;
#pragma unroll
            for (int ai = 0; ai < 2; ++ai)
#pragma unroll
                for (int m = 0; m < 4; ++m)
#pragma unroll
                    for (int bj = 0; bj < 2; ++bj) { float v[8];
#pragma unroll
                        for (int n = 0; n < 2; ++n)
#pragma unroll
                            for (int q = 0; q < 4; ++q) v[4 * n + q] = gelu_tanh(acc[ai][bj][m][n][q] * ASCALE);
                        u32x4 w; w.x = cvt_pk_bf16(v[0], v[1]); w.y = cvt_pk_bf16(v[2], v[3]); w.z = cvt_pk_bf16(v[4], v[5]); w.w = cvt_pk_bf16(v[6], v[7]);
                        *(u32x4*)(pb_ + (size_t)(ai * 128 + m * 16) * 2048 + bj * 128) = w; }
        } else {
            const float scl = (pn == 5) ? QSCALE * ASCALE : ASCALE;
            bf16_t* pb_ = PROJ + (size_t)row0 * 2048 + pn * 256 + col0;
#pragma unroll
            for (int ai = 0; ai < 2; ++ai)
#pragma unroll
                for (int m = 0; m < 4; ++m)
#pragma unroll
                    for (int bj = 0; bj < 2; ++bj) { const f32x4 a0 = acc[ai][bj][m][0] * scl, a1 = acc[ai][bj][m][1] * scl;
                        u32x4 w; w.x = cvt_pk_bf16(a0[0], a0[1]); w.y = cvt_pk_bf16(a0[2], a0[3]); w.z = cvt_pk_bf16(a1[0], a1[1]); w.w = cvt_pk_bf16(a1[2], a1[3]);
                        *(u32x4*)(pb_ + (size_t)(ai * 128 + m * 16) * 2048 + bj * 128) = w; }
        }
        if (pn == 5 || pn == 6) {
            const float sc = (pn == 5) ? QSCALE : 1.f;
#pragma unroll
            for (int bj = 0; bj < 2; ++bj) { float mx = 0.f;
#pragma unroll
                for (int ai = 0; ai < 2; ++ai)
#pragma unroll
                    for (int m = 0; m < 4; ++m) { float ss = 0.f;
#pragma unroll
                        for (int n = 0; n < 2; ++n)
#pragma unroll
                            for (int q = 0; q < 4; ++q) { const float x = acc[ai][bj][m][n][q] * (sc * ASCALE); ss += x * x; }
                        ss = fq_sum(ss); mx = fmaxf(mx, ss); }
                mx = row16_max_dpp(mx);
                if (fr == 0 && fq == 0) atomicMax(NRM + ((((pn - 5) * 2 + (u.pm >> 5)) * 4 + 2 * bj + (wc >> 1)) * 2 + (wc & 1)), __float_as_uint(mx)); } }
    } };
struct Epi2 { static constexpr bool PERM = true; static constexpr int NBJ = 1; const unsigned char* SG; bf16_t* MRG; mutable f32x4 mrg[2][4][2];
    __device__ __forceinline__ void operator()(const Acc& acc, const Unit& u, int wr, int wc, int fr, int fq) const {
        asm volatile("" : "+v"(fr), "+v"(fq));
        const int n_ = u.a; const int row0 = u.pm * 256 + wr * 64 + fr, col0 = u.pn * 128 + wc * 32 + 8 * fq;
        u32x2 g[2][4];
#pragma unroll
        for (int ai = 0; ai < 2; ++ai)
#pragma unroll
            for (int m = 0; m < 4; ++m) g[ai][m] = *(const u32x2*)(SG + (size_t)(row0 + ai * 128 + m * 16) * 4096 + n_ * 1024 + col0);
#define E2_TERMS(ai, m) const u32x2 gg = g[ai][m]; const f32x4 a0 = acc[ai][0][m][0] * (FP8_G2 ? 1.f / (255.f * 512.f) : 1.f / 255.f), a1 = acc[ai][0][m][1] * (FP8_G2 ? 1.f / (255.f * 512.f) : 1.f / 255.f); \
                const f32x4 t0 = (f32x4){(float)(gg.x & 255u) * a0[0], (float)((gg.x >> 8) & 255u) * a0[1], (float)((gg.x >> 16) & 255u) * a0[2], (float)(gg.x >> 24) * a0[3]}; \
                const f32x4 t1 = (f32x4){(float)(gg.y & 255u) * a1[0], (float)((gg.y >> 8) & 255u) * a1[1], (float)((gg.y >> 16) & 255u) * a1[2], (float)(gg.y >> 24) * a1[3]};
        if (n_ == 0) {
#pragma unroll
            for (int ai = 0; ai < 2; ++ai)
#pragma unroll
                for (int m = 0; m < 4; ++m) { E2_TERMS(ai, m) mrg[ai][m][0] = t0; mrg[ai][m][1] = t1; }
        } else if (n_ < 3) {
#pragma unroll
            for (int ai = 0; ai < 2; ++ai)
#pragma unroll
                for (int m = 0; m < 4; ++m) { E2_TERMS(ai, m) mrg[ai][m][0] = mrg[ai][m][0] + t0; mrg[ai][m][1] = mrg[ai][m][1] + t1; }
        } else {
#pragma unroll
            for (int ai = 0; ai < 2; ++ai)
#pragma unroll
                for (int m = 0; m < 4; ++m) { E2_TERMS(ai, m) const f32x4 r0 = mrg[ai][m][0] + t0, r1 = mrg[ai][m][1] + t1;
#if FP8_G3
                    u32x2 w; w.x = pk4_fp8(r0[0] * 16.f, r0[1] * 16.f, r0[2] * 16.f, r0[3] * 16.f); w.y = pk4_fp8(r1[0] * 16.f, r1[1] * 16.f, r1[2] * 16.f, r1[3] * 16.f);
                    *(u32x2*)((unsigned char*)MRG + (size_t)(row0 + ai * 128 + m * 16) * 1024 + col0) = w; }
#else
                    u32x4 w; w.x = cvt_pk_bf16(r0[0], r0[1]); w.y = cvt_pk_bf16(r0[2], r0[3]); w.z = cvt_pk_bf16(r1[0], r1[1]); w.w = cvt_pk_bf16(r1[2], r1[3]);
                    *(u32x4*)(MRG + (size_t)(row0 + ai * 128 + m * 16) * 1024 + col0) = w; }
#endif
        }
#undef E2_TERMS
    } };
struct Epi3 { static constexpr bool PERM = true; static constexpr int NBJ = 2; static constexpr float ASCALE = FP8_G3 ? 1.f / 1024.f : 1.f; const float* xin32; bf16_t* X; const float* gate;
    __device__ __forceinline__ void operator()(const Acc& acc, const Unit& u, int wr, int wc, int fr, int fq) const {
        asm volatile("" : "+v"(fr), "+v"(fq));
        const int b = u.pm >> 5; const float* gp = gate + (size_t)b * 6144 + 2 * 1024;
        const int row0 = u.pm * 256 + wr * 64 + fr, col0 = u.pn * 256 + wc * 32 + 8 * fq;
#define E3_BODY(...) _Pragma("unroll") for (int bj = 0; bj < 2; ++bj) { const int col = col0 + bj * 128; const f32x4 g0 = *(const f32x4*)(gp + col) * ASCALE, g1 = *(const f32x4*)(gp + col + 4) * ASCALE; \
            _Pragma("unroll") for (int ai = 0; ai < 2; ++ai) _Pragma("unroll") for (int m = 0; m < 4; ++m) { const size_t off = (size_t)(row0 + ai * 128 + m * 16) * 1024 + col; f32x4 x0, x1; __VA_ARGS__ \
                    x0 = x0 + g0 * acc[ai][bj][m][0]; x1 = x1 + g1 * acc[ai][bj][m][1]; \
                    u32x4 o; o.x = cvt_pk_bf16(x0[0], x0[1]); o.y = cvt_pk_bf16(x0[2], x0[3]); o.z = cvt_pk_bf16(x1[0], x1[1]); o.w = cvt_pk_bf16(x1[2], x1[3]); \
                    *(u32x4*)(X + off) = o; } }
        if (xin32) { E3_BODY(x0 = *(const f32x4*)(xin32 + off); x1 = *(const f32x4*)(xin32 + off + 4);) }
        else { E3_BODY(const u32x4 w = *(const u32x4*)(X + off); x0 = (f32x4){bflo(w.x), bfhi(w.x), bflo(w.y), bfhi(w.y)}; x1 = (f32x4){bflo(w.z), bfhi(w.z), bflo(w.w), bfhi(w.w)};) }
#undef E3_BODY
    } };
struct EpiUp { static constexpr bool PERM = true; static constexpr int NBJ = 2; static constexpr float ASCALE = FP8_GA ? 1.f / 64.f : 1.f; bf16_t* HID; const float* GWP; unsigned* TD;
    __device__ __forceinline__ void operator()(const Acc& acc, const Unit& u, int wr, int wc, int fr, int fq) const {
        asm volatile("" : "+v"(fr), "+v"(fq));
#if FP8_GB
#define EUP_STORE() u32x2 w; w.x = pk4_fp8(v[0], v[1], v[2], v[3]); w.y = pk4_fp8(v[4], v[5], v[6], v[7]);   \
                    *(u32x2*)((unsigned char*)HID + slot * 256 + u.pn * 128 + wc * 32 + 8 * fq) = w;
#else
#define EUP_STORE() u32x4 w; w.x = cvt_pk_bf16(v[0], v[1]); w.y = cvt_pk_bf16(v[2], v[3]); w.z = cvt_pk_bf16(v[4], v[5]); w.w = cvt_pk_bf16(v[6], v[7]); \
                    *(u32x4*)(HID + slot * 256 + u.pn * 128 + wc * 32 + 8 * fq) = w;
#endif
#define EUP_BODY(...) _Pragma("unroll") for (int ai = 0; ai < 2; ++ai) _Pragma("unroll") for (int m = 0; m < 4; ++m) { const int r = ai * 128 + wr * 64 + m * 16 + fr; \
                if (r < u.b) { const size_t slot = (size_t)u.a + r; const float gw = (__VA_ARGS__) * ((FP8_GB ? 8.f : 1.f) * ASCALE * ASCALE); float v[8];   \
                    _Pragma("unroll") for (int n = 0; n < 2; ++n) _Pragma("unroll") for (int q = 0; q < 4; ++q) { const float a_ = acc[ai][0][m][n][q]; v[4 * n + q] = (a_ * acc[ai][1][m][n][q]) * gw * frcp(1.f + fexp2(a_ * (-LOG2E * ASCALE))); } \
                    EUP_STORE() } }
        if (u.e < 64) { EUP_BODY(GWP[u.c + r]) } else { EUP_BODY(1.f) }
#undef EUP_BODY
#undef EUP_STORE
        if (TD) { asm volatile("s_waitcnt vmcnt(0)" ::: "memory"); if (lane_id() == 0) (void)__hip_atomic_fetch_add(TD + u.pm, 1u, __ATOMIC_RELAXED, __HIP_MEMORY_SCOPE_AGENT); }
    } };
struct EpiDown { static constexpr bool PERM = true; static constexpr int NBJ = 2; static constexpr float ASCALE = FP8_GB ? 1.f / 512.f : 1.f; unsigned char* Y2Q; float* Y2S;
    __device__ __forceinline__ void operator()(const Acc& acc, const Unit& u, int wr, int wc, int fr, int fq) const {
        asm volatile("" : "+v"(fr), "+v"(fq));
#pragma unroll
        for (int ai = 0; ai < 2; ++ai)
#pragma unroll
            for (int m = 0; m < 4; ++m) { const int r = ai * 128 + wr * 64 + m * 16 + fr; const size_t slot = (size_t)u.a + r;
#pragma unroll
                for (int bj = 0; bj < 2; ++bj) { const f32x4 a0 = acc[ai][bj][m][0], a1 = acc[ai][bj][m][1];
                    float mx, m1_, m2_;
                    asm("v_max3_f32 %0, |%1|, |%2|, |%3|" : "=v"(m1_) : "v"(a0[0]), "v"(a0[1]), "v"(a0[2]));
                    asm("v_max3_f32 %0, %1, |%2|, |%3|" : "=v"(m2_) : "v"(m1_), "v"(a0[3]), "v"(a1[0]));
                    asm("v_max3_f32 %0, %1, |%2|, |%3|" : "=v"(m1_) : "v"(m2_), "v"(a1[1]), "v"(a1[2]));
                    asm("v_max_f32_e64 %0, %1, |%2|" : "=v"(mx) : "v"(m1_), "v"(a1[3]));
                    mx = fq_max(mx);
                    const float sc = mx * (ASCALE / 127.f), inv = mx > 0.f ? 127.f * frcp(mx) : 0.f;
                    unsigned w0 = 0u, w1 = 0u;
#pragma unroll
                    for (int i = 0; i < 4; ++i) { w0 = __builtin_amdgcn_cvt_pk_u8_f32(a0[i] * inv + 128.f, i, w0); w1 = __builtin_amdgcn_cvt_pk_u8_f32(a1[i] * inv + 128.f, i, w1); }
                    if (r < u.b) { *(u32x2*)(Y2Q + slot * 1024 + u.pn * 256 + bj * 128 + wc * 32 + 8 * fq) = (u32x2){w0, w1};
                        if (fq == 0) Y2S[slot * 32 + u.pn * 8 + bj * 4 + wc] = sc; } } }
    } };

__device__ __forceinline__ void phase_token(const Params& P, LAS unsigned char* lds, int l, int bid, int G, const int g_wave, int ctr) {
    const int tid = TIDX, lane = tid & 63, wave = __builtin_amdgcn_readfirstlane(tid >> 6);
    constexpr int AP = 1032;
    LAS bf16_t* Ahi = (LAS bf16_t*)lds; LAS bf16_t* Alo = (LAS bf16_t*)(lds + 16 * AP * 2);
    LAS float* part = (LAS float*)(lds + 2 * 16 * AP * 2);
    LAS int* cntw = (LAS int*)(lds + 2 * 16 * AP * 2 + 8192); LAS int* basew = cntw + 8 * 64;
    const float* MOD = (const float*)(wsptr(P) + WS_SMALL + SM_MOD);
    const bf16_t* X = (const bf16_t*)(wsptr(P) + WS_X); bf16_t* H = (bf16_t*)(wsptr(P) + WS_H);
    int* TE = (int*)(wsptr(P) + WS_SMALL + SM_TE); int* TP = (int*)(wsptr(P) + WS_SMALL + SM_TP);
    int* IDXP = (int*)(wsptr(P) + WS_SMALL + SM_IDXP); float* GWP = (float*)(wsptr(P) + WS_SMALL + SM_GWP);
    unsigned* CNT = (unsigned*)(wsptr(P) + WS_CTL) + CW_CNT + ctr * 64;
    const int nt = wave & 3, kh = wave >> 2, kq = lane >> 4;
    bf16x8 bhi[16], blo[16];
    { const bf16_t* WRT = (const bf16_t*)(wsptr(P) + WS_WB) + WB_WR + (size_t)(16 * nt + (lane & 15)) * 1024 + kh * 512 + 8 * kq;
#pragma unroll
      for (int ks = 0; ks < 16; ++ks) { bhi[ks] = *(const bf16x8*)(WRT + 32 * ks); blo[ks] = *(const bf16x8*)(WRT + 65536 + 32 * ks); } }
    const float rb = inptr(I_RB)[l * 64 + lane];
    for (int grp = bid; grp < M / 64; grp += G) {
        int selk[8]; float selw[8]; int cnt = 0;
        f32x4 mA[4], mB[4];
        { const float* md = MOD + (size_t)(l * 2 + ((grp * 64) >> 13)) * 6144;
#pragma unroll
          for (int j = 0; j < 4; ++j) { const int d0 = 256 * j + 4 * lane; mA[j] = *(const f32x4*)(inptr(I_FNG) + l * D + d0) * (*(const f32x4*)(md + 4 * 1024 + d0) + 1.0f); mB[j] = *(const f32x4*)(md + 3 * 1024 + d0); } }
        u32x2 vx[2][4];
#pragma unroll
        for (int i2 = 0; i2 < 2; ++i2)
#pragma unroll
            for (int j = 0; j < 4; ++j) vx[i2][j] = *(const u32x2*)(X + (size_t)(grp * 64 + 2 * wave + i2) * D + 256 * j + 4 * lane);
#pragma unroll
        for (int sub = 0; sub < 4; ++sub) {
#pragma unroll
            for (int i2 = 0; i2 < 2; ++i2) { const int tl = 2 * wave + i2, row = grp * 64 + sub * 16 + tl;
                f32x4 v[4]; float ss = 0.f;
#pragma unroll
                for (int j = 0; j < 4; ++j) { const u32x2 w_ = vx[i2][j]; v[j] = (f32x4){bflo(w_.x), bfhi(w_.x), bflo(w_.y), bfhi(w_.y)}; ss += (v[j][0] * v[j][0] + v[j][1] * v[j][1]) + (v[j][2] * v[j][2] + v[j][3] * v[j][3]); }
                if (sub < 3) {
#pragma unroll
                    for (int j = 0; j < 4; ++j) vx[i2][j] = *(const u32x2*)(X + (size_t)(row + 16) * D + 256 * j + 4 * lane); }
                const float rms = 1.0f / sqrtf(wave_sum(ss) * (1.f / D) + EPS);
#pragma unroll
                for (int j = 0; j < 4; ++j) { const int d0 = 256 * j + 4 * lane;
                    const f32x4 h = v[j] * rms * mA[j] + mB[j];
                    u32x2 w; w.x = cvt_pk_bf16(h[0], h[1]); w.y = cvt_pk_bf16(h[2], h[3]);
#if FP8_GA
                    *(unsigned*)((unsigned char*)(wsptr(P) + WS_HF8) + (size_t)row * D + d0) = pk4_fp8(h[0], h[1], h[2], h[3]);
#else
                    *(u32x2*)(H + (size_t)row * D + d0) = w;
#endif
                    *(LAS u32x2*)(Ahi + tl * AP + d0) = w;
                    u32x2 wl; wl.x = cvt_pk_bf16(h[0] - bflo(w.x), h[1] - bfhi(w.x)); wl.y = cvt_pk_bf16(h[2] - bflo(w.y), h[3] - bfhi(w.y)); *(LAS u32x2*)(Alo + tl * AP + d0) = wl; } }
            __syncthreads();
            { f32x4 a0 = (f32x4){0.f, 0.f, 0.f, 0.f}, a1 = a0, a2 = a0; const int ao = (lane & 15) * AP + kh * 512 + 8 * kq;
#pragma unroll
              for (int ks = 0; ks < 16; ++ks) { const bf16x8 ahi = *(const LAS bf16x8*)(Ahi + ao + 32 * ks), alo = *(const LAS bf16x8*)(Alo + ao + 32 * ks);
                  a0 = __builtin_amdgcn_mfma_f32_16x16x32_bf16(ahi, bhi[ks], a0, 0, 0, 0); a1 = __builtin_amdgcn_mfma_f32_16x16x32_bf16(alo, bhi[ks], a1, 0, 0, 0);
                  a2 = __builtin_amdgcn_mfma_f32_16x16x32_bf16(ahi, blo[ks], a2, 0, 0, 0); }
              const f32x4 acc = a0 + (a1 + a2);
#pragma unroll
              for (int j = 0; j < 4; ++j) part[(kh * 16 + 4 * kq + j) * 64 + 16 * nt + (lane & 15)] = acc[j]; }
            __syncthreads();
            {
                float score[2], sel[2], m1[2], m2[2], gs[2], cand[2]; int i1[2], grank[2], myrank[2];
#pragma unroll
                for (int i2 = 0; i2 < 2; ++i2) { const int tl = 2 * wave + i2; score[i2] = sigmoidf_(part[tl * 64 + lane] + part[(16 + tl) * 64 + lane]); sel[i2] = score[i2] + rb; m1[i2] = grp8_max_dpp(sel[i2]); }
#pragma unroll
                for (int i2 = 0; i2 < 2; ++i2) i1[i2] = grp8_min_dpp((sel[i2] == m1[i2]) ? lane : 64);
#pragma unroll
                for (int i2 = 0; i2 < 2; ++i2) m2[i2] = grp8_max_dpp((lane == i1[i2]) ? -INFINITY : sel[i2]);
                const int grp_id = lane >> 3;
#pragma unroll
                for (int i2 = 0; i2 < 2; ++i2) { gs[i2] = m1[i2] + m2[i2]; grank[i2] = 0; }
#pragma unroll
                for (int j = 0; j < 8; ++j)
#pragma unroll
                    for (int i2 = 0; i2 < 2; ++i2) { const float o = __builtin_bit_cast(float, __builtin_amdgcn_readlane(__builtin_bit_cast(int, gs[i2]), 8 * j)); grank[i2] += (o > gs[i2] || (o == gs[i2] && j < grp_id)) ? 1 : 0; }
#pragma unroll
                for (int i2 = 0; i2 < 2; ++i2) { cand[i2] = (grank[i2] < 4) ? sel[i2] : -INFINITY; myrank[i2] = -1; }
#pragma unroll
                for (int k = 0; k < TOPK; ++k) {
#pragma unroll
                    for (int i2 = 0; i2 < 2; ++i2) { const float mx = wave_max_dpp(cand[i2]); const int first = __ffsll((unsigned long long)__ballot(cand[i2] == mx)) - 1; if (lane == first) { myrank[i2] = k; cand[i2] = -INFINITY; } } }
#pragma unroll
                for (int i2 = 0; i2 < 2; ++i2) { const bool chosen = myrank[i2] >= 0; const float den = wave_sum_dpp(chosen ? score[i2] : 0.f);
                    selk[sub * 2 + i2] = myrank[i2]; selw[sub * 2 + i2] = score[i2] / den * 2.5f; cnt += chosen ? 1 : 0; } }
            __syncthreads();
        }
        cntw[wave * 64 + lane] = cnt;
        __syncthreads();
        if (tid < 64) { int tot = 0; int pre[8];
#pragma unroll
            for (int w = 0; w < 8; ++w) { pre[w] = tot; tot += cntw[w * 64 + tid]; }
            int base = 0; if (tot > 0) base = (int)__hip_atomic_fetch_add(CNT + tid, (unsigned)tot, __ATOMIC_RELAXED, __HIP_MEMORY_SCOPE_AGENT);
#pragma unroll
            for (int w = 0; w < 8; ++w) basew[w * 64 + tid] = base + pre[w]; }
        __syncthreads();
        int run = basew[wave * 64 + lane];
#pragma unroll
        for (int i = 0; i < 8; ++i) { const int t = grp * 64 + (i >> 1) * 16 + 2 * wave + (i & 1);
            if (selk[i] >= 0) { const int o = t * TOPK + selk[i]; TE[o] = lane; TP[o] = run; IDXP[lane * CAP + run] = t; GWP[lane * CAP + run] = selw[i]; ++run; } }
        __syncthreads();
    }
}
__device__ __forceinline__ int moe_tile_list(const Params& P, LAS unsigned char* lds, int l, const int g_wave) {
    moe_offsets(P, lds, l, g_wave);
    LAS const int* eo = (LAS const int*)(lds + EOFF_OFF); LAS i32x4* TL = (LAS i32x4*)(lds + TL_OFF);
    const int tid = TIDX; const int nrt = eo[64 + 63] + ((eo[128 + 63] + 255) >> 8);
    LAS int* TLi = (LAS int*)(lds + TL_OFF);
    if (tid < 64) { const int e = tid, n = eo[128 + e], t0 = eo[64 + e];
#pragma unroll 1
        for (int j = 0; j * 256 < n; ++j) { LAS int* q = TLi + 4 * (t0 + 8 * (e >> 3) + j); q[0] = e; q[1] = eo[e] + j * 256; q[2] = (n - j * 256 < 256) ? n - j * 256 : 256; q[3] = e * CAP + j * 256; } }
    else if (tid < 128) { const int s_ = tid - 64, g_ = s_ >> 3; LAS int* q = TLi + 4 * ((g_ < 7 ? eo[64 + 8 * (g_ + 1)] : nrt) + s_); q[0] = opaque(64); q[1] = NPAIR + s_ * 256; q[2] = opaque(256); q[3] = 64 * CAP + s_ * 256; }
    __syncthreads();
    return nrt + 64;
}

constexpr int PH_PER_LAYER = 8, N_PHASES = 1 + NL * PH_PER_LAYER + 1;
__global__ void __launch_bounds__(NTHREADS, 2) fwd_kernel(Params P) {
    LAS unsigned char* lds = (LAS unsigned char*)lds_raw;
    const int wave = __builtin_amdgcn_readfirstlane((int)threadIdx.x >> 6);
    int bid = blockIdx.x, G = gridDim.x;
    const int g_wave = wave; const int tid = TIDX;
    int gw = bid * NWAVES + wave, NGW = G * NWAVES;
    if (tid < 64) ((LAS unsigned*)(lds + LDSCTL_OFF))[tid] = 0u;
    if (tid == 0) {
#pragma unroll
        for (int i = 0; i < 29; ++i) *(LAS unsigned long long*)(lds + PTRS_OFF + 8 * i) = (unsigned long long)P.in[i];
        *(LAS unsigned long long*)(lds + PTRS_OFF + 8 * 29) = (unsigned long long)P.ws; }
    __syncthreads();
    unsigned* ctl = (unsigned*)(wsptr(P) + WS_CTL);
#if MK_ONE_LAUNCH
    XcdBarrier bar = xcd_barrier_post(ctl + CW_BAR, (volatile LAS unsigned*)(lds + MISC_OFF) + 8, wave);
#define SEAM() xcd_barrier(bar, wave)
#else
#define SEAM() do {} while (0)
#endif
    const int lo = P.ph_lo, hi = P.ph_hi;
#ifndef KMASK
#define KMASK 0xffff
#endif
#define IN(k) (lo <= (k) && (k) < hi)
#define KIND(j) ((KMASK >> (j)) & 1)
#define BOTH(k) (IN(k) && IN((k) + 1))
#define WB ((bf16_t*)(wsptr(P) + WS_WB))
#define X ((float*)(wsptr(P) + WS_X))
#define H ((bf16_t*)(wsptr(P) + WS_H))
#define YS ((bf16_t*)(wsptr(P) + WS_YS))
#define MRG ((bf16_t*)(wsptr(P) + WS_MRG))
#define HID ((bf16_t*)(wsptr(P) + WS_HID))
#define PROJ ((bf16_t*)(wsptr(P) + WS_R1))
#define SG (PROJ + (size_t)M * 2048)
#define Y2 ((bf16_t*)(wsptr(P) + WS_R1))
#define MOD ((const float*)(wsptr(P) + WS_SMALL + SM_MOD))
#define SOPQ(v) asm volatile("" : "+s"(v))
#ifndef DUPK
#define DUPK -1
#endif
#define REP(k) for (int rep_ = 0; rep_ < ((DUPK == (k)) ? 2 : 1); ++rep_, ((DUPK == (k)) && rep_ == 1 ? (SEAM(), 0) : 0))
    if (KIND(0) && IN(0)) { REP(0) phase_ada(P, lds, bid, G, wave); if (BOTH(0)) SEAM(); }

    for (int l = 0; l < NL; ++l) {
        const int pb = 1 + l * PH_PER_LAYER;
        if (KIND(1) && IN(pb + 0)) { SOPQ(bid); SOPQ(G); SOPQ(gw); SOPQ(NGW);
            const float* win_ = inptr(I_WIN) + (size_t)l * 1024 * COLT + 2048;
            const f32x4 wfr0 = *(const f32x4*)(win_ + (size_t)TIDX * COLT), wfr1 = *(const f32x4*)(win_ + (size_t)(TIDX + NTHREADS) * COLT);
            REP(1) phase_convert<true>(P, lds, l, gw, NGW, wave, 0, CVT_EARLY);
            __syncthreads();
            if (l == 0) { for (int rep_ = 0; rep_ < ((DUPK == 12) ? 2 : 1); ++rep_) phase_norm1<0>(P, lds, l, gw, NGW, wave, wfr0, wfr1); } else phase_norm1<1>(P, lds, l, gw, NGW, wave, wfr0, wfr1);
            if (BOTH(pb + 0)) SEAM();
        }
        if (KIND(2) && IN(pb + 1)) { SOPQ(bid); SOPQ(G); SOPQ(gw); SOPQ(NGW);
            {
#pragma unroll 1
              for (int vb = bid; vb < 256; vb += G) scan_logf(P, lds, vb, wave);
              VM_WAIT(); __syncthreads(); }
#if FP8_G1
            pg8::Gemm g{(const bf16_t*)(wsptr(P) + WS_HF8), WB + WB_WIN, 512, 512, 512, nullptr}; SchedDense S{64, 24, G, bid, 512, 512}; Epi1 E{PROJ, SG, ctl + CW_NRM + 64 * l};
            REP(2) pg8::gemm_phase<Epi1, SchedDense, false, true>(lds, g, S, E, wave);
#else
            pg8::Gemm g{H, WB + WB_WIN, 1024, 1024, 1024, nullptr}; SchedDense S{64, 24, G, bid, 1024, 1024}; Epi1 E{PROJ, SG, ctl + CW_NRM + 64 * l};
            REP(2) pg8::gemm_phase<Epi1, SchedDense, false>(lds, g, S, E, wave);
#endif
            if (BOTH(pb + 1)) SEAM();
        }
        if (KIND(3) && IN(pb + 2)) { SOPQ(bid); SOPQ(G); SOPQ(gw); SOPQ(NGW);
            REP(3) {
            unsigned* qheads = ctl + CW_QS + ((l * 2 + rep_) * 8) * 64; LAS int* qitem = (LAS int*)(lds + MISC_OFF) + 16;
            const bf16_t* CBp = (const bf16_t*)(wsptr(P) + WS_SMALL + SM_CB);
            constexpr int NCV = (CVT_ALL - CVT_EARLY + 7) / 8, NI = 896 + NCV;
            int sh = bid & 7, dry = 0;
            for (;;) {
                if (TIDX == 0) *qitem = (int)__hip_atomic_fetch_add(qheads + 64 * sh, 1u, __ATOMIC_RELAXED, __HIP_MEMORY_SCOPE_AGENT);
                __syncthreads();
                const int it = __builtin_amdgcn_readfirstlane(*qitem) * 8 + sh;
                __syncthreads();
                if (it >= NI) { if (++dry >= 8) break; sh = (sh + 1) & 7; continue; }
                if (it >= 256 && it < 256 + NCV) { phase_convert<false>(P, lds, l, wave, 8, wave, CVT_EARLY + (it - 256) * 8, min(CVT_EARLY + (it - 256) * 8 + 8, CVT_ALL)); continue; }
                if (it < 256) {
                    const int qb = 31 - (it >> 3), bh = (it + (it >> 3)) & 7;
                    int t0 = 0;
                    { const unsigned* nq = ctl + CW_NRM + 64 * l + bh * 2; const unsigned* nk = nq + 16;
                      const float qn2 = __uint_as_float(__hip_atomic_load(nq, __ATOMIC_RELAXED, __HIP_MEMORY_SCOPE_AGENT)) + __uint_as_float(__hip_atomic_load(nq + 1, __ATOMIC_RELAXED, __HIP_MEMORY_SCOPE_AGENT));
                      const float kn2 = __uint_as_float(__hip_atomic_load(nk, __ATOMIC_RELAXED, __HIP_MEMORY_SCOPE_AGENT)) + __uint_as_float(__hip_atomic_load(nk + 1, __ATOMIC_RELAXED, __HIP_MEMORY_SCOPE_AGENT));
                      const float thr = 2.f * 1.02f * sqrtf(qn2 * kn2) + 160.f;
                      const float* cum = (const float*)(wsptr(P) + WS_SMALL + SM_CUM) + (size_t)bh * SEQ; const float ci = cum[qb * 256];
                      const int ln = lane_id(); int cnt = 0;
#pragma unroll
                      for (int k2 = 0; k2 < 2; ++k2) { const int J = ln + 64 * k2; const bool sk = (J < 4 * qb) && (cum[(J < 128 ? J : 127) * 64 + 63] - ci > thr); cnt += __popcll(__ballot(sk)); }
                      t0 = __builtin_amdgcn_readfirstlane(cnt) & ~1; }
                    fa::attn_unit<8>(bh >> 2, bh & 3, qb, t0, PROJ + 1280, PROJ + 1536, PROJ + 1792, CBp, YS + 768, (char*)lds_raw, wave);
                }
                else if (it < NCV + 384) sg_unit(P, lds, l, it - NCV - 256, wave);
                else if (it < NCV + 640) conv_unit(P, lds, l, it - NCV - 384, wave);
                else pool_unit(P, lds, l, it - NCV - 640, wave);
            }
            }
            if (BOTH(pb + 2)) SEAM();
        }
        if (KIND(4) && IN(pb + 3)) { SOPQ(bid); SOPQ(G); SOPQ(gw); SOPQ(NGW);
#if FP8_G2
            pg8::Gemm g{YS, WB + WB_WBR, 512, 128, 128, nullptr}; SchedG2 S{G, bid}; Epi2 E{(const unsigned char*)SG, MRG, {}};
            REP(4) pg8::gemm_phase<Epi2, SchedG2, false, true>(lds, g, S, E, wave);
#else
            pg8::Gemm g{YS, WB + WB_WBR, 1024, 256, 256, nullptr}; SchedG2 S{G, bid}; Epi2 E{(const unsigned char*)SG, MRG, {}};
            REP(4) pg8::gemm_phase<Epi2, SchedG2, false>(lds, g, S, E, wave);
#endif
            if (BOTH(pb + 3)) SEAM();
        }
        if (KIND(5) && IN(pb + 4)) { SOPQ(bid); SOPQ(G); SOPQ(gw); SOPQ(NGW);
#if FP8_G3
            pg8::Gemm g{MRG, WB + WB_WOUT, 512, 512, 512, nullptr}; SchedDense S{64, 4, G, bid, 512, 512}; Epi3 E{l == 0 ? inptr(I_X) : (const float*)nullptr, (bf16_t*)X, MOD + (size_t)l * 2 * 6144};
            for (int rep_ = 0; rep_ < ((DUPK == 5 && l == 0) ? 2 : 1); ++rep_) pg8::gemm_phase<Epi3, SchedDense, false, true>(lds, g, S, E, wave);
#else
            pg8::Gemm g{MRG, WB + WB_WOUT, 1024, 1024, 1024, nullptr}; SchedDense S{64, 4, G, bid, 1024, 1024}; Epi3 E{l == 0 ? inptr(I_X) : (const float*)nullptr, (bf16_t*)X, MOD + (size_t)l * 2 * 6144};
            for (int rep_ = 0; rep_ < ((DUPK == 5 && l == 0) ? 2 : 1); ++rep_) pg8::gemm_phase<Epi3, SchedDense, false>(lds, g, S, E, wave);
#endif
            if (BOTH(pb + 4)) SEAM();
        }
        if (KIND(6) && IN(pb + 5)) { SOPQ(bid); SOPQ(G); SOPQ(gw); SOPQ(NGW); if (DUPK == 6) { phase_token(P, lds, l, bid, G, wave, 2 + l); SEAM(); } phase_token(P, lds, l, bid, G, wave, l); if (BOTH(pb + 5)) SEAM(); }
        if (KIND(10) && IN(pb + 6)) { SOPQ(bid); SOPQ(G); SOPQ(gw); SOPQ(NGW);
            const bool fused = ((volatile LAS unsigned*)(lds + MISC_OFF))[8 + 3] != 0u && G == 256;
            const int x = fused ? (int)bar.x : (bid & 7), j = fused ? (int)((volatile LAS unsigned*)(lds + MISC_OFF))[8 + 4] : (bid >> 3), per = fused ? 32 : ((G - x + 7) >> 3);
            unsigned* TDl = fused ? ctl + CW_TD + l * 512 : (unsigned*)nullptr;
            const int nt = moe_tile_list(P, lds, l, wave); const int t0x = (int)((long)nt * x / 8), t1x = (int)((long)nt * (x + 1) / 8);
#if FP8_GA
            pg8::Gemm g{(const bf16_t*)(wsptr(P) + WS_HF8), WB, 512, 512, 512, (const int*)(wsptr(P) + WS_SMALL + SM_IDXP)};
#else
            pg8::Gemm g{H, WB, 1024, 1024, 1024, (const int*)(wsptr(P) + WS_SMALL + SM_IDXP)};
#endif
            SchedMoe<2, false> S{(LAS const i32x4*)(lds + TL_OFF), 2 * t0x, 2 * t1x, per, j, 0, nullptr};
            EpiUp E{HID, (const float*)(wsptr(P) + WS_SMALL + SM_GWP), TDl};
            REP(10) pg8::gemm_phase<EpiUp, SchedMoe<2, false>, true, FP8_GA != 0>(lds, g, S, E, wave);
            if (BOTH(pb + 6) && !fused) SEAM();
        }
        if (KIND(11) && IN(pb + 7)) { SOPQ(bid); SOPQ(G); SOPQ(gw); SOPQ(NGW);
            const bool fused = ((volatile LAS unsigned*)(lds + MISC_OFF))[8 + 3] != 0u && G == 256 && BOTH(pb + 6);
            const int x = fused ? (int)bar.x : (bid & 7), j = fused ? (int)((volatile LAS unsigned*)(lds + MISC_OFF))[8 + 4] : (bid >> 3), per = fused ? 32 : ((G - x + 7) >> 3);
            const unsigned* TDl = fused ? ctl + CW_TD + l * 512 : (const unsigned*)nullptr;
            const int nt = moe_tile_list(P, lds, l, wave); const int t0x = (int)((long)nt * x / 8), t1x = (int)((long)nt * (x + 1) / 8);
#if FP8_GB
            pg8::Gemm g{HID, WB, 128, 128, 128, nullptr};
#else
            pg8::Gemm g{HID, WB, 256, 256, 256, nullptr};
#endif
            SchedMoe<4, true> S{(LAS const i32x4*)(lds + TL_OFF), 4 * t0x, 4 * t1x, per, j, (2 * (t1x - t0x)) % per, TDl};
            EpiDown E{(unsigned char*)Y2, (float*)(wsptr(P) + WS_R1 + Y2SC_OFF)};
            REP(11) pg8::gemm_phase<EpiDown, SchedMoe<4, true>, false, FP8_GB != 0>(lds, g, S, E, wave);
            if (BOTH(pb + 7)) SEAM();
        }
    }
    if (KIND(12) && IN(N_PHASES - 1)) { REP(13) phase_norm1<2>(P, lds, NL, gw, NGW, wave); }
#undef IN
#undef BOTH
#undef SEAM
#undef WB
#undef X
#undef H
#undef YS
#undef MRG
#undef HID
#undef PROJ
#undef SG
#undef Y2
#undef MOD
}

extern "C" void kernel_launch(void* const* d_in, const int* in_sizes, int n_in, void* d_out, int out_size, void* d_ws, size_t ws_size, hipStream_t stream) {
    static int grid = 0;
    if (grid == 0) {
        if (n_in != 29 || out_size != M * D || ws_size < WS_END) { fprintf(stderr, "kernel_launch: unexpected shapes (n_in %d, out %d, ws %zu)\n", n_in, out_size, ws_size); grid = -1; return; }
        int dev = 0, cus = 0;
        if (hipGetDevice(&dev) != hipSuccess || hipDeviceGetAttribute(&cus, hipDeviceAttributeMultiprocessorCount, dev) != hipSuccess) { grid = -1; return; }
        if (hipFuncSetAttribute((const void*)fwd_kernel, hipFuncAttributeMaxDynamicSharedMemorySize, LDS_BYTES) != hipSuccess) { fprintf(stderr, "kernel_launch: hipFuncSetAttribute failed\n"); grid = -1; return; }
        int per_cu = 0;
        if (hipOccupancyMaxActiveBlocksPerMultiprocessor(&per_cu, (const void*)fwd_kernel, NTHREADS, LDS_BYTES) != hipSuccess || per_cu < 1) { fprintf(stderr, "kernel_launch: occupancy query says %d\n", per_cu); }
        (void)hipGetLastError();
        grid = cus;
    }
    if (grid < 0) return;
    (void)hipMemsetAsync((char*)d_ws + WS_CTL, 0, CTL_ZERO_BYTES, stream);
    Params p; memset(&p, 0, sizeof(p));
    for (int i = 0; i < 29; ++i) p.in[i] = (const float*)d_in[i];
    p.out = (float*)d_out; p.ws = (unsigned char*)d_ws;
#if MK_ONE_LAUNCH
    p.ph_lo = 0; p.ph_hi = N_PHASES;
    hipLaunchKernelGGL(fwd_kernel, dim3(grid), dim3(NTHREADS), LDS_BYTES, stream, p);
#else
    for (int k = 0; k < N_PHASES; ++k) { p.ph_lo = k; p.ph_hi = k + 1; hipLaunchKernelGGL(fwd_kernel, dim3(grid), dim3(NTHREADS), LDS_BYTES, stream, p); }
#endif
}
```
